# Optimizing an MI355X kernel written in HIP

```python
import jax, jax.numpy as jnp
from jax import lax
import numpy as np

D_MODEL = 2048
BATCH = 4
SEQ = 2048
DEPTH = 1
DEC_BATCH = 128
DEC_SEQ = 1
PAST_LEN = 16384
PAGE_SIZE = 128

D_POOL = D_MODEL // 2
POOL_WINDOWS = (2, 4, 8, 16)
POOL_GROUPS = len(POOL_WINDOWS)
POOL_GROUP_DIM = D_POOL // POOL_GROUPS
POOL_BUF = max(POOL_WINDOWS) - 1
N_HEADS = 8
HEAD_DK = D_MODEL // 16
HEAD_DV = D_MODEL // 8
D_QK = N_HEADS * HEAD_DK
D_V = N_HEADS * HEAD_DV
CHUNK = 128
ROPE_BASE = 10000.0
EPS = 1e-6
D_IN = 2 * D_POOL + 2 * D_QK + 2 * D_V
SPLITS = (D_POOL, 2 * D_POOL, 2 * D_POOL + D_QK, 2 * D_POOL + 2 * D_QK, 2 * D_POOL + 2 * D_QK + D_V)

kernel_name = 'pool_retention_gated_hybrid_step'


def rmsnorm(x, g):
    xf = x.astype(jnp.float32)
    xf = xf * lax.rsqrt(jnp.mean(xf * xf, axis=-1, keepdims=True) + EPS)
    return xf * g.astype(jnp.float32)


def rotary(x, start):
    T = x.shape[1]
    half = HEAD_DK // 2
    inv = ROPE_BASE ** (-jnp.arange(half, dtype=jnp.float32) / half)
    pos = start + jnp.arange(T, dtype=jnp.float32)
    ang = pos[:, None] * inv[None, :]
    cos = jnp.cos(ang)[None, :, None, :]
    sin = jnp.sin(ang)[None, :, None, :]
    x1, x2 = x[..., :half], x[..., half:]
    return jnp.concatenate([x1 * cos - x2 * sin, x1 * sin + x2 * cos], axis=-1)


def pool_mixer(xa, buf, start, pool_w, pool_scale):
    B, T, _ = xa.shape
    P = POOL_BUF
    ext = jnp.concatenate([buf.astype(jnp.float32), xa.astype(jnp.float32)], axis=1)
    cs = jnp.concatenate([jnp.zeros((B, 1, D_POOL), jnp.float32), jnp.cumsum(ext, axis=1)], axis=1)
    pos = start + jnp.arange(T)
    outs = []
    for g, w in enumerate(POOL_WINDOWS):
        sl = slice(g * POOL_GROUP_DIM, (g + 1) * POOL_GROUP_DIM)
        win = cs[:, P + 1:P + 1 + T, sl] - cs[:, P + 1 - w:P + 1 - w + T, sl]
        cnt = jnp.minimum(pos + 1, w).astype(jnp.float32)[None, :, None]
        outs.append(win / cnt - ext[:, P:, sl])
    pooled = jnp.stack(outs, axis=2)
    mixed = jnp.einsum('btgc,gcd->btgd', pooled, pool_w).reshape(B, T, D_POOL) * pool_scale
    return mixed, ext[:, -POOL_BUF:]


def retention(q, k, v, S0):
    B, H, T, _ = q.shape
    C = min(CHUNK, T)
    NC = T // C
    lg = jnp.log1p(-jnp.power(2.0, -5.0 - jnp.arange(N_HEADS, dtype=jnp.float32)))
    idx = jnp.arange(C, dtype=jnp.float32)
    diff = idx[:, None] - idx[None, :]
    dmask = jnp.where(diff[None] >= 0, jnp.exp(jnp.maximum(diff, 0.0)[None] * lg[:, None, None]), 0.0)
    q_dec = jnp.exp((idx + 1.0)[None, :] * lg[:, None])[..., None]
    k_dec = jnp.exp((C - 1.0 - idx)[None, :] * lg[:, None])[..., None]
    chunk_dec = jnp.exp(C * lg)[:, None, None]

    def to_chunks(a):
        return jnp.moveaxis(a.reshape(B, H, NC, C, a.shape[-1]), 2, 0)

    def step(S, inp):
        qc, kc, vc = inp
        scores = jnp.einsum('bhld,bhmd->bhlm', qc, kc) * dmask
        o = jnp.einsum('bhlm,bhmv->bhlv', scores, vc) + jnp.einsum('bhld,bhdv->bhlv', qc * q_dec, S)
        S = chunk_dec * S + jnp.einsum('bhld,bhlv->bhdv', kc * k_dec, vc)
        return S, o

    S, o = lax.scan(step, S0, (to_chunks(q), to_chunks(k), to_chunks(v)))
    o = jnp.moveaxis(o, 0, 2).reshape(B, H, T, HEAD_DV)
    return o, S


def mixer_layer(x, c, buf, S0, start, ada_w, ada_b, g_pre, g_post, w_in, pool_w, pool_scale,
                gn_g, w_a_proj, w_b_proj, w_merge, b_merge, w_out):
    B, T, _ = x.shape
    mod = jax.nn.silu(c.astype(jnp.float32)) @ ada_w + ada_b
    shift, scale, gate = jnp.split(mod, 3, axis=-1)
    h = rmsnorm(x, g_pre) * (1.0 + scale[:, None]) + shift[:, None]
    z = h @ w_in
    a_x, a_g, q, k, v, b_g = jnp.split(z, SPLITS, axis=-1)
    y_a, new_buf = pool_mixer(a_x, buf, start, pool_w, pool_scale)
    y_a = y_a * jax.nn.silu(a_g)
    q = rotary(q.reshape(B, T, N_HEADS, HEAD_DK), start)
    k = rotary(k.reshape(B, T, N_HEADS, HEAD_DK), start) * (HEAD_DK ** -0.5)
    v = v.reshape(B, T, N_HEADS, HEAD_DV)
    o, S = retention(q.transpose(0, 2, 1, 3), k.transpose(0, 2, 1, 3), v.transpose(0, 2, 1, 3),
                     S0.astype(jnp.float32))
    o = o.transpose(0, 2, 1, 3)
    mu = jnp.mean(o, axis=-1, keepdims=True)
    var = jnp.mean(jnp.square(o - mu), axis=-1, keepdims=True)
    o = (o - mu) * lax.rsqrt(var + EPS) * gn_g
    y_b = o.reshape(B, T, D_V) * jax.nn.silu(b_g)
    ya = y_a @ w_a_proj
    yb = y_b @ w_b_proj
    gates = jax.nn.sigmoid(h @ w_merge + b_merge)
    g_a, g_b = jnp.split(gates, 2, axis=-1)
    out = rmsnorm((g_a * ya + g_b * yb) @ w_out, g_post)
    y = x.astype(jnp.float32) + gate[:, None] * out
    return y.astype(x.dtype), new_buf.astype(buf.dtype), S.astype(S0.dtype)


def setup_inputs(seed: int = 0) -> dict:
    key = jax.random.key(seed)
    ks = jax.random.split(key, 20)
    f32 = jnp.float32
    nrm = lambda k, shape, s: jax.random.normal(k, shape, f32) * s
    D = D_MODEL
    return {
        'x_prompt': nrm(ks[0], (BATCH, SEQ, D), 1.0),
        'x_sample': nrm(ks[1], (DEC_BATCH, DEC_SEQ, D), 1.0),
        'state_pool': nrm(ks[2], (DEPTH, DEC_BATCH, POOL_BUF, D_POOL), 1.0),
        'state_ret': nrm(ks[3], (DEPTH, DEC_BATCH, N_HEADS, HEAD_DK, HEAD_DV), 0.5),
        'c_prompt': nrm(ks[4], (BATCH, D), 1.0),
        'c_sample': nrm(ks[5], (DEC_BATCH, D), 1.0),
        'ada_w': nrm(ks[6], (DEPTH, D, 3 * D), 0.5 * D ** -0.5),
        'ada_b': nrm(ks[7], (DEPTH, 3 * D), 0.02),
        'g_pre': 1.0 + nrm(ks[8], (DEPTH, D), 0.02),
        'g_post': 1.0 + nrm(ks[9], (DEPTH, D), 0.02),
        'w_in': nrm(ks[10], (DEPTH, D, D_IN), D ** -0.5),
        'pool_w': nrm(ks[11], (DEPTH, POOL_GROUPS, POOL_GROUP_DIM, POOL_GROUP_DIM), POOL_GROUP_DIM ** -0.5),
        'pool_scale': 1.0 + nrm(ks[12], (DEPTH, D_POOL), 0.02),
        'gn_g': 1.0 + nrm(ks[13], (DEPTH, N_HEADS, HEAD_DV), 0.02),
        'w_a_proj': nrm(ks[14], (DEPTH, D_POOL, D), D_POOL ** -0.5),
        'w_b_proj': nrm(ks[15], (DEPTH, D_V, D), D_V ** -0.5),
        'w_merge': nrm(ks[16], (DEPTH, D, 2 * D), D ** -0.5),
        'b_merge': nrm(ks[17], (DEPTH, 2 * D), 0.02),
        'w_out': nrm(ks[18], (DEPTH, D, D), D ** -0.5),
    }


def reference(x_prompt, x_sample, state_pool, state_ret, c_prompt, c_sample, ada_w, ada_b, g_pre, g_post,
              w_in, pool_w, pool_scale, gn_g, w_a_proj, w_b_proj, w_merge, b_merge, w_out):
    xp, xs = x_prompt, x_sample
    pool_p, ret_p, pool_s, ret_s = [], [], [], []
    for l in range(DEPTH):
        params = (ada_w[l], ada_b[l], g_pre[l], g_post[l], w_in[l], pool_w[l], pool_scale[l], gn_g[l],
                  w_a_proj[l], w_b_proj[l], w_merge[l], b_merge[l], w_out[l])
        buf0 = jnp.zeros((xp.shape[0], POOL_BUF, D_POOL), state_pool.dtype)
        S00 = jnp.zeros((xp.shape[0], N_HEADS, HEAD_DK, HEAD_DV), state_ret.dtype)
        xp, bp, sp = mixer_layer(xp, c_prompt, buf0, S00, 0, *params)
        xs, bs, ss = mixer_layer(xs, c_sample, state_pool[l], state_ret[l], PAST_LEN, *params)
        pool_p.append(bp)
        ret_p.append(sp)
        pool_s.append(bs)
        ret_s.append(ss)
    new_pool_prompt = jnp.stack(pool_p, axis=0)
    new_ret_prompt = jnp.stack(ret_p, axis=0)
    new_pool_sample = jnp.stack(pool_s, axis=0)
    new_ret_sample = jnp.stack(ret_s, axis=0)
    return (xp, xs, new_pool_prompt, new_ret_prompt, new_pool_sample, new_ret_sample)
```

```cpp
#include <hip/hip_runtime.h>
#include <cstdio>
#include <cstdint>

#ifndef PH_MASK
#define PH_MASK 255
#endif
#ifndef MK_N_LAUNCHES
#define MK_N_LAUNCHES 1
#endif

namespace pg8 {
#define PG8_LAS __attribute__((address_space(3)))
typedef unsigned short bf16_t;
typedef short bf16x8 __attribute__((ext_vector_type(8)));
typedef float f32x4 __attribute__((ext_vector_type(4)));
typedef unsigned u32x4 __attribute__((ext_vector_type(4)));
typedef unsigned u32x2 __attribute__((ext_vector_type(2)));
constexpr int BM = 256, BK = 64, HALF = 128, HTB = HALF * BK * 2  , STAGE_BYTES = 8 * HTB, NXCD = 8, WGM = 8;

__host__ __device__ __forceinline__ int lds_byte(int r, int c) { const int st = (r >> 4) * 2 + (c >> 5), rr = r & 15, cc = c & 31, ob = rr * 64 + cc * 2; return st * 1024 + (ob ^ (((ob >> 9) & 1) << 5)); }
__host__ __device__ __forceinline__ void stage_rc(int b, int& R, int& C) { const int st = b / 1024, sb = b % 1024, swz = sb ^ (((sb >> 9) & 1) << 5); R = (st >> 1) * 16 + swz / 64; C = (st & 1) * 32 + (swz % 64) / 2; }
__host__ __device__ __forceinline__ int perm32(int rho) { const int n = rho >> 4, i = rho & 15; return 8 * (i >> 2) + 4 * n + (i & 3); }

struct Unit { int pm, pn; };
struct Gemm { const bf16_t* A; const bf16_t* Bt; int K, lda, ldb, a_pn_bytes; };

struct StaticOrder {
    int nM, nN, nwg, G, c;
    __host__ __device__ void init(int M, int N, int G_, int c_) { nM = M / BM; nN = N / BM; nwg = nM * nN; G = G_; c = c_; }
    __host__ __device__ bool next(int i, Unit& u) const {
        const long L = (long)i * G + c; if (L >= nwg) return false;
        int wgid = (int)L; { const int q = nwg / NXCD, r = nwg % NXCD, xcd = wgid % NXCD, off = wgid / NXCD; wgid = (xcd < r ? xcd * (q + 1) : r * (q + 1) + (xcd - r) * q) + off; }
        const int nig = WGM * nN, gid = wgid / nig, fm = gid * WGM, gsz = (nM - fm) < WGM ? (nM - fm) : WGM;
        u.pm = fm + ((wgid % nig) % gsz); u.pn = (wgid % nig) / gsz; return true;
    }
};

__device__ __forceinline__ unsigned cvt_pk_bf16(float lo, float hi) { unsigned r; asm volatile("v_cvt_pk_bf16_f32 %0, %1, %2" : "=v"(r) : "v"(lo), "v"(hi)); return r; }
__device__ __forceinline__ float bf_lo(unsigned w) { return __uint_as_float(w << 16); }
__device__ __forceinline__ float bf_hi(unsigned w) { return __uint_as_float(w & 0xffff0000u); }
__device__ __forceinline__ float sigmoidf_(float v) { return __builtin_amdgcn_rcpf(1.0f + __builtin_amdgcn_exp2f(-1.4426950408889634f * v)); }


template <class Epi, class Sched, bool ALIGN_EPI = false, bool SP2 = false>
__device__ __forceinline__ void gemm_phase(PG8_LAS unsigned char* lds, const Gemm g, const Sched& S, const Epi& E, const int tid) {
    const int wid = __builtin_amdgcn_readfirstlane(tid >> 6), lane = tid & 63, wr = wid >> 2, wc = wid & 3, fr = lane & 15, fq = lane >> 4;
    const int K = g.K, nt = K / BK;
    unsigned voffA[2], voffB[2];
#pragma unroll
    for (int i = 0; i < 2; ++i) { int R, C; stage_rc(tid * 16 + i * 8192, R, C); const int Rb = Epi::PERM ? ((R & ~31) + perm32(R & 31)) : R;
        voffA[i] = (unsigned)(R * g.lda + C) * 2u; voffB[i] = (unsigned)(Rb * g.ldb + C) * 2u; }
    const size_t kstep = (size_t)(BK * 2);
    const size_t hstepA = (size_t)HALF * g.lda * 2, hstepB = (size_t)HALF * g.ldb * 2;
    const size_t tstepA = 2 * hstepA, tstepB = 2 * hstepB;
    const unsigned ldsw = (unsigned)wid * 1024u;
    const int aoff = lds_byte(wr * 64 + fr, fq * 8), boff = lds_byte(wc * 32 + fr, fq * 8);
#define PG8_SA(b, h) (((b) * 2 + (h)) * HTB)
#define PG8_SB(b, h) ((4 + (b) * 2 + (h)) * HTB)
#define PG8_STAGE(bufoff, gbase, voff) do { _Pragma("unroll") for (int _i = 0; _i < 2; ++_i) \
        __builtin_amdgcn_global_load_lds((const unsigned*)((const char*)(gbase) + (voff)[_i]), (PG8_LAS unsigned*)(lds + (bufoff) + ldsw + _i * 8192), 16, 0, 0); } while (0)
#define PG8_LDA(dst, b, h) do { _Pragma("unroll") for (int m = 0; m < 4; ++m) _Pragma("unroll") for (int k = 0; k < 2; ++k) dst[m][k] = *(const PG8_LAS bf16x8*)(lds + PG8_SA(b, h) + aoff + m * 2048 + k * 1024); } while (0)
#define PG8_LDB(dst, b, h) do { _Pragma("unroll") for (int n = 0; n < 2; ++n) _Pragma("unroll") for (int k = 0; k < 2; ++k) dst[n][k] = *(const PG8_LAS bf16x8*)(lds + PG8_SB(b, h) + boff + n * 2048 + k * 1024); } while (0)
#define PG8_MMA(ai, bj, At, Bt) do { __builtin_amdgcn_s_setprio(1); _Pragma("unroll") for (int m = 0; m < 4; ++m) _Pragma("unroll") for (int n = 0; n < 2; ++n) _Pragma("unroll") for (int k = 0; k < 2; ++k) \
        acc[ai][bj][m][n] = __builtin_amdgcn_mfma_f32_16x16x32_bf16(Bt[n][k], At[m][k], acc[ai][bj][m][n], 0, 0, 0); __builtin_amdgcn_s_setprio(0); } while (0)
#define PG8_WAIT_V(n) asm volatile("s_waitcnt vmcnt(" #n ")" ::: "memory")
#define PG8_WAIT_L(n) asm volatile("s_waitcnt lgkmcnt(" #n ")" ::: "memory")
#define PG8_BAR __builtin_amdgcn_s_barrier()
#define PG8_SCHED __builtin_amdgcn_sched_barrier(0)
    Unit cur, nxt; int ui = 0;
    if (!S.next(0, cur)) return;
    f32x4 acc[2][2][4][2];
#pragma unroll
    for (int a = 0; a < 2; ++a)
#pragma unroll
        for (int b = 0; b < 2; ++b)
#pragma unroll
            for (int m = 0; m < 4; ++m)
#pragma unroll
                for (int n = 0; n < 2; ++n) acc[a][b][m][n] = (f32x4){0.f, 0.f, 0.f, 0.f};
    bf16x8 At[4][2], B0[2][2], B1[2][2];
    const char* cA = (const char*)g.A + (size_t)cur.pm * tstepA + (size_t)cur.pn * g.a_pn_bytes; const char* cB = (const char*)g.Bt + (size_t)cur.pn * tstepB;
    if constexpr (SP2) {
        PG8_STAGE(PG8_SB(0, 0), cB, voffB); PG8_STAGE(PG8_SB(0, 1), cB + hstepB, voffB); PG8_STAGE(PG8_SA(0, 0), cA, voffA); PG8_STAGE(PG8_SA(0, 1), cA + hstepA, voffA);
        if (wr == 1) PG8_BAR;
        PG8_WAIT_V(2); PG8_BAR;
        PG8_STAGE(PG8_SB(1, 0), cB + kstep, voffB); PG8_STAGE(PG8_SA(1, 0), cA + kstep, voffA); PG8_STAGE(PG8_SB(1, 1), cB + hstepB + kstep, voffB);
        PG8_WAIT_V(6); PG8_BAR;
    } else {
        PG8_STAGE(PG8_SB(0, 0), cB, voffB); PG8_STAGE(PG8_SA(0, 0), cA, voffA); PG8_STAGE(PG8_SB(0, 1), cB + hstepB, voffB); PG8_STAGE(PG8_SA(0, 1), cA + hstepA, voffA);
        if (wr == 1) PG8_BAR;
        PG8_WAIT_V(4); PG8_BAR;
        PG8_STAGE(PG8_SB(1, 0), cB + kstep, voffB); PG8_STAGE(PG8_SA(1, 0), cA + kstep, voffA); PG8_STAGE(PG8_SB(1, 1), cB + hstepB + kstep, voffB);
        PG8_WAIT_V(6); PG8_BAR;
    }
    for (;;) {
        const bool has_next = S.next(ui + 1, nxt);
        const char* nA = has_next ? (const char*)g.A + (size_t)nxt.pm * tstepA + (size_t)nxt.pn * g.a_pn_bytes : cA; const char* nB = has_next ? (const char*)g.Bt + (size_t)nxt.pn * tstepB : cB;
        for (int t = 0; t < nt; t += 2) {
            if constexpr (Epi::MID_T > 0) { if (t == Epi::MID_T) E.mid(acc, cur, wr, wc, fr, fq); }
            const bool last = (t == nt - 2);
            const char* a1 = cA + (size_t)(t + 1) * kstep;
            const char* a2 = last ? nA : cA + (size_t)(t + 2) * kstep; const char* b2 = last ? nB : cB + (size_t)(t + 2) * kstep;
            const char* a3 = a2 + kstep; const char* b3 = b2 + kstep;
            if constexpr (SP2) {
            PG8_LDB(B0, 0, 0); PG8_LDB(B1, 0, 1); PG8_SCHED; PG8_LDA(At, 0, 0); PG8_STAGE(PG8_SA(1, 1), a1 + hstepA, voffA);
            PG8_WAIT_V(8); PG8_WAIT_L(0); PG8_BAR; PG8_MMA(0, 0, At, B0); PG8_MMA(0, 1, At, B1); PG8_BAR; PG8_SCHED;
            PG8_LDA(At, 0, 1); PG8_STAGE(PG8_SB(0, 0), b2, voffB); PG8_STAGE(PG8_SB(0, 1), b2 + hstepB, voffB); PG8_STAGE(PG8_SA(0, 0), a2, voffA);
            PG8_WAIT_V(8); PG8_WAIT_L(0); PG8_BAR; PG8_MMA(1, 0, At, B0); PG8_MMA(1, 1, At, B1); PG8_BAR; PG8_SCHED;
            PG8_LDB(B0, 1, 0); PG8_LDB(B1, 1, 1); PG8_SCHED; PG8_LDA(At, 1, 0); PG8_STAGE(PG8_SA(0, 1), a2 + hstepA, voffA);
            PG8_WAIT_V(8); PG8_WAIT_L(0); PG8_BAR; PG8_MMA(0, 0, At, B0); PG8_MMA(0, 1, At, B1); PG8_BAR; PG8_SCHED;
            PG8_LDA(At, 1, 1); PG8_STAGE(PG8_SB(1, 0), b3, voffB); PG8_STAGE(PG8_SB(1, 1), b3 + hstepB, voffB); PG8_STAGE(PG8_SA(1, 0), a3, voffA);
            PG8_WAIT_V(8); PG8_WAIT_L(0); PG8_BAR; PG8_MMA(1, 0, At, B0); PG8_MMA(1, 1, At, B1); PG8_BAR; PG8_SCHED;
            } else {
            PG8_LDB(B0, 0, 0); PG8_SCHED; PG8_LDA(At, 0, 0); PG8_STAGE(PG8_SA(1, 1), a1 + hstepA, voffA);
            PG8_WAIT_L(8); PG8_BAR; PG8_WAIT_L(0); PG8_MMA(0, 0, At, B0); PG8_BAR; PG8_SCHED;
            PG8_LDB(B1, 0, 1); PG8_STAGE(PG8_SB(0, 0), b2, voffB);
            PG8_BAR; PG8_WAIT_L(0); PG8_MMA(0, 1, At, B1); PG8_BAR;
            PG8_LDA(At, 0, 1); PG8_STAGE(PG8_SA(0, 0), a2, voffA);
            PG8_BAR; PG8_WAIT_L(0); PG8_MMA(1, 0, At, B0); PG8_BAR; PG8_SCHED;
            PG8_STAGE(PG8_SB(0, 1), b2 + hstepB, voffB);
            PG8_WAIT_V(6); PG8_BAR; PG8_MMA(1, 1, At, B1); PG8_BAR;
            PG8_LDB(B0, 1, 0); PG8_SCHED; PG8_LDA(At, 1, 0); PG8_STAGE(PG8_SA(0, 1), a2 + hstepA, voffA);
            PG8_WAIT_L(8); PG8_BAR; PG8_WAIT_L(0); PG8_MMA(0, 0, At, B0); PG8_BAR; PG8_SCHED;
            PG8_LDB(B1, 1, 1); PG8_STAGE(PG8_SB(1, 0), b3, voffB);
            PG8_BAR; PG8_WAIT_L(0); PG8_MMA(0, 1, At, B1); PG8_BAR;
            PG8_LDA(At, 1, 1); PG8_STAGE(PG8_SA(1, 0), a3, voffA);
            PG8_BAR; PG8_WAIT_L(0); PG8_MMA(1, 0, At, B0); PG8_BAR; PG8_SCHED;
            PG8_STAGE(PG8_SB(1, 1), b3 + hstepB, voffB);
            PG8_WAIT_V(6); PG8_BAR; PG8_MMA(1, 1, At, B1); PG8_BAR;
            }
        }
        if constexpr (ALIGN_EPI) { if (wr == 0) PG8_BAR; }
        E(acc, cur, wr, wc, fr, fq);
        if (!has_next) break;
#pragma unroll
        for (int a = 0; a < 2; ++a)
#pragma unroll
            for (int b = 0; b < 2; ++b)
#pragma unroll
                for (int m = 0; m < 4; ++m)
#pragma unroll
                    for (int n = 0; n < 2; ++n) acc[a][b][m][n] = (f32x4){0.f, 0.f, 0.f, 0.f};
        cur = nxt; cA = nA; cB = nB; ++ui;
        if constexpr (ALIGN_EPI) { if (wr == 1) PG8_BAR; }
    }
    PG8_WAIT_V(0);
    if constexpr (!ALIGN_EPI) { if (wr == 0) PG8_BAR; }
    PG8_BAR;
#undef PG8_SA
#undef PG8_SB
#undef PG8_STAGE
#undef PG8_LDA
#undef PG8_LDB
#undef PG8_MMA
#undef PG8_WAIT_V
#undef PG8_WAIT_L
#undef PG8_BAR
#undef PG8_SCHED
}
}

constexpr int NWAVES = 8;
constexpr int DM = 2048, MP = 8192, MS = 128, SEQ = 2048, MT = 8448;
constexpr int DPOOL = 1024, NH = 8, DK = 128, DV = 256, DIN = 8192, LDZ = 12288, LDY = 3072;
constexpr int ZC_AX = 0, ZC_AG = 1024, ZC_Q = 2048, ZC_K = 3072, ZC_V = 4096, ZC_BG = 6144, ZC_GA = 8192, ZC_GB = 10240;
constexpr float EPS = 1e-6f;
constexpr int PAST = 16384;
constexpr size_t O_YP = 0, O_YS = 16777216, O_PP = 17039360, O_RP = 17100800, O_PS = 18149376, O_RS = 20115456;

constexpr size_t MiB = 1u << 20;
constexpr size_t WS_CTL = 0, CTL_ZERO_BYTES = 1 * MiB;
constexpr size_t WS_ROPE = 1 * MiB;
constexpr size_t WS_MOD = 3 * MiB;
constexpr size_t WS_SS = 7 * MiB;
constexpr size_t WS_WCAT = 16 * MiB;
constexpr size_t WS_WAB = 64 * MiB;
constexpr size_t WS_WOUT = 76 * MiB;
constexpr size_t WS_POOLW = 84 * MiB;
constexpr size_t WS_H = 96 * MiB;
constexpr size_t WS_Z = 130 * MiB;
constexpr size_t WS_YAB = 328 * MiB;
constexpr size_t WS_POOLED = 378 * MiB;
constexpr size_t WS_SN = 396 * MiB;
constexpr size_t WS_MB = 428 * MiB;
constexpr size_t WS_END = 462 * MiB;
constexpr int CW_BAR = 4096;

constexpr int RING_OFF = 0, RING_BYTES = 131072;
constexpr int LDSCTL_OFF = RING_BYTES, MISC_OFF = LDSCTL_OFF + 320;
constexpr int STAT_OFF = RING_BYTES + 1024;
constexpr int LDS_BYTES = 147456;

#define GAS __attribute__((address_space(1)))
#define LAS __attribute__((address_space(3)))
typedef unsigned short bf16;
typedef unsigned v4u __attribute__((ext_vector_type(4)));
typedef unsigned v2u __attribute__((ext_vector_type(2)));
typedef float f32x4 __attribute__((ext_vector_type(4)));
typedef float f32x16 __attribute__((ext_vector_type(16)));
typedef short bf16x8 __attribute__((ext_vector_type(8)));
typedef short s16x4 __attribute__((ext_vector_type(4)));
typedef GAS unsigned gu32;
#define RLX_AGENT __ATOMIC_RELAXED, __HIP_MEMORY_SCOPE_AGENT
#define LDS_WAIT() asm volatile("s_waitcnt lgkmcnt(0)" ::: "memory")
#define VM_WAIT() asm volatile("s_waitcnt vmcnt(0)" ::: "memory")
__device__ __forceinline__ unsigned f2bf(float f) { unsigned u = __builtin_bit_cast(unsigned, f); return (u + 0x7fffu + ((u >> 16) & 1u)) >> 16; }
__device__ __forceinline__ unsigned pk2(float lo, float hi) { return f2bf(lo) | (f2bf(hi) << 16); }
__device__ __forceinline__ float bflo(unsigned w) { return __uint_as_float(w << 16); }
__device__ __forceinline__ float bfhi(unsigned w) { return __uint_as_float(w & 0xffff0000u); }
__device__ __forceinline__ float bf1(bf16 b) { return __uint_as_float((unsigned)b << 16); }
__device__ __forceinline__ float silu_(float v) { return v * __builtin_amdgcn_rcpf(1.0f + __builtin_amdgcn_exp2f(-1.4426950408889634f * v)); }
__device__ __forceinline__ float wave_sum(float v) {
#pragma unroll
    for (int o = 1; o < 64; o <<= 1) v += __shfl_xor(v, o);
    return v;
}
__device__ __forceinline__ float lg2gamma(int h) {
    const float t[8] = {-0.04580368961312479f, -0.02272007650008353f, -0.011315313227834146f, -0.005646563141142063f, -0.0028205190623786626f, -0.0014095702546713536f, -0.0007046129765893727f, -0.0003522634716290214f};
    float r = t[0];
#pragma unroll
    for (int i = 1; i < 8; ++i) r = (h == i) ? t[i] : r;
    return r;
}

__device__ __forceinline__ int fresh_lane() { unsigned m_ = ~0u; asm volatile("" : "+s"(m_)); return (int)__builtin_amdgcn_mbcnt_hi(m_, __builtin_amdgcn_mbcnt_lo(m_, 0u)); }
#define XB_TMO      128
#define XB_XCNT(j)  (256  + 64 * (j))
#define XB_XSUB(j)  (1280 + 64 * (j))
#define XB_XGEN(j)  (2304 + 64 * (j))
#define XB_TOP      3328
#define XB_TOPGEN   3392
#define XCD_BAR_WORDS 3456
#define XB_SPIN_CAP (1u << 18)
__device__ __forceinline__ unsigned xb_ld(unsigned* p)              { return __hip_atomic_load(p, __ATOMIC_RELAXED, __HIP_MEMORY_SCOPE_AGENT); }
__device__ __forceinline__ unsigned xb_add(unsigned* p, unsigned v) { return __hip_atomic_fetch_add(p, v, __ATOMIC_RELAXED, __HIP_MEMORY_SCOPE_AGENT); }
__device__ __forceinline__ unsigned xb_xcc_id() { return (unsigned)__builtin_amdgcn_s_getreg((3 << 11) | 20) & 0xFu; }
#define XB_SPIN(cond, bar) do { unsigned _sp = 0; while (cond) { __builtin_amdgcn_s_sleep(1); \
    if ((++_sp & 255u) == 0u) { if (xb_ld(&(bar)[XB_TMO])) break; if (_sp > XB_SPIN_CAP) { atomicAdd(&(bar)[XB_TMO], 1u); break; } } } } while (0)
struct XcdBarrier { unsigned* bar; unsigned x; volatile LAS unsigned* st; int wave; };
__device__ __forceinline__ XcdBarrier xcd_barrier_post(unsigned* bar, volatile LAS unsigned* st, int wave) {
    XcdBarrier b; b.bar = bar; b.x = xb_xcc_id(); b.st = st; b.wave = wave;
    if (wave == 0 && fresh_lane() == 0) (void)xb_add(&bar[XB_XCNT(b.x)], 1u);
    return b;
}
__device__ __forceinline__ void xcd_barrier_complete(unsigned* bar, unsigned x, unsigned& nloc, unsigned& nx) {
    const unsigned G = gridDim.x * gridDim.y * gridDim.z;
    unsigned sum, cnt, mine, sp = 0u;
    for (;;) {
        sum = 0u; cnt = 0u; mine = 0u;
#pragma unroll
        for (unsigned j = 0; j < 16; ++j) { const unsigned c = xb_ld(&bar[XB_XCNT(j)]); sum += c; cnt += (c > 0u) ? 1u : 0u; mine = (j == x) ? c : mine; }
        if (sum == G) break;
        __builtin_amdgcn_s_sleep(1);
        if ((++sp & 255u) == 0u) { if (xb_ld(&bar[XB_TMO])) break; if (sp > XB_SPIN_CAP) { atomicAdd(&bar[XB_TMO], 1u); break; } }
    }
    nloc = mine > 0u ? mine : 1u; nx = cnt > 0u ? cnt : 1u;
}
__device__ __forceinline__ void xcd_barrier(const XcdBarrier& b) {
    asm volatile("s_waitcnt vmcnt(0)" ::: "memory");
    __syncthreads();
    if (b.wave == 0 && fresh_lane() == 0) {
        unsigned* bar = b.bar;
        __builtin_amdgcn_s_waitcnt(0);
        unsigned nloc = b.st[0], nx = b.st[1];
        if (nloc == 0u) { xcd_barrier_complete(bar, b.x, nloc, nx); b.st[0] = nloc; b.st[1] = nx; }
        const unsigned old = xb_add(&bar[XB_XSUB(b.x)], 1u);
        const unsigned gen = old / nloc;
        if (old + 1u == (gen + 1u) * nloc) {
            __builtin_amdgcn_fence(__ATOMIC_RELEASE, "agent");
            asm volatile("s_waitcnt vmcnt(0)" ::: "memory");
            const unsigned og = xb_add(&bar[XB_TOP], 1u);
            const unsigned tg = og / nx;
            if (og + 1u == (tg + 1u) * nx) xb_add(&bar[XB_TOPGEN], 1u);
            else XB_SPIN(xb_ld(&bar[XB_TOPGEN]) == tg, bar);
            __builtin_amdgcn_fence(__ATOMIC_ACQUIRE, "agent");
            xb_add(&bar[XB_XGEN(b.x)], 1u);
            asm volatile("s_waitcnt vmcnt(0)" ::: "memory");
        } else {
            XB_SPIN(xb_ld(&bar[XB_XGEN(b.x)]) == gen, bar);
            __builtin_amdgcn_fence(__ATOMIC_ACQUIRE, "agent");
            asm volatile("s_waitcnt vmcnt(0)" ::: "memory");
        }
    }
    __syncthreads();
}

struct Frame {
    LAS unsigned char* lds;
    volatile LAS unsigned* MISC;
    gu32* ctl;
    int tid, lane, wave;
    int vcu, G;
    const float *x_p, *x_s, *st_pool, *st_ret, *c_p, *c_s, *ada_w, *ada_b, *g_pre, *g_post, *w_in, *pool_w, *pool_scale, *gn_g, *w_a, *w_b, *w_merge, *b_merge, *w_out;
    float* out;
    float *ropec, *ropes, *mod, *ss;
    bf16 *Wcat, *Wab, *Wout, *PoolW, *H, *Z, *YAB, *POOLED, *SN, *MB;
};

struct EpiZ {
    static constexpr bool PERM = true; static constexpr int MID_T = 0;
    bf16* Z; const float* bmerge; const float* ropec; const float* ropes; float* out_pp; float* out_ps;
    __device__ __forceinline__ void operator()(const pg8::f32x4 (&acc)[2][2][4][2], const pg8::Unit& u, int wr, int wc, int fr, int fq) const {
        using namespace pg8;
        const int pn = u.pn, row0 = u.pm * BM + wr * 64 + fr, colp = wc * 32 + 8 * fq;
        if (pn >= 8 && pn < 16) {
            const float ksc = (pn >= 12) ? 0.08838834764831845f : 1.0f;
            const int j0 = 16 * wc + 4 * fq;
#pragma unroll
            for (int ai = 0; ai < 2; ++ai)
#pragma unroll
                for (int m = 0; m < 4; ++m) {
                    const int row = row0 + ai * HALF + m * 16; const int pos = row < MP ? (row & (SEQ - 1)) : SEQ;
                    const f32x4 c4 = *(const f32x4*)(ropec + pos * 64 + j0), s4 = *(const f32x4*)(ropes + pos * 64 + j0);
                    bf16* rowp = Z + (size_t)row * LDZ + pn * BM;
#pragma unroll
                    for (int bj = 0; bj < 2; ++bj) {
                        const f32x4 v0 = acc[ai][bj][m][0], v1 = acc[ai][bj][m][1];
                        const f32x4 o1 = (v0 * c4 - v1 * s4) * ksc, o2 = (v0 * s4 + v1 * c4) * ksc;
                        u32x2 w1, w2; w1.x = cvt_pk_bf16(o1[0], o1[1]); w1.y = cvt_pk_bf16(o1[2], o1[3]); w2.x = cvt_pk_bf16(o2[0], o2[1]); w2.y = cvt_pk_bf16(o2[2], o2[3]);
                        *(u32x2*)(rowp + bj * HALF + j0) = w1; *(u32x2*)(rowp + bj * HALF + 64 + j0) = w2;
                    }
                }
            return;
        }
        const int act = (pn >= 32) ? 2 : (((pn >= 4 && pn < 8) || (pn >= 24)) ? 1 : 0);
        f32x4 bv[2][2];
#pragma unroll
        for (int bj = 0; bj < 2; ++bj)
#pragma unroll
            for (int n = 0; n < 2; ++n) bv[bj][n] = (act == 2) ? *(const f32x4*)(bmerge + (pn - 32) * BM + bj * HALF + colp + 4 * n) : (f32x4){0.f, 0.f, 0.f, 0.f};
#pragma unroll
        for (int ai = 0; ai < 2; ++ai)
#pragma unroll
            for (int m = 0; m < 4; ++m) {
                const int row = row0 + ai * HALF + m * 16;
                bf16* rowp = Z + (size_t)row * LDZ + pn * BM + colp;
#pragma unroll
                for (int bj = 0; bj < 2; ++bj) {
                    f32x4 v0 = acc[ai][bj][m][0] + bv[bj][0], v1 = acc[ai][bj][m][1] + bv[bj][1];
                    if (act == 1) {
#pragma unroll
                        for (int e = 0; e < 4; ++e) { v0[e] = silu_(v0[e]); v1[e] = silu_(v1[e]); }
                    } else if (act == 2) {
#pragma unroll
                        for (int e = 0; e < 4; ++e) { v0[e] = sigmoidf_(v0[e]); v1[e] = sigmoidf_(v1[e]); }
                    }
                    u32x4 w; w.x = cvt_pk_bf16(v0[0], v0[1]); w.y = cvt_pk_bf16(v0[2], v0[3]); w.z = cvt_pk_bf16(v1[0], v1[1]); w.w = cvt_pk_bf16(v1[2], v1[3]);
                    *(u32x4*)(rowp + bj * HALF) = w;
                    if (pn < 4) {
                        const int col = pn * BM + bj * HALF + colp;
                        if (row < MP) { const int t = row & (SEQ - 1); if (t >= SEQ - 15) { float* o = out_pp + ((size_t)((row >> 11) * 15 + (t - (SEQ - 15)))) * DPOOL + col; *(f32x4*)o = v0; *(f32x4*)(o + 4) = v1; } }
                        else if (row < MP + MS) { float* o = out_ps + ((size_t)((row - MP) * 15 + 14)) * DPOOL + col; *(f32x4*)o = v0; *(f32x4*)(o + 4) = v1; }
                    }
                }
            }
    }
};
struct EpiPool {
    static constexpr bool PERM = true; static constexpr int MID_T = 0;
    bf16* Y; const bf16* Z; const float* pscale;
    __device__ __forceinline__ void operator()(const pg8::f32x4 (&acc)[2][2][4][2], const pg8::Unit& u, int wr, int wc, int fr, int fq) const {
        using namespace pg8;
        const int row0 = u.pm * BM + wr * 64 + fr, col0 = u.pn * BM + wc * 32 + 8 * fq;
        f32x4 ps[2][2];
#pragma unroll
        for (int bj = 0; bj < 2; ++bj)
#pragma unroll
            for (int n = 0; n < 2; ++n) ps[bj][n] = *(const f32x4*)(pscale + col0 + bj * HALF + 4 * n);
#pragma unroll
        for (int ai = 0; ai < 2; ++ai)
#pragma unroll
            for (int m = 0; m < 4; ++m) {
                const int row = row0 + ai * HALF + m * 16;
#pragma unroll
                for (int bj = 0; bj < 2; ++bj) {
                    const u32x4 g = *(const u32x4*)(Z + (size_t)row * LDZ + ZC_AG + col0 + bj * HALF);
                    f32x4 v0 = acc[ai][bj][m][0] * ps[bj][0], v1 = acc[ai][bj][m][1] * ps[bj][1];
                    v0[0] *= bf_lo(g.x); v0[1] *= bf_hi(g.x); v0[2] *= bf_lo(g.y); v0[3] *= bf_hi(g.y);
                    v1[0] *= bf_lo(g.z); v1[1] *= bf_hi(g.z); v1[2] *= bf_lo(g.w); v1[3] *= bf_hi(g.w);
                    u32x4 w; w.x = cvt_pk_bf16(v0[0], v0[1]); w.y = cvt_pk_bf16(v0[2], v0[3]); w.z = cvt_pk_bf16(v1[0], v1[1]); w.w = cvt_pk_bf16(v1[2], v1[3]);
                    *(u32x4*)(Y + (size_t)row * LDY + col0 + bj * HALF) = w;
                }
            }
    }
};
struct EpiMerge {
    static constexpr bool PERM = true; static constexpr int MID_T = 16;
    bf16* O; const bf16* Z;
    __device__ __forceinline__ void mid(pg8::f32x4 (&acc)[2][2][4][2], const pg8::Unit& u, int wr, int wc, int fr, int fq) const {
        using namespace pg8;
        const bf16* zb = Z + (size_t)(u.pm * BM + wr * 64 + fr) * LDZ + ZC_GA + u.pn * BM + wc * 32 + 8 * fq;
        asm volatile("" : "+v"(zb));
#pragma unroll
        for (int ai = 0; ai < 2; ++ai)
#pragma unroll
            for (int m = 0; m < 4; ++m) {
                const bf16* zr = zb + (size_t)(ai * HALF + m * 16) * LDZ;
#pragma unroll
                for (int bj = 0; bj < 2; ++bj) {
                    const u32x4 ga = *(const u32x4*)(zr + bj * HALF), gb = *(const u32x4*)(zr + (ZC_GB - ZC_GA) + bj * HALF);
                    f32x4& v0 = acc[ai][bj][m][0]; f32x4& v1 = acc[ai][bj][m][1];
                    v0[0] *= bf_lo(ga.x) * __builtin_amdgcn_rcpf(bf_lo(gb.x)); v0[1] *= bf_hi(ga.x) * __builtin_amdgcn_rcpf(bf_hi(gb.x)); v0[2] *= bf_lo(ga.y) * __builtin_amdgcn_rcpf(bf_lo(gb.y)); v0[3] *= bf_hi(ga.y) * __builtin_amdgcn_rcpf(bf_hi(gb.y));
                    v1[0] *= bf_lo(ga.z) * __builtin_amdgcn_rcpf(bf_lo(gb.z)); v1[1] *= bf_hi(ga.z) * __builtin_amdgcn_rcpf(bf_hi(gb.z)); v1[2] *= bf_lo(ga.w) * __builtin_amdgcn_rcpf(bf_lo(gb.w)); v1[3] *= bf_hi(ga.w) * __builtin_amdgcn_rcpf(bf_hi(gb.w));
                }
                asm volatile("" ::: "memory");
            }
    }
    __device__ __forceinline__ void operator()(const pg8::f32x4 (&acc)[2][2][4][2], const pg8::Unit& u, int wr, int wc, int fr, int fq) const {
        using namespace pg8;
        const int row0 = u.pm * BM + wr * 64 + fr, col0 = u.pn * BM + wc * 32 + 8 * fq;
#pragma unroll
        for (int ai = 0; ai < 2; ++ai)
#pragma unroll
            for (int m = 0; m < 4; ++m) {
                const int row = row0 + ai * HALF + m * 16;
#pragma unroll
                for (int bj = 0; bj < 2; ++bj) {
                    const u32x4 g = *(const u32x4*)(Z + (size_t)row * LDZ + ZC_GB + col0 + bj * HALF);
                    f32x4 v0 = acc[ai][bj][m][0], v1 = acc[ai][bj][m][1];
                    v0[0] *= bf_lo(g.x); v0[1] *= bf_hi(g.x); v0[2] *= bf_lo(g.y); v0[3] *= bf_hi(g.y);
                    v1[0] *= bf_lo(g.z); v1[1] *= bf_hi(g.z); v1[2] *= bf_lo(g.w); v1[3] *= bf_hi(g.w);
                    u32x4 w; w.x = cvt_pk_bf16(v0[0], v0[1]); w.y = cvt_pk_bf16(v0[2], v0[3]); w.z = cvt_pk_bf16(v1[0], v1[1]); w.w = cvt_pk_bf16(v1[2], v1[3]);
                    *(u32x4*)(O + (size_t)row * DM + col0 + bj * HALF) = w;
                }
            }
    }
};
struct EpiOut {
    static constexpr bool PERM = false; static constexpr int MID_T = 0;
    float* out; float* ss;
    __device__ __forceinline__ void operator()(const pg8::f32x4 (&acc)[2][2][4][2], const pg8::Unit& u, int wr, int wc, int fr, int fq) const {
        using namespace pg8;
        const int row0 = u.pm * BM + wr * 64 + fr, col0 = u.pn * BM + wc * 32 + 4 * fq;
#pragma unroll
        for (int ai = 0; ai < 2; ++ai)
#pragma unroll
            for (int m = 0; m < 4; ++m) {
                const int row = row0 + ai * HALF + m * 16;
                float s = 0.f;
#pragma unroll
                for (int bj = 0; bj < 2; ++bj)
#pragma unroll
                    for (int n = 0; n < 2; ++n) { const f32x4 v = acc[ai][bj][m][n]; s += (v[0] * v[0] + v[1] * v[1]) + (v[2] * v[2] + v[3] * v[3]); }
                s += __shfl_xor(s, 16); s += __shfl_xor(s, 32);
                if (fq == 0) ss[(size_t)row * 32 + u.pn * 4 + wc] = s;
                if (row < MP + MS) {
                    float* rowp = out + (row < MP ? O_YP + (size_t)row * DM : O_YS + (size_t)(row - MP) * DM) + col0;
#pragma unroll
                    for (int bj = 0; bj < 2; ++bj)
#pragma unroll
                        for (int n = 0; n < 2; ++n) *(f32x4*)(rowp + bj * HALF + n * 16) = acc[ai][bj][m][n];
                }
            }
    }
};

__device__ __forceinline__ int rot_row(int n) { const int L = n & 127, hf = L >> 6, j = L & 63; return (n & ~127) + 32 * (j >> 4) + 8 * ((j >> 2) & 3) + 4 * hf + (j & 3); }
__device__ __forceinline__ void p0_transpose_item(const float* W, int N, bf16* WT, int ldw, int row_off, int koff, int rot_lo, int rot_hi, LAS float* scr, int item, int lane) {
    const int nblk = N / 32, kb = item / nblk, nb = item % nblk, k0 = 64 * kb, n0 = 32 * nb;
#pragma unroll 8
    for (int i = 0; i < 32; ++i) { const int kk = 2 * i + (lane >> 5); scr[kk * 33 + (lane & 31)] = W[(size_t)(k0 + kk) * N + n0 + (lane & 31)]; }
    LDS_WAIT(); asm volatile("" ::: "memory");
    const int c = lane & 7;
#pragma unroll
    for (int j = 0; j < 4; ++j) { const int n = (lane >> 3) + 8 * j; const LAS float* s = scr + (8 * c) * 33 + n;
        v4u o; o.x = pk2(s[0 * 33], s[1 * 33]); o.y = pk2(s[2 * 33], s[3 * 33]); o.z = pk2(s[4 * 33], s[5 * 33]); o.w = pk2(s[6 * 33], s[7 * 33]);
        int nn = n0 + n; if (nn >= rot_lo && nn < rot_hi) nn = rot_row(nn);
        *(GAS v4u*)(WT + (size_t)(row_off + nn) * ldw + koff + k0 + 8 * c) = o; }
    LDS_WAIT(); asm volatile("" ::: "memory");
}
__device__ __forceinline__ void p0_mod_item(Frame& F, int strip) {
    const int n0 = strip * 32, lane = F.lane, fr = lane & 15, fq = lane >> 4, wave = F.wave;
    f32x4 acc[9][2];
#pragma unroll
    for (int a = 0; a < 9; ++a) { acc[a][0] = (f32x4){0.f, 0.f, 0.f, 0.f}; acc[a][1] = (f32x4){0.f, 0.f, 0.f, 0.f}; }
    for (int ks = 0; ks < 8; ++ks) {
        const int k0 = wave * 256 + ks * 32 + 8 * fq;
        bf16x8 bfr[2];
#pragma unroll
        for (int nt = 0; nt < 2; ++nt) {
            float w[8];
#pragma unroll
            for (int j = 0; j < 8; ++j) w[j] = F.ada_w[(size_t)(k0 + j) * 6144 + n0 + 16 * nt + fr];
            v4u p; p.x = pk2(w[0], w[1]); p.y = pk2(w[2], w[3]); p.z = pk2(w[4], w[5]); p.w = pk2(w[6], w[7]);
            bfr[nt] = __builtin_bit_cast(bf16x8, p);
        }
#pragma unroll
        for (int mt = 0; mt < 9; ++mt) {
            const int row = 16 * mt + fr;
            f32x4 a0 = (f32x4){0.f, 0.f, 0.f, 0.f}, a1 = a0;
            if (row < 132) { const float* cp = (row < 4 ? F.c_p + (size_t)row * DM : F.c_s + (size_t)(row - 4) * DM) + k0; a0 = *(const f32x4*)cp; a1 = *(const f32x4*)(cp + 4); }
            v4u p; p.x = pk2(silu_(a0[0]), silu_(a0[1])); p.y = pk2(silu_(a0[2]), silu_(a0[3])); p.z = pk2(silu_(a1[0]), silu_(a1[1])); p.w = pk2(silu_(a1[2]), silu_(a1[3]));
            const bf16x8 afr = __builtin_bit_cast(bf16x8, p);
            acc[mt][0] = __builtin_amdgcn_mfma_f32_16x16x32_bf16(afr, bfr[0], acc[mt][0], 0, 0, 0);
            acc[mt][1] = __builtin_amdgcn_mfma_f32_16x16x32_bf16(afr, bfr[1], acc[mt][1], 0, 0, 0);
        }
    }
    LAS float* red = (LAS float*)F.lds;
    for (int w = 0; w < 8; ++w) {
        if (wave == w) {
#pragma unroll
            for (int mt = 0; mt < 9; ++mt)
#pragma unroll
                for (int nt = 0; nt < 2; ++nt)
#pragma unroll
                    for (int r = 0; r < 4; ++r) { const int idx = (16 * mt + 4 * fq + r) * 32 + 16 * nt + fr; if (w == 0) red[idx] = acc[mt][nt][r]; else red[idx] += acc[mt][nt][r]; }
        }
        __syncthreads();
    }
    for (int i = F.tid; i < 132 * 32; i += NWAVES * 64) { const int r = i >> 5, cc = i & 31; F.mod[(size_t)r * 6144 + n0 + cc] = red[i] + F.ada_b[n0 + cc]; }
    __syncthreads();
}
__device__ __forceinline__ void rope_entry(int prow, int i, float* cosT, float* sinT) {
    double th = 1.0, bs = 0.8659643233600653;
    for (int e = i; e; e >>= 1) { if (e & 1) th *= bs; bs *= bs; }
    const double t2 = th * th; double c = 1.0, s = th, tc = 1.0, ts = th;
#pragma unroll 1
    for (int n = 1; n <= 12; ++n) { tc *= -t2 / (double)((2 * n - 1) * (2 * n)); c += tc; ts *= -t2 / (double)((2 * n) * (2 * n + 1)); s += ts; }
    const int pos = prow < SEQ ? prow : PAST;
    double rc = 1.0, rs = 0.0, bc = c, bn = s;
    for (int e = pos; e; e >>= 1) { if (e & 1) { const double t = rc * bc - rs * bn; rs = rc * bn + rs * bc; rc = t; } const double t = bc * bc - bn * bn; bn = 2.0 * bc * bn; bc = t; }
    cosT[prow * 64 + i] = (float)rc; sinT[prow * 64 + i] = (float)rs;
}
__device__ __forceinline__ void p0_prologue(Frame& F) {
    if (F.vcu < 192) for (int s = F.vcu; s < 192; s += F.G) p0_mod_item(F, s);
    LAS float* scr = (LAS float*)(F.lds + RING_OFF + F.wave * 16384);
    const int gw = F.vcu * NWAVES + F.wave, NGW = F.G * NWAVES;
    constexpr int I_IN = 32 * 256, I_MG = 32 * 128, I_A = 16 * 64, I_B = 32 * 64, I_O = 32 * 64, I_P = 4 * 8;
    constexpr int NITEMS = I_IN + I_MG + I_A + I_B + I_O + 4 * I_P;
    for (int it = gw; it < NITEMS; it += NGW) {
        int r = it;
        if (r < I_IN) { p0_transpose_item(F.w_in, DIN, F.Wcat, DM, 0, 0, ZC_Q, ZC_V, scr, r, F.lane); continue; } r -= I_IN;
        if (r < I_MG) { p0_transpose_item(F.w_merge, 4096, F.Wcat, DM, DIN, 0, 0, 0, scr, r, F.lane); continue; } r -= I_MG;
        if (r < I_A) { p0_transpose_item(F.w_a, DM, F.Wab, LDY, 0, 0, 0, 0, scr, r, F.lane); continue; } r -= I_A;
        if (r < I_B) { p0_transpose_item(F.w_b, DM, F.Wab, LDY, 0, 1024, 0, 0, scr, r, F.lane); continue; } r -= I_B;
        if (r < I_O) { p0_transpose_item(F.w_out, DM, F.Wout, DM, 0, 0, 0, 0, scr, r, F.lane); continue; } r -= I_O;
        { const int g = r / I_P; p0_transpose_item(F.pool_w + (size_t)g * 65536, 256, F.PoolW, 256, g * 256, 0, 0, 0, scr, r % I_P, F.lane); }
    }
    const int gt = F.vcu * (NWAVES * 64) + F.tid, NGT = F.G * NWAVES * 64;
    for (int e = gt; e < 2049 * 64; e += NGT) rope_entry(e >> 6, e & 63, F.ropec, F.ropes);
}

__device__ __forceinline__ void h_row(Frame& F, const float* xrow, const float* modrow, bf16* orow) {
    const GAS f32x4* xr = (const GAS f32x4*)xrow + F.lane;
    f32x4 v[8]; float s = 0.f;
#pragma unroll
    for (int j = 0; j < 8; ++j) { v[j] = xr[64 * j]; s += (v[j].x * v[j].x + v[j].y * v[j].y) + (v[j].z * v[j].z + v[j].w * v[j].w); }
    const float rstd = 1.0f / sqrtf(wave_sum(s) * (1.0f / DM) + EPS);
    GAS v2u* o8 = (GAS v2u*)orow + F.lane;
#pragma unroll
    for (int j = 0; j < 8; ++j) {
        const int col = 4 * F.lane + 256 * j;
        const f32x4 g = *(const f32x4*)(F.g_pre + col), sh = *(const f32x4*)(modrow + col), sc = *(const f32x4*)(modrow + DM + col);
        const f32x4 o = v[j] * rstd * g * (sc + 1.0f) + sh;
        v2u w; w.x = pk2(o.x, o.y); w.y = pk2(o.z, o.w); o8[64 * j] = w;
    }
}

__device__ __forceinline__ unsigned off_a(unsigned row, unsigned ch) { return 2048u * (row >> 3) + 512u * (ch >> 2) + 64u * (row & 7) + 16u * ((ch & 3) ^ ((row >> 2) & 3)); }
struct RowA { unsigned e, d; };
struct TrA { unsigned t0, t1; };
__device__ __forceinline__ RowA row_addr(unsigned lane) { RowA r; r.e = off_a(lane & 31, lane >> 5); r.d = off_a(lane & 31, 2 + (lane >> 5)) - r.e; return r; }
__device__ __forceinline__ TrA tr_addr(unsigned lane) { const unsigned h = lane >> 5, blk = (lane >> 4) & 1, q = (lane & 15) >> 2, p = lane & 3; TrA t;
    t.t0 = off_a(8 * h + q, 2 * blk + (p >> 1)) + 8 * (p & 1); t.t1 = off_a(8 * h + 4 + q, 2 * blk + (p >> 1)) + 8 * (p & 1); return t; }
__device__ __forceinline__ bf16x8 frag_row(const LAS unsigned char* img, const RowA& ra, int s) { return *(const LAS bf16x8*)(img + (ra.e + (unsigned)(s & 1) * ra.d + 512u * (unsigned)(s >> 1))); }
__device__ __forceinline__ bf16x8 frag_tr(const LAS unsigned char* img, const TrA& ta, int c, int ks) {
    const s16x4 lo = __builtin_bit_cast(s16x4, __builtin_amdgcn_ds_read_tr16_b64_v4i16((LAS s16x4*)(img + ta.t0 + 512 * c + 4096 * ks)));
    const s16x4 hi = __builtin_bit_cast(s16x4, __builtin_amdgcn_ds_read_tr16_b64_v4i16((LAS s16x4*)(img + ta.t1 + 512 * c + 4096 * ks)));
    return __builtin_shufflevector(lo, hi, 0, 1, 2, 3, 4, 5, 6, 7);
}
#define MFMA32(a, b, c) __builtin_amdgcn_mfma_f32_32x32x16_bf16((a), (b), (c), 0, 0, 0)
__device__ __forceinline__ int crow(int reg, int h) { return (reg & 3) + 8 * (reg >> 2) + 4 * h; }

__device__ __forceinline__ void ret_ab_unit(Frame& F, int unit) {
    const int bh = unit >> 1, half = unit & 1, b = bh >> 3, h = bh & 7, lane = F.lane, wave = F.wave, hh = lane >> 5;
    const float lg = lg2gamma(h);
    const float cdec = __builtin_amdgcn_exp2f(128.0f * lg);
    const int ti = wave & 3, tj = (wave >> 2) * 2;
    const TrA ta = tr_addr(lane);
    f32x16 acc[2];
#pragma unroll
    for (int e = 0; e < 16; ++e) { acc[0][e] = 0.f; acc[1][e] = 0.f; }
    const bf16* Zb = F.Z + (size_t)(b * SEQ) * LDZ;
    v4u rk[4], rv[4];
#define AB_LOAD(c) do { _Pragma("unroll") for (int i = 0; i < 4; ++i) { const int n = F.tid + 512 * i, row = n >> 4, ch = n & 15; const bf16* rp = Zb + (size_t)((c) * 128 + row) * LDZ; \
        rk[i] = *(const GAS v4u*)(rp + ZC_K + h * DK + ch * 8); rv[i] = *(const GAS v4u*)(rp + ZC_V + h * DV + half * 128 + ch * 8); } } while (0)
#define AB_STORE(buf) do { _Pragma("unroll") for (int i = 0; i < 4; ++i) { const int n = F.tid + 512 * i, row = n >> 4, ch = n & 15; \
        const float d = __builtin_amdgcn_exp2f((float)(127 - row) * lg); v4u kk = rk[i]; \
        kk.x = pk2(bflo(kk.x) * d, bfhi(kk.x) * d); kk.y = pk2(bflo(kk.y) * d, bfhi(kk.y) * d); kk.z = pk2(bflo(kk.z) * d, bfhi(kk.z) * d); kk.w = pk2(bflo(kk.w) * d, bfhi(kk.w) * d); \
        const unsigned o = (unsigned)(buf) * 65536u + (unsigned)(row >> 5) * 8192u + off_a(row & 31, ch); \
        *(LAS v4u*)(F.lds + o) = kk; *(LAS v4u*)(F.lds + 32768u + o) = rv[i]; } } while (0)
    AB_LOAD(0); AB_STORE(0); __syncthreads();
#pragma unroll 1
    for (int c = 0; c < 16; ++c) {
        if (c + 1 < 16) AB_LOAD(c + 1);
        if (c > 0) {
            bf16* sn = F.SN + ((size_t)(bh * 16 + c) * 256) * 128;
#pragma unroll
            for (int t = 0; t < 2; ++t) { const int dv = half * 128 + 32 * (tj + t) + (lane & 31);
#pragma unroll
                for (int g = 0; g < 4; ++g) { v2u w; w.x = pk2(acc[t][4 * g], acc[t][4 * g + 1]); w.y = pk2(acc[t][4 * g + 2], acc[t][4 * g + 3]);
                    *(GAS v2u*)(sn + (size_t)dv * 128 + 32 * ti + 8 * g + 4 * hh) = w; } }
        }
#pragma unroll
        for (int e = 0; e < 16; ++e) { acc[0][e] *= cdec; acc[1][e] *= cdec; }
        const LAS unsigned char* kb = F.lds + (c & 1) * 65536; const LAS unsigned char* vb = kb + 32768;
#pragma unroll
        for (int kk = 0; kk < 8; ++kk) {
            const bf16x8 a = frag_tr(kb + (kk >> 1) * 8192, ta, ti, kk & 1);
            const bf16x8 b0 = frag_tr(vb + (kk >> 1) * 8192, ta, tj, kk & 1), b1 = frag_tr(vb + (kk >> 1) * 8192, ta, tj + 1, kk & 1);
            acc[0] = MFMA32(a, b0, acc[0]); acc[1] = MFMA32(a, b1, acc[1]);
        }
        if (c + 1 < 16) AB_STORE((c + 1) & 1);
        __syncthreads();
    }
#undef AB_LOAD
#undef AB_STORE
    float* so = F.out + O_RP + (size_t)bh * (DK * DV);
#pragma unroll
    for (int t = 0; t < 2; ++t) { const int dv = half * 128 + 32 * (tj + t) + (lane & 31);
#pragma unroll
        for (int e = 0; e < 16; ++e) so[(size_t)(32 * ti + crow(e, hh)) * DV + dv] = acc[t][e]; }
}

__device__ __forceinline__ void pooled_prompt(Frame& F) {
    const int gt = F.vcu * (NWAVES * 64) + F.tid, NGT = F.G * NWAVES * 64;
    for (int it = gt; it < MP * 128; it += NGT) {
        const int row = it >> 7, q = it & 127, t = row & (SEQ - 1), w = 2 << (q >> 5), cnt = (t + 1 < w) ? t + 1 : w;
        const bf16* p = F.Z + (size_t)row * LDZ + ZC_AX + q * 8;
        float s[8], a[8];
        { const v4u x = *(const GAS v4u*)p; a[0] = bflo(x.x); a[1] = bfhi(x.x); a[2] = bflo(x.y); a[3] = bfhi(x.y); a[4] = bflo(x.z); a[5] = bfhi(x.z); a[6] = bflo(x.w); a[7] = bfhi(x.w); }
#pragma unroll
        for (int e = 0; e < 8; ++e) s[e] = a[e];
        for (int j = 1; j < cnt; ++j) { const v4u x = *(const GAS v4u*)(p - (size_t)j * LDZ);
            s[0] += bflo(x.x); s[1] += bfhi(x.x); s[2] += bflo(x.y); s[3] += bfhi(x.y); s[4] += bflo(x.z); s[5] += bfhi(x.z); s[6] += bflo(x.w); s[7] += bfhi(x.w); }
        const float inv = 1.0f / (float)cnt;
        v4u o; o.x = pk2(s[0] * inv - a[0], s[1] * inv - a[1]); o.y = pk2(s[2] * inv - a[2], s[3] * inv - a[3]); o.z = pk2(s[4] * inv - a[4], s[5] * inv - a[5]); o.w = pk2(s[6] * inv - a[6], s[7] * inv - a[7]);
        *(GAS v4u*)(F.POOLED + (size_t)row * DPOOL + q * 8) = o;
    }
}
__device__ __forceinline__ void pooled_sample(Frame& F) {
    const int gt = F.vcu * (NWAVES * 64) + F.tid, NGT = F.G * NWAVES * 64;
    for (int it = gt; it < MS * 128; it += NGT) {
        const int bs = it >> 7, q = it & 127, w = 2 << (q >> 5);
        const v4u x = *(const GAS v4u*)(F.Z + (size_t)(MP + bs) * LDZ + ZC_AX + q * 8);
        float a[8] = {bflo(x.x), bfhi(x.x), bflo(x.y), bfhi(x.y), bflo(x.z), bfhi(x.z), bflo(x.w), bfhi(x.w)}, s[8];
#pragma unroll
        for (int e = 0; e < 8; ++e) s[e] = a[e];
        const float* sp = F.st_pool + (size_t)bs * 15 * DPOOL + q * 8;
        float* op = F.out + O_PS + (size_t)bs * 15 * DPOOL + q * 8;
#pragma unroll
        for (int i = 14; i >= 0; --i) {
            const f32x4 b0 = *(const f32x4*)(sp + (size_t)i * DPOOL), b1 = *(const f32x4*)(sp + (size_t)i * DPOOL + 4);
            if (i >= 1) { *(f32x4*)(op + (size_t)(i - 1) * DPOOL) = b0; *(f32x4*)(op + (size_t)(i - 1) * DPOOL + 4) = b1; }
            if (15 - i < w) { s[0] += b0.x; s[1] += b0.y; s[2] += b0.z; s[3] += b0.w; s[4] += b1.x; s[5] += b1.y; s[6] += b1.z; s[7] += b1.w; }
        }
        const float inv = 1.0f / (float)w;
        v4u o; o.x = pk2(s[0] * inv - a[0], s[1] * inv - a[1]); o.y = pk2(s[2] * inv - a[2], s[3] * inv - a[3]); o.z = pk2(s[4] * inv - a[4], s[5] * inv - a[5]); o.w = pk2(s[6] * inv - a[6], s[7] * inv - a[7]);
        *(GAS v4u*)(F.POOLED + (size_t)(MP + bs) * DPOOL + q * 8) = o;
    }
}
__device__ __forceinline__ void ret_sample_item(Frame& F, int item) {
    const int bs = item >> 3, h = item & 7, lane = F.lane, wave = F.wave, row = MP + bs;
    const float gam = 1.0f - __builtin_amdgcn_exp2f((float)(-5 - h));
    const bf16* zr = F.Z + (size_t)row * LDZ;
    f32x4 v4; { const v2u x = *(const GAS v2u*)(zr + ZC_V + h * DV + 4 * lane); v4 = (f32x4){bflo(x.x), bfhi(x.x), bflo(x.y), bfhi(x.y)}; }
    const float* s0 = F.st_ret + ((size_t)(bs * NH + h) * DK) * DV + 4 * lane;
    float* s1 = F.out + O_RS + ((size_t)(bs * NH + h) * DK) * DV + 4 * lane;
    f32x4 o4 = (f32x4){0.f, 0.f, 0.f, 0.f};
    f32x4 sv[16];
#pragma unroll
    for (int r = 0; r < 16; ++r) sv[r] = *(const f32x4*)(s0 + (size_t)(16 * wave + r) * DV);
#pragma unroll
    for (int r = 0; r < 16; ++r) {
        const int dk = 16 * wave + r;
        const float qd = bf1(zr[ZC_Q + h * DK + dk]), kd = bf1(zr[ZC_K + h * DK + dk]);
        const f32x4 sn = sv[r] * gam + v4 * kd;
        *(f32x4*)(s1 + (size_t)dk * DV) = sn;
        o4 += sn * qd;
    }
    LAS float* part = (LAS float*)(F.lds);
    *(LAS f32x4*)(part + wave * 256 + 4 * lane) = o4;
    __syncthreads();
    if (wave == 0) {
        f32x4 o = *(LAS f32x4*)(part + 4 * lane);
#pragma unroll
        for (int w = 1; w < 8; ++w) o += *(LAS f32x4*)(part + w * 256 + 4 * lane);
        const float mu = wave_sum((o.x + o.y) + (o.z + o.w)) * (1.0f / DV);
        o = o - mu;
        const float var = wave_sum((o.x * o.x + o.y * o.y) + (o.z * o.z + o.w * o.w)) * (1.0f / DV);
        const float rstd = 1.0f / sqrtf(var + EPS);
        const f32x4 g = *(const f32x4*)(F.gn_g + h * DV + 4 * lane);
        const v2u x = *(const GAS v2u*)(zr + ZC_BG + h * DV + 4 * lane);
        o = o * rstd * g; o.x *= bflo(x.x); o.y *= bfhi(x.x); o.z *= bflo(x.y); o.w *= bfhi(x.y);
        v2u wv; wv.x = pk2(o.x, o.y); wv.y = pk2(o.z, o.w);
        *(GAS v2u*)(F.YAB + (size_t)row * LDY + 1024 + h * DV + 4 * lane) = wv;
    }
    __syncthreads();
}

__device__ __forceinline__ void ret_c_unit(Frame& F, int unit) {
    const int bh = unit >> 4, c = unit & 15, b = bh >> 3, h = bh & 7, lane = F.lane, wave = F.wave, hh = lane >> 5, l31 = lane & 31;
    const float lg = lg2gamma(h);
    const int ti = wave & 3, wh = wave >> 2;
    const RowA ra = row_addr(lane); const TrA ta = tr_addr(lane);
    const int rowbase = b * SEQ + c * 128;
    const bf16* Zb = F.Z + (size_t)rowbase * LDZ;
    LAS unsigned char* Qi = F.lds; LAS unsigned char* Ki = F.lds + 32768; LAS unsigned char* Vi = F.lds + 65536;
#pragma unroll
    for (int i = 0; i < 4; ++i) { const int n = F.tid + 512 * i, row = n >> 4, ch = n & 15; const bf16* rp = Zb + (size_t)row * LDZ;
        const v4u q = *(const GAS v4u*)(rp + ZC_Q + h * DK + ch * 8), k = *(const GAS v4u*)(rp + ZC_K + h * DK + ch * 8);
        const unsigned o = (unsigned)(row >> 5) * 8192u + off_a(row & 31, ch);
        *(LAS v4u*)(Qi + o) = q; *(LAS v4u*)(Ki + o) = k; }
#pragma unroll
    for (int i = 0; i < 8; ++i) { const int n = F.tid + 512 * i, row = n >> 5, ch = n & 31;
        const v4u v = *(const GAS v4u*)(Zb + (size_t)row * LDZ + ZC_V + h * DV + ch * 8);
        *(LAS v4u*)(Vi + (unsigned)((row >> 5) * 2 + (ch >> 4)) * 8192u + off_a(row & 31, ch & 15)) = v; }
    __syncthreads();
    f32x16 X[2];
#pragma unroll
    for (int t = 0; t < 2; ++t) {
        const int sj = 2 * wh + t;
#pragma unroll
        for (int e = 0; e < 16; ++e) X[t][e] = 0.f;
        if (sj <= ti) {
#pragma unroll
            for (int ks = 0; ks < 8; ++ks) X[t] = MFMA32(frag_row(Ki + sj * 8192, ra, ks), frag_row(Qi + ti * 8192, ra, ks), X[t]);
        }
    }
    __syncthreads();
#pragma unroll
    for (int t = 0; t < 2; ++t) {
        const int sj = 2 * wh + t;
        if (sj <= ti) {
            const int tt = 32 * ti + l31;
#pragma unroll
            for (int g = 0; g < 4; ++g) {
                float p[4];
#pragma unroll
                for (int e = 0; e < 4; ++e) { const int s = 32 * sj + 8 * g + 4 * hh + e; const float f = __builtin_amdgcn_exp2f(-(float)(s + 1) * lg); p[e] = (s <= tt) ? X[t][4 * g + e] * f : 0.f; }
                v2u w; w.x = pk2(p[0], p[1]); w.y = pk2(p[2], p[3]);
                *(LAS v2u*)(Ki + ti * 8192 + off_a(l31, 4 * sj + g) + 8 * hh) = w;
            }
        }
    }
    __syncthreads();
    f32x16 O[4];
#pragma unroll
    for (int j = 0; j < 4; ++j)
#pragma unroll
        for (int e = 0; e < 16; ++e) O[j][e] = 0.f;
    for (int kk = 0; kk < 2 * (ti + 1); ++kk) {
        const bf16x8 a = frag_row(Ki + ti * 8192, ra, kk);
        const LAS unsigned char* vimg = Vi + ((kk >> 1) * 2 + wh) * 8192;
#pragma unroll
        for (int j = 0; j < 4; ++j) O[j] = MFMA32(a, frag_tr(vimg, ta, j, kk & 1), O[j]);
    }
    if (c > 0) {
        const bf16* sn = F.SN + ((size_t)(bh * 16 + c) * 256) * 128;
#pragma unroll
        for (int ks = 0; ks < 8; ++ks) {
            const bf16x8 a = frag_row(Qi + ti * 8192, ra, ks);
#pragma unroll
            for (int j = 0; j < 4; ++j) {
                const int dv = 128 * wh + 32 * j + l31;
                const bf16x8 bb = __builtin_bit_cast(bf16x8, *(const GAS v4u*)(sn + (size_t)dv * 128 + 16 * ks + 8 * hh));
                O[j] = MFMA32(a, bb, O[j]);
            }
            if (ks & 1) asm volatile("" ::: "memory");
        }
    }
    LAS float* st = (LAS float*)(F.lds + STAT_OFF);
    float mu[16], rs[16];
#pragma unroll
    for (int e = 0; e < 16; ++e) {
        const float f = __builtin_amdgcn_exp2f((float)(crow(e, hh) + 32 * ti + 1) * lg);
        float s = 0.f;
#pragma unroll
        for (int j = 0; j < 4; ++j) { O[j][e] *= f; s += O[j][e]; }
        s += __shfl_xor(s, 1); s += __shfl_xor(s, 2); s += __shfl_xor(s, 4); s += __shfl_xor(s, 8); s += __shfl_xor(s, 16);
        if (l31 == 0) st[(32 * ti + crow(e, hh)) * 2 + wh] = s;
    }
    __syncthreads();
#pragma unroll
    for (int e = 0; e < 16; ++e) { const int r = 32 * ti + crow(e, hh); mu[e] = (st[r * 2] + st[r * 2 + 1]) * (1.0f / DV); }
#pragma unroll
    for (int e = 0; e < 16; ++e) {
        float s = 0.f;
#pragma unroll
        for (int j = 0; j < 4; ++j) { O[j][e] -= mu[e]; s += O[j][e] * O[j][e]; }
        s += __shfl_xor(s, 1); s += __shfl_xor(s, 2); s += __shfl_xor(s, 4); s += __shfl_xor(s, 8); s += __shfl_xor(s, 16);
        if (l31 == 0) st[256 + (32 * ti + crow(e, hh)) * 2 + wh] = s;
    }
    __syncthreads();
#pragma unroll
    for (int e = 0; e < 16; ++e) { const int r = 32 * ti + crow(e, hh); rs[e] = 1.0f / sqrtf((st[256 + r * 2] + st[256 + r * 2 + 1]) * (1.0f / DV) + EPS); }
    float gn[4];
#pragma unroll
    for (int j = 0; j < 4; ++j) gn[j] = F.gn_g[h * DV + 128 * wh + 32 * j + l31];
#pragma unroll
    for (int e = 0; e < 16; ++e) {
        const int row = rowbase + 32 * ti + crow(e, hh);
        const bf16* zr = F.Z + (size_t)row * LDZ + ZC_BG + h * DV + 128 * wh + l31;
        bf16* yr = F.YAB + (size_t)row * LDY + 1024 + h * DV + 128 * wh + l31;
#pragma unroll
        for (int j = 0; j < 4; ++j) yr[32 * j] = (bf16)f2bf(O[j][e] * rs[e] * gn[j] * bf1(zr[32 * j]));
        asm volatile("" ::: "memory");
    }
    __syncthreads();
}

__device__ __forceinline__ void final_row(Frame& F, const float* xrow, float* yrow, const float* ssrow, const float* gaterow) {
    float s = (F.lane < 32) ? ssrow[F.lane] : 0.f;
    const float rstd = 1.0f / sqrtf(wave_sum(s) * (1.0f / DM) + EPS);
#pragma unroll
    for (int j = 0; j < 8; ++j) {
        const int col = 4 * F.lane + 256 * j;
        const f32x4 x = *(const f32x4*)(xrow + col), o = *(const f32x4*)(yrow + col), g = *(const f32x4*)(F.g_post + col), gt = *(const f32x4*)(gaterow + col);
        *(f32x4*)(yrow + col) = x + gt * (o * rstd * g);
    }
}

struct Args { const float* in[19]; float* out; unsigned char* ws; int ph_lo, ph_hi; };
constexpr int N_PHASES = 8;
__global__ void __launch_bounds__(NWAVES * 64, 2) hybrid_fwd(Args args) {
    extern __shared__ __attribute__((aligned(16))) unsigned char lds[];
    Frame F;
    F.lds = (LAS unsigned char*)lds;
    F.MISC = (volatile LAS unsigned*)(F.lds + MISC_OFF);
    F.wave = __builtin_amdgcn_readfirstlane((int)threadIdx.x >> 6); F.lane = fresh_lane(); F.tid = F.wave * 64 + F.lane;
    F.G = gridDim.x; { const int bx = blockIdx.x; F.vcu = (F.G % 8 == 0) ? (bx % 8) * (F.G / 8) + bx / 8 : bx; }
    unsigned char* ws = args.ws;
    F.ctl = (gu32*)(ws + WS_CTL);
    F.x_p = args.in[0]; F.x_s = args.in[1]; F.st_pool = args.in[2]; F.st_ret = args.in[3]; F.c_p = args.in[4]; F.c_s = args.in[5]; F.ada_w = args.in[6]; F.ada_b = args.in[7];
    F.g_pre = args.in[8]; F.g_post = args.in[9]; F.w_in = args.in[10]; F.pool_w = args.in[11]; F.pool_scale = args.in[12]; F.gn_g = args.in[13]; F.w_a = args.in[14]; F.w_b = args.in[15];
    F.w_merge = args.in[16]; F.b_merge = args.in[17]; F.w_out = args.in[18]; F.out = args.out;
    F.ropec = (float*)(ws + WS_ROPE); F.ropes = F.ropec + 2049 * 64; F.mod = (float*)(ws + WS_MOD); F.ss = (float*)(ws + WS_SS);
    F.Wcat = (bf16*)(ws + WS_WCAT); F.Wab = (bf16*)(ws + WS_WAB); F.Wout = (bf16*)(ws + WS_WOUT); F.PoolW = (bf16*)(ws + WS_POOLW);
    F.H = (bf16*)(ws + WS_H); F.Z = (bf16*)(ws + WS_Z); F.YAB = (bf16*)(ws + WS_YAB); F.POOLED = (bf16*)(ws + WS_POOLED); F.SN = (bf16*)(ws + WS_SN); F.MB = (bf16*)(ws + WS_MB);
    for (int u = F.tid; u < (LDS_BYTES - LDSCTL_OFF) / 4; u += NWAVES * 64) ((LAS unsigned*)(F.lds + LDSCTL_OFF))[u] = 0u;
    __syncthreads();
    const int lo = args.ph_lo, hi = args.ph_hi;
    XcdBarrier bar; bar.bar = (unsigned*)(F.ctl + CW_BAR); bar.x = 0; bar.st = nullptr; bar.wave = F.wave;
    if (hi - lo > 1) bar = xcd_barrier_post((unsigned*)(F.ctl + CW_BAR), F.MISC + 8, F.wave);
#define IN(k) (lo <= (k) && (k) < hi)
#define PHASE_BEGIN() do { F.lane = fresh_lane(); F.tid = F.wave * 64 + F.lane; } while (0)
#define SEAM(k) do { if (IN(k) && IN((k) + 1)) xcd_barrier(bar); } while (0)
    const int gw = F.vcu * NWAVES + F.wave, NGW = F.G * NWAVES;

    if (((PH_MASK >> 0) & 1) && IN(0)) { PHASE_BEGIN(); p0_prologue(F); } SEAM(0);

    if (((PH_MASK >> 1) & 1) && IN(1)) { PHASE_BEGIN();
        for (int m = gw; m < MP + MS; m += NGW) {
            const float* xr = m < MP ? F.x_p + (size_t)m * DM : F.x_s + (size_t)(m - MP) * DM;
            const float* mr = F.mod + (size_t)(m < MP ? (m >> 11) : 4 + (m - MP)) * 6144;
            h_row(F, xr, mr, F.H + (size_t)m * DM);
        }
    } SEAM(1);

    if (((PH_MASK >> 2) & 1) && IN(2)) { PHASE_BEGIN();
        pg8::Gemm g{F.H, F.Wcat, DM, DM, DM, 0}; pg8::StaticOrder S; S.init(MT, LDZ, F.G, (int)blockIdx.x);
        EpiZ E{F.Z, F.b_merge, F.ropec, F.ropes, F.out + O_PP, F.out + O_PS};
        pg8::gemm_phase<EpiZ, pg8::StaticOrder, true, true>(F.lds + RING_OFF, g, S, E, F.tid);
    } SEAM(2);

    if (((PH_MASK >> 3) & 1) && IN(3)) { PHASE_BEGIN();
        for (int u = F.vcu; u < 64; u += F.G) ret_ab_unit(F, u);
        PHASE_BEGIN();
        pooled_prompt(F);
        pooled_sample(F);
        PHASE_BEGIN();
        for (int it = F.vcu; it < MS * NH; it += F.G) ret_sample_item(F, it);
    } SEAM(3);

    if (((PH_MASK >> 4) & 1) && IN(4)) { PHASE_BEGIN();
        for (int u = F.vcu; u < 512; u += F.G) ret_c_unit(F, u);
        PHASE_BEGIN();
        pg8::Gemm g{F.POOLED, F.PoolW, 256, DPOOL, 256, 512}; pg8::StaticOrder S; S.init(MT, DPOOL, F.G, (int)blockIdx.x);
        EpiPool E{F.YAB, F.Z, F.pool_scale};
        pg8::gemm_phase<EpiPool, pg8::StaticOrder, true, true>(F.lds + RING_OFF, g, S, E, F.tid);
    } SEAM(4);

    if (((PH_MASK >> 5) & 1) && IN(5)) { PHASE_BEGIN();
        pg8::Gemm g{F.YAB, F.Wab, LDY, LDY, LDY, 0}; pg8::StaticOrder S; S.init(MT, DM, F.G, (int)blockIdx.x);
        EpiMerge E{F.MB, F.Z};
        pg8::gemm_phase<EpiMerge, pg8::StaticOrder, true, true>(F.lds + RING_OFF, g, S, E, F.tid);
    } SEAM(5);

    if (((PH_MASK >> 6) & 1) && IN(6)) { PHASE_BEGIN();
        pg8::Gemm g{F.MB, F.Wout, DM, DM, DM, 0}; pg8::StaticOrder S; S.init(MT, DM, F.G, (int)blockIdx.x);
        EpiOut E{F.out, F.ss};
        pg8::gemm_phase<EpiOut, pg8::StaticOrder, true, true>(F.lds + RING_OFF, g, S, E, F.tid);
    } SEAM(6);

    if (((PH_MASK >> 7) & 1) && IN(7)) { PHASE_BEGIN();
        for (int m = gw; m < MP + MS; m += NGW) {
            const float* xr = m < MP ? F.x_p + (size_t)m * DM : F.x_s + (size_t)(m - MP) * DM;
            float* yr = F.out + (m < MP ? O_YP + (size_t)m * DM : O_YS + (size_t)(m - MP) * DM);
            const float* gr = F.mod + (size_t)(m < MP ? (m >> 11) : 4 + (m - MP)) * 6144 + 2 * DM;
            final_row(F, xr, yr, F.ss + (size_t)m * 32, gr);
        }
    }
#undef IN
#undef SEAM
}

extern "C" void kernel_launch(void* const* d_in, const int* in_sizes, int n_in, void* d_out, int out_size, void* d_ws, size_t ws_size, hipStream_t stream) {
    static int grid = 0;
    if (grid == 0) {
        if (n_in != 19 || ws_size < WS_END) { fprintf(stderr, "kernel_launch: unexpected inputs (n_in %d, ws %zu)\n", n_in, ws_size); grid = -1; return; }
        int dev = 0, cus = 0, per_cu = 0;
        if (hipGetDevice(&dev) != hipSuccess || hipDeviceGetAttribute(&cus, hipDeviceAttributeMultiprocessorCount, dev) != hipSuccess) { grid = -1; return; }
        if (hipFuncSetAttribute((const void*)hybrid_fwd, hipFuncAttributeMaxDynamicSharedMemorySize, LDS_BYTES) != hipSuccess) { fprintf(stderr, "kernel_launch: hipFuncSetAttribute failed\n"); grid = -1; return; }
        if (hipOccupancyMaxActiveBlocksPerMultiprocessor(&per_cu, (const void*)hybrid_fwd, NWAVES * 64, LDS_BYTES) != hipSuccess || per_cu < 1) { fprintf(stderr, "kernel_launch: occupancy query says %d\n", per_cu); per_cu = 1; }
        (void)hipGetLastError();
        grid = cus;
    }
    if (grid < 0) return;
    (void)hipMemsetAsync((char*)d_ws + WS_CTL, 0, CTL_ZERO_BYTES, stream);
    Args a{};
    for (int i = 0; i < 19; ++i) a.in[i] = (const float*)d_in[i];
    a.out = (float*)d_out; a.ws = (unsigned char*)d_ws;
    if (MK_N_LAUNCHES == 1) { a.ph_lo = 0; a.ph_hi = N_PHASES; hipLaunchKernelGGL(hybrid_fwd, dim3(grid), dim3(NWAVES * 64), LDS_BYTES, stream, a); }
    else for (int p = 0; p < N_PHASES; ++p) { a.ph_lo = p; a.ph_hi = p + 1; hipLaunchKernelGGL(hybrid_fwd, dim3(grid), dim3(NWAVES * 64), LDS_BYTES, stream, a); }
}
```

```cpp
#include <hip/hip_runtime.h>
#include <cstdio>
#include <cstdint>

#ifndef PH_MASK
#define PH_MASK 255
#endif
#ifndef MK_N_LAUNCHES
#define MK_N_LAUNCHES 1
#endif

namespace pg8 {
#define PG8_LAS __attribute__((address_space(3)))
typedef unsigned short bf16_t;
typedef short bf16x8 __attribute__((ext_vector_type(8)));
typedef float f32x4 __attribute__((ext_vector_type(4)));
typedef unsigned u32x4 __attribute__((ext_vector_type(4)));
typedef unsigned u32x2 __attribute__((ext_vector_type(2)));
constexpr int BM = 256, BK = 64, HALF = 128, HTB = HALF * BK * 2  , STAGE_BYTES = 8 * HTB, NXCD = 8, WGM = 8;

__host__ __device__ __forceinline__ int lds_byte(int r, int c) { const int st = (r >> 4) * 2 + (c >> 5), rr = r & 15, cc = c & 31, ob = rr * 64 + cc * 2; return st * 1024 + (ob ^ (((ob >> 9) & 1) << 5)); }
__host__ __device__ __forceinline__ void stage_rc(int b, int& R, int& C) { const int st = b / 1024, sb = b % 1024, swz = sb ^ (((sb >> 9) & 1) << 5); R = (st >> 1) * 16 + swz / 64; C = (st & 1) * 32 + (swz % 64) / 2; }
__host__ __device__ __forceinline__ int perm32(int rho) { const int n = rho >> 4, i = rho & 15; return 8 * (i >> 2) + 4 * n + (i & 3); }

struct Unit { int pm, pn; };
struct Gemm { const bf16_t* A; const bf16_t* Bt; int K, lda, ldb, a_pn_bytes; };

struct StaticOrder {
    int nM, nN, nwg, G, c;
    __host__ __device__ void init(int M, int N, int G_, int c_) { nM = M / BM; nN = N / BM; nwg = nM * nN; G = G_; c = c_; }
    __host__ __device__ bool next(int i, Unit& u) const {
        const long L = (long)i * G + c; if (L >= nwg) return false;
        int wgid = (int)L; { const int q = nwg / NXCD, r = nwg % NXCD, xcd = wgid % NXCD, off = wgid / NXCD; wgid = (xcd < r ? xcd * (q + 1) : r * (q + 1) + (xcd - r) * q) + off; }
        const int nig = WGM * nN, gid = wgid / nig, fm = gid * WGM, gsz = (nM - fm) < WGM ? (nM - fm) : WGM;
        u.pm = fm + ((wgid % nig) % gsz); u.pn = (wgid % nig) / gsz; return true;
    }
};

__device__ __forceinline__ unsigned cvt_pk_bf16(float lo, float hi) { unsigned r; asm volatile("v_cvt_pk_bf16_f32 %0, %1, %2" : "=v"(r) : "v"(lo), "v"(hi)); return r; }
__device__ __forceinline__ float bf_lo(unsigned w) { return __uint_as_float(w << 16); }
__device__ __forceinline__ float bf_hi(unsigned w) { return __uint_as_float(w & 0xffff0000u); }
__device__ __forceinline__ float sigmoidf_(float v) { return __builtin_amdgcn_rcpf(1.0f + __builtin_amdgcn_exp2f(-1.4426950408889634f * v)); }


template <class Epi, class Sched, bool ALIGN_EPI = false, bool SP2 = false>
__device__ __forceinline__ void gemm_phase(PG8_LAS unsigned char* lds, const Gemm g, const Sched& S, const Epi& E, const int tid) {
    const int wid = __builtin_amdgcn_readfirstlane(tid >> 6), lane = tid & 63, wr = wid >> 2, wc = wid & 3, fr = lane & 15, fq = lane >> 4;
    const int K = g.K, nt = K / BK;
    unsigned voffA[2], voffB[2];
#pragma unroll
    for (int i = 0; i < 2; ++i) { int R, C; stage_rc(tid * 16 + i * 8192, R, C); const int Rb = Epi::PERM ? ((R & ~31) + perm32(R & 31)) : R;
        voffA[i] = (unsigned)(R * g.lda + C) * 2u; voffB[i] = (unsigned)(Rb * g.ldb + C) * 2u; }
    const size_t kstep = (size_t)(BK * 2);
    const size_t hstepA = (size_t)HALF * g.lda * 2, hstepB = (size_t)HALF * g.ldb * 2;
    const size_t tstepA = 2 * hstepA, tstepB = 2 * hstepB;
    const unsigned ldsw = (unsigned)wid * 1024u;
    const int aoff = lds_byte(wr * 64 + fr, fq * 8), boff = lds_byte(wc * 32 + fr, fq * 8);
#define PG8_SA(b, h) (((b) * 2 + (h)) * HTB)
#define PG8_SB(b, h) ((4 + (b) * 2 + (h)) * HTB)
#define PG8_STAGE(bufoff, gbase, voff) do { _Pragma("unroll") for (int _i = 0; _i < 2; ++_i) \
        __builtin_amdgcn_global_load_lds((const unsigned*)((const char*)(gbase) + (voff)[_i]), (PG8_LAS unsigned*)(lds + (bufoff) + ldsw + _i * 8192), 16, 0, 0); } while (0)
#define PG8_LDA(dst, b, h) do { _Pragma("unroll") for (int m = 0; m < 4; ++m) _Pragma("unroll") for (int k = 0; k < 2; ++k) dst[m][k] = *(const PG8_LAS bf16x8*)(lds + PG8_SA(b, h) + aoff + m * 2048 + k * 1024); } while (0)
#define PG8_LDB(dst, b, h) do { _Pragma("unroll") for (int n = 0; n < 2; ++n) _Pragma("unroll") for (int k = 0; k < 2; ++k) dst[n][k] = *(const PG8_LAS bf16x8*)(lds + PG8_SB(b, h) + boff + n * 2048 + k * 1024); } while (0)
#define PG8_MMA(ai, bj, At, Bt) do { __builtin_amdgcn_s_setprio(1); _Pragma("unroll") for (int m = 0; m < 4; ++m) _Pragma("unroll") for (int n = 0; n < 2; ++n) _Pragma("unroll") for (int k = 0; k < 2; ++k) \
        acc[ai][bj][m][n] = __builtin_amdgcn_mfma_f32_16x16x32_bf16(Bt[n][k], At[m][k], acc[ai][bj][m][n], 0, 0, 0); __builtin_amdgcn_s_setprio(0); } while (0)
#define PG8_WAIT_V(n) asm volatile("s_waitcnt vmcnt(" #n ")" ::: "memory")
#define PG8_WAIT_L(n) asm volatile("s_waitcnt lgkmcnt(" #n ")" ::: "memory")
#define PG8_BAR __builtin_amdgcn_s_barrier()
#define PG8_SCHED __builtin_amdgcn_sched_barrier(0)
    Unit cur, nxt; int ui = 0;
    if (!S.next(0, cur)) return;
    f32x4 acc[2][2][4][2];
#pragma unroll
    for (int a = 0; a < 2; ++a)
#pragma unroll
        for (int b = 0; b < 2; ++b)
#pragma unroll
            for (int m = 0; m < 4; ++m)
#pragma unroll
                for (int n = 0; n < 2; ++n) acc[a][b][m][n] = (f32x4){0.f, 0.f, 0.f, 0.f};
    bf16x8 At[4][2], B0[2][2], B1[2][2];
    const char* cA = (const char*)g.A + (size_t)cur.pm * tstepA + (size_t)cur.pn * g.a_pn_bytes; const char* cB = (const char*)g.Bt + (size_t)cur.pn * tstepB;
    if constexpr (SP2) {
        PG8_STAGE(PG8_SB(0, 0), cB, voffB); PG8_STAGE(PG8_SB(0, 1), cB + hstepB, voffB); PG8_STAGE(PG8_SA(0, 0), cA, voffA); PG8_STAGE(PG8_SA(0, 1), cA + hstepA, voffA);
        if (wr == 1) PG8_BAR;
        PG8_WAIT_V(2); PG8_BAR;
        PG8_STAGE(PG8_SB(1, 0), cB + kstep, voffB); PG8_STAGE(PG8_SA(1, 0), cA + kstep, voffA); PG8_STAGE(PG8_SB(1, 1), cB + hstepB + kstep, voffB);
        PG8_WAIT_V(6); PG8_BAR;
    } else {
        PG8_STAGE(PG8_SB(0, 0), cB, voffB); PG8_STAGE(PG8_SA(0, 0), cA, voffA); PG8_STAGE(PG8_SB(0, 1), cB + hstepB, voffB); PG8_STAGE(PG8_SA(0, 1), cA + hstepA, voffA);
        if (wr == 1) PG8_BAR;
        PG8_WAIT_V(4); PG8_BAR;
        PG8_STAGE(PG8_SB(1, 0), cB + kstep, voffB); PG8_STAGE(PG8_SA(1, 0), cA + kstep, voffA); PG8_STAGE(PG8_SB(1, 1), cB + hstepB + kstep, voffB);
        PG8_WAIT_V(6); PG8_BAR;
    }
    for (;;) {
        const bool has_next = S.next(ui + 1, nxt);
        const char* nA = has_next ? (const char*)g.A + (size_t)nxt.pm * tstepA + (size_t)nxt.pn * g.a_pn_bytes : cA; const char* nB = has_next ? (const char*)g.Bt + (size_t)nxt.pn * tstepB : cB;
        for (int t = 0; t < nt; t += 2) {
            if constexpr (Epi::MID_T > 0) { if (t == Epi::MID_T) {
#pragma unroll
                for (int ai = 0; ai < 2; ++ai)
#pragma unroll
                    for (int bj = 0; bj < 2; ++bj) E.template mid<4>(acc[ai][bj], cur.pm * BM + ai * HALF + wr * 64 + fr, cur.pn * BM + bj * HALF + wc * 32, fq); } }
            const bool last = (t == nt - 2);
            const char* a1 = cA + (size_t)(t + 1) * kstep;
            const char* a2 = last ? nA : cA + (size_t)(t + 2) * kstep; const char* b2 = last ? nB : cB + (size_t)(t + 2) * kstep;
            const char* a3 = a2 + kstep; const char* b3 = b2 + kstep;
            if constexpr (SP2) {
            PG8_LDB(B0, 0, 0); PG8_LDB(B1, 0, 1); PG8_SCHED; PG8_LDA(At, 0, 0); PG8_STAGE(PG8_SA(1, 1), a1 + hstepA, voffA);
            PG8_WAIT_V(8); PG8_WAIT_L(0); PG8_BAR; PG8_MMA(0, 0, At, B0); PG8_MMA(0, 1, At, B1); PG8_BAR; PG8_SCHED;
            PG8_LDA(At, 0, 1); PG8_STAGE(PG8_SB(0, 0), b2, voffB); PG8_STAGE(PG8_SB(0, 1), b2 + hstepB, voffB); PG8_STAGE(PG8_SA(0, 0), a2, voffA);
            PG8_WAIT_V(8); PG8_WAIT_L(0); PG8_BAR; PG8_MMA(1, 0, At, B0); PG8_MMA(1, 1, At, B1); PG8_BAR; PG8_SCHED;
            PG8_LDB(B0, 1, 0); PG8_LDB(B1, 1, 1); PG8_SCHED; PG8_LDA(At, 1, 0); PG8_STAGE(PG8_SA(0, 1), a2 + hstepA, voffA);
            PG8_WAIT_V(8); PG8_WAIT_L(0); PG8_BAR; PG8_MMA(0, 0, At, B0); PG8_MMA(0, 1, At, B1); PG8_BAR; PG8_SCHED;
            PG8_LDA(At, 1, 1); PG8_STAGE(PG8_SB(1, 0), b3, voffB); PG8_STAGE(PG8_SB(1, 1), b3 + hstepB, voffB); PG8_STAGE(PG8_SA(1, 0), a3, voffA);
            PG8_WAIT_V(8); PG8_WAIT_L(0); PG8_BAR; PG8_MMA(1, 0, At, B0); PG8_MMA(1, 1, At, B1); PG8_BAR; PG8_SCHED;
            } else {
            PG8_LDB(B0, 0, 0); PG8_SCHED; PG8_LDA(At, 0, 0); PG8_STAGE(PG8_SA(1, 1), a1 + hstepA, voffA);
            PG8_WAIT_L(8); PG8_BAR; PG8_WAIT_L(0); PG8_MMA(0, 0, At, B0); PG8_BAR; PG8_SCHED;
            PG8_LDB(B1, 0, 1); PG8_STAGE(PG8_SB(0, 0), b2, voffB);
            PG8_BAR; PG8_WAIT_L(0); PG8_MMA(0, 1, At, B1); PG8_BAR;
            PG8_LDA(At, 0, 1); PG8_STAGE(PG8_SA(0, 0), a2, voffA);
            PG8_BAR; PG8_WAIT_L(0); PG8_MMA(1, 0, At, B0); PG8_BAR; PG8_SCHED;
            PG8_STAGE(PG8_SB(0, 1), b2 + hstepB, voffB);
            PG8_WAIT_V(6); PG8_BAR; PG8_MMA(1, 1, At, B1); PG8_BAR;
            PG8_LDB(B0, 1, 0); PG8_SCHED; PG8_LDA(At, 1, 0); PG8_STAGE(PG8_SA(0, 1), a2 + hstepA, voffA);
            PG8_WAIT_L(8); PG8_BAR; PG8_WAIT_L(0); PG8_MMA(0, 0, At, B0); PG8_BAR; PG8_SCHED;
            PG8_LDB(B1, 1, 1); PG8_STAGE(PG8_SB(1, 0), b3, voffB);
            PG8_BAR; PG8_WAIT_L(0); PG8_MMA(0, 1, At, B1); PG8_BAR;
            PG8_LDA(At, 1, 1); PG8_STAGE(PG8_SA(1, 0), a3, voffA);
            PG8_BAR; PG8_WAIT_L(0); PG8_MMA(1, 0, At, B0); PG8_BAR; PG8_SCHED;
            PG8_STAGE(PG8_SB(1, 1), b3 + hstepB, voffB);
            PG8_WAIT_V(6); PG8_BAR; PG8_MMA(1, 1, At, B1); PG8_BAR;
            }
        }
        if constexpr (ALIGN_EPI) { if (wr == 0) PG8_BAR; }
#pragma unroll
        for (int ai = 0; ai < 2; ++ai)
#pragma unroll
            for (int bj = 0; bj < 2; ++bj) E.template core<4>(acc[ai][bj], cur.pm * BM + ai * HALF + wr * 64 + fr, cur.pn * BM + bj * HALF + wc * 32, fq);
        if (!has_next) break;
#pragma unroll
        for (int a = 0; a < 2; ++a)
#pragma unroll
            for (int b = 0; b < 2; ++b)
#pragma unroll
                for (int m = 0; m < 4; ++m)
#pragma unroll
                    for (int n = 0; n < 2; ++n) acc[a][b][m][n] = (f32x4){0.f, 0.f, 0.f, 0.f};
        cur = nxt; cA = nA; cB = nB; ++ui;
        if constexpr (ALIGN_EPI) { if (wr == 1) PG8_BAR; }
    }
    PG8_WAIT_V(0);
    if constexpr (!ALIGN_EPI) { if (wr == 0) PG8_BAR; }
    PG8_BAR;
#undef PG8_SA
#undef PG8_SB
#undef PG8_STAGE
#undef PG8_LDA
#undef PG8_LDB
#undef PG8_MMA
#undef PG8_WAIT_V
#undef PG8_WAIT_L
#undef PG8_BAR
#undef PG8_SCHED
}

template <class Epi>
__device__ __forceinline__ void sgemm_phase(PG8_LAS unsigned char* lds, const Gemm g, const int row_base, const int n_units, const int first, const int stride, const Epi& E, const int tid) {
    const int wid = __builtin_amdgcn_readfirstlane(tid >> 6), lane = tid & 63, wr = wid >> 1, wc = wid & 1, fr = lane & 15, fq = lane >> 4;
    const int nt = g.K / BK;
    unsigned voffA[2], voffB;
#pragma unroll
    for (int i = 0; i < 2; ++i) { int R, C; stage_rc(tid * 16 + i * 8192, R, C); voffA[i] = (unsigned)(R * g.lda + C) * 2u;
        if (i == 0) { const int Rb = Epi::PERM ? ((R & ~31) + perm32(R & 31)) : R; voffB = (unsigned)(Rb * g.ldb + C) * 2u; } }
    const unsigned ldsw = (unsigned)wid * 1024u;
    const int aoff = lds_byte(wr * 32 + fr, fq * 8), boff = 16384 + lds_byte(wc * 32 + fr, fq * 8);
    constexpr int SLOT = 24576;
#define SG_STAGE(slot, pa, pb) do { \
        __builtin_amdgcn_global_load_lds((const unsigned*)((pa) + voffA[0]), (PG8_LAS unsigned*)(lds + (slot) * SLOT + ldsw), 16, 0, 0); \
        __builtin_amdgcn_global_load_lds((const unsigned*)((pa) + voffA[1]), (PG8_LAS unsigned*)(lds + (slot) * SLOT + ldsw + 8192), 16, 0, 0); \
        __builtin_amdgcn_global_load_lds((const unsigned*)((pb) + voffB), (PG8_LAS unsigned*)(lds + (slot) * SLOT + 16384 + ldsw), 16, 0, 0); } while (0)
    const char* cA = (const char*)g.A;
    for (int ui = first; ui < n_units; ui += stride) {
        const char* cB = (const char*)g.Bt + (size_t)ui * 64 * g.ldb * 2;
        f32x4 acc[2][2];
#pragma unroll
        for (int m = 0; m < 2; ++m)
#pragma unroll
            for (int n = 0; n < 2; ++n) acc[m][n] = (f32x4){0.f, 0.f, 0.f, 0.f};
        SG_STAGE(0, cA, cB); SG_STAGE(1, cA + 128, cB + 128); SG_STAGE(2, cA + 256, cB + 256);
        for (int t = 0; t < nt; ++t) {
            if constexpr (Epi::MID_T > 0) { if (t == Epi::MID_T) E.template mid<2>(acc, row_base + wr * 32 + fr, ui * 64 + wc * 32, fq); }
            asm volatile("s_waitcnt vmcnt(6)" ::: "memory"); __builtin_amdgcn_s_barrier();
            { const int tn = (t + 3 < nt) ? t + 3 : nt - 1; const int sl = (t + 3) & 3; SG_STAGE(sl, cA + (size_t)tn * 128, cB + (size_t)tn * 128); }
            const PG8_LAS unsigned char* sp = lds + (t & 3) * SLOT;
            bf16x8 At[2][2], Bt[2][2];
#pragma unroll
            for (int m = 0; m < 2; ++m)
#pragma unroll
                for (int k = 0; k < 2; ++k) At[m][k] = *(const PG8_LAS bf16x8*)(sp + aoff + m * 2048 + k * 1024);
#pragma unroll
            for (int n = 0; n < 2; ++n)
#pragma unroll
                for (int k = 0; k < 2; ++k) Bt[n][k] = *(const PG8_LAS bf16x8*)(sp + boff + n * 2048 + k * 1024);
            asm volatile("s_waitcnt lgkmcnt(0)" ::: "memory");
            __builtin_amdgcn_sched_barrier(0);
#pragma unroll
            for (int m = 0; m < 2; ++m)
#pragma unroll
                for (int n = 0; n < 2; ++n)
#pragma unroll
                    for (int k = 0; k < 2; ++k) acc[m][n] = __builtin_amdgcn_mfma_f32_16x16x32_bf16(Bt[n][k], At[m][k], acc[m][n], 0, 0, 0);
        }
        asm volatile("s_waitcnt vmcnt(0)" ::: "memory"); __builtin_amdgcn_s_barrier();
        E.template core<2>(acc, row_base + wr * 32 + fr, ui * 64 + wc * 32, fq);
    }
#undef SG_STAGE
}
}

constexpr int NWAVES = 8;
constexpr int DM = 2048, MP = 8192, MS = 128, SEQ = 2048, MT = 8448;
constexpr int DPOOL = 1024, NH = 8, DK = 128, DV = 256, DIN = 8192, LDZ = 12288, LDY = 3072;
constexpr int ZC_AX = 0, ZC_AG = 1024, ZC_Q = 2048, ZC_K = 3072, ZC_V = 4096, ZC_BG = 6144, ZC_GA = 8192, ZC_GB = 10240;
constexpr float EPS = 1e-6f;
constexpr int PAST = 16384;
constexpr size_t O_YP = 0, O_YS = 16777216, O_PP = 17039360, O_RP = 17100800, O_PS = 18149376, O_RS = 20115456;

constexpr size_t MiB = 1u << 20;
constexpr size_t WS_CTL = 0, CTL_ZERO_BYTES = 1 * MiB;
constexpr size_t WS_ROPE = 1 * MiB;
constexpr size_t WS_MOD = 3 * MiB;
constexpr size_t WS_SS = 7 * MiB;
constexpr size_t WS_WCAT = 16 * MiB;
constexpr size_t WS_WAB = 64 * MiB;
constexpr size_t WS_WOUT = 76 * MiB;
constexpr size_t WS_POOLW = 84 * MiB;
constexpr size_t WS_H = 96 * MiB;
constexpr size_t WS_Z = 130 * MiB;
constexpr size_t WS_YAB = 328 * MiB;
constexpr size_t WS_POOLED = 378 * MiB;
constexpr size_t WS_SN = 396 * MiB;
constexpr size_t WS_MB = 428 * MiB;
constexpr size_t WS_END = 462 * MiB;
constexpr int CW_BAR = 4096;

constexpr int RING_OFF = 0, RING_BYTES = 131072;
constexpr int LDSCTL_OFF = RING_BYTES, MISC_OFF = LDSCTL_OFF + 320;
constexpr int STAT_OFF = RING_BYTES + 1024;
constexpr int LDS_BYTES = 147456;

#define GAS __attribute__((address_space(1)))
#define LAS __attribute__((address_space(3)))
typedef unsigned short bf16;
typedef unsigned v4u __attribute__((ext_vector_type(4)));
typedef unsigned v2u __attribute__((ext_vector_type(2)));
typedef float f32x4 __attribute__((ext_vector_type(4)));
typedef float f32x16 __attribute__((ext_vector_type(16)));
typedef short bf16x8 __attribute__((ext_vector_type(8)));
typedef short s16x4 __attribute__((ext_vector_type(4)));
typedef GAS unsigned gu32;
#define RLX_AGENT __ATOMIC_RELAXED, __HIP_MEMORY_SCOPE_AGENT
#define LDS_WAIT() asm volatile("s_waitcnt lgkmcnt(0)" ::: "memory")
#define VM_WAIT() asm volatile("s_waitcnt vmcnt(0)" ::: "memory")
__device__ __forceinline__ unsigned f2bf(float f) { unsigned u = __builtin_bit_cast(unsigned, f); return (u + 0x7fffu + ((u >> 16) & 1u)) >> 16; }
__device__ __forceinline__ unsigned pk2(float lo, float hi) { return f2bf(lo) | (f2bf(hi) << 16); }
__device__ __forceinline__ float bflo(unsigned w) { return __uint_as_float(w << 16); }
__device__ __forceinline__ float bfhi(unsigned w) { return __uint_as_float(w & 0xffff0000u); }
__device__ __forceinline__ float bf1(bf16 b) { return __uint_as_float((unsigned)b << 16); }
__device__ __forceinline__ float silu_(float v) { return v * __builtin_amdgcn_rcpf(1.0f + __builtin_amdgcn_exp2f(-1.4426950408889634f * v)); }
__device__ __forceinline__ float wave_sum(float v) {
#pragma unroll
    for (int o = 1; o < 64; o <<= 1) v += __shfl_xor(v, o);
    return v;
}
__device__ __forceinline__ float lg2gamma(int h) {
    const float t[8] = {-0.04580368961312479f, -0.02272007650008353f, -0.011315313227834146f, -0.005646563141142063f, -0.0028205190623786626f, -0.0014095702546713536f, -0.0007046129765893727f, -0.0003522634716290214f};
    float r = t[0];
#pragma unroll
    for (int i = 1; i < 8; ++i) r = (h == i) ? t[i] : r;
    return r;
}

__device__ __forceinline__ int fresh_lane() { unsigned m_ = ~0u; asm volatile("" : "+s"(m_)); return (int)__builtin_amdgcn_mbcnt_hi(m_, __builtin_amdgcn_mbcnt_lo(m_, 0u)); }
#define XB_TMO      128
#define XB_XCNT(j)  (256  + 64 * (j))
#define XB_XSUB(j)  (1280 + 64 * (j))
#define XB_XGEN(j)  (2304 + 64 * (j))
#define XB_TOP      3328
#define XB_TOPGEN   3392
#define XCD_BAR_WORDS 3456
#define XB_SPIN_CAP (1u << 18)
__device__ __forceinline__ unsigned xb_ld(unsigned* p)              { return __hip_atomic_load(p, __ATOMIC_RELAXED, __HIP_MEMORY_SCOPE_AGENT); }
__device__ __forceinline__ unsigned xb_add(unsigned* p, unsigned v) { return __hip_atomic_fetch_add(p, v, __ATOMIC_RELAXED, __HIP_MEMORY_SCOPE_AGENT); }
__device__ __forceinline__ unsigned xb_xcc_id() { return (unsigned)__builtin_amdgcn_s_getreg((3 << 11) | 20) & 0xFu; }
#define XB_SPIN(cond, bar) do { unsigned _sp = 0; while (cond) { __builtin_amdgcn_s_sleep(1); \
    if ((++_sp & 255u) == 0u) { if (xb_ld(&(bar)[XB_TMO])) break; if (_sp > XB_SPIN_CAP) { atomicAdd(&(bar)[XB_TMO], 1u); break; } } } } while (0)
struct XcdBarrier { unsigned* bar; unsigned x; volatile LAS unsigned* st; int wave; };
__device__ __forceinline__ XcdBarrier xcd_barrier_post(unsigned* bar, volatile LAS unsigned* st, int wave) {
    XcdBarrier b; b.bar = bar; b.x = xb_xcc_id(); b.st = st; b.wave = wave;
    if (wave == 0 && fresh_lane() == 0) (void)xb_add(&bar[XB_XCNT(b.x)], 1u);
    return b;
}
__device__ __forceinline__ void xcd_barrier_complete(unsigned* bar, unsigned x, unsigned& nloc, unsigned& nx) {
    const unsigned G = gridDim.x * gridDim.y * gridDim.z;
    unsigned sum, cnt, mine, sp = 0u;
    for (;;) {
        sum = 0u; cnt = 0u; mine = 0u;
#pragma unroll
        for (unsigned j = 0; j < 16; ++j) { const unsigned c = xb_ld(&bar[XB_XCNT(j)]); sum += c; cnt += (c > 0u) ? 1u : 0u; mine = (j == x) ? c : mine; }
        if (sum == G) break;
        __builtin_amdgcn_s_sleep(1);
        if ((++sp & 255u) == 0u) { if (xb_ld(&bar[XB_TMO])) break; if (sp > XB_SPIN_CAP) { atomicAdd(&bar[XB_TMO], 1u); break; } }
    }
    nloc = mine > 0u ? mine : 1u; nx = cnt > 0u ? cnt : 1u;
}
__device__ __forceinline__ void xcd_barrier(const XcdBarrier& b) {
    asm volatile("s_waitcnt vmcnt(0)" ::: "memory");
    __syncthreads();
    if (b.wave == 0 && fresh_lane() == 0) {
        unsigned* bar = b.bar;
        __builtin_amdgcn_s_waitcnt(0);
        unsigned nloc = b.st[0], nx = b.st[1];
        if (nloc == 0u) { xcd_barrier_complete(bar, b.x, nloc, nx); b.st[0] = nloc; b.st[1] = nx; }
        const unsigned old = xb_add(&bar[XB_XSUB(b.x)], 1u);
        const unsigned gen = old / nloc;
        if (old + 1u == (gen + 1u) * nloc) {
            __builtin_amdgcn_fence(__ATOMIC_RELEASE, "agent");
            asm volatile("s_waitcnt vmcnt(0)" ::: "memory");
            const unsigned og = xb_add(&bar[XB_TOP], 1u);
            const unsigned tg = og / nx;
            if (og + 1u == (tg + 1u) * nx) xb_add(&bar[XB_TOPGEN], 1u);
            else XB_SPIN(xb_ld(&bar[XB_TOPGEN]) == tg, bar);
            __builtin_amdgcn_fence(__ATOMIC_ACQUIRE, "agent");
            xb_add(&bar[XB_XGEN(b.x)], 1u);
            asm volatile("s_waitcnt vmcnt(0)" ::: "memory");
        } else {
            XB_SPIN(xb_ld(&bar[XB_XGEN(b.x)]) == gen, bar);
            __builtin_amdgcn_fence(__ATOMIC_ACQUIRE, "agent");
            asm volatile("s_waitcnt vmcnt(0)" ::: "memory");
        }
    }
    __syncthreads();
}

struct Frame {
    LAS unsigned char* lds;
    volatile LAS unsigned* MISC;
    gu32* ctl;
    int tid, lane, wave;
    int vcu, G;
    const float *x_p, *x_s, *st_pool, *st_ret, *c_p, *c_s, *ada_w, *ada_b, *g_pre, *g_post, *w_in, *pool_w, *pool_scale, *gn_g, *w_a, *w_b, *w_merge, *b_merge, *w_out;
    float* out;
    float *ropec, *ropes, *mod, *ss;
    bf16 *Wcat, *Wab, *Wout, *PoolW, *H, *Z, *YAB, *POOLED, *SN, *MB;
};

struct EpiZ {
    static constexpr bool PERM = true; static constexpr int MID_T = 0;
    bf16* Z; const float* bmerge; const float* ropec; const float* ropes; float* out_pp; float* out_ps;
    template <int NM> __device__ __forceinline__ void core(const pg8::f32x4 (&a)[NM][2], int row0, int cs, int fq) const {
        using namespace pg8;
        if (cs >= ZC_Q && cs < ZC_V) {
            const float ksc = (cs >= ZC_K) ? 0.08838834764831845f : 1.0f;
            const int j0 = 16 * ((cs & 127) >> 5) + 4 * fq, hb = cs & ~127;
#pragma unroll
            for (int m = 0; m < NM; ++m) {
                const int row = row0 + m * 16; const int pos = row < MP ? (row & (SEQ - 1)) : SEQ;
                const f32x4 c4 = *(const f32x4*)(ropec + pos * 64 + j0), s4 = *(const f32x4*)(ropes + pos * 64 + j0);
                bf16* rowp = Z + (size_t)row * LDZ + hb + j0;
                const f32x4 v0 = a[m][0], v1 = a[m][1];
                const f32x4 o1 = (v0 * c4 - v1 * s4) * ksc, o2 = (v0 * s4 + v1 * c4) * ksc;
                u32x2 w1, w2; w1.x = cvt_pk_bf16(o1[0], o1[1]); w1.y = cvt_pk_bf16(o1[2], o1[3]); w2.x = cvt_pk_bf16(o2[0], o2[1]); w2.y = cvt_pk_bf16(o2[2], o2[3]);
                *(u32x2*)rowp = w1; *(u32x2*)(rowp + 64) = w2;
            }
            return;
        }
        const int act = (cs >= ZC_GA) ? 2 : (((cs >= ZC_AG && cs < ZC_Q) || (cs >= ZC_BG)) ? 1 : 0);
        const int col = cs + 8 * fq;
        f32x4 bv[2];
#pragma unroll
        for (int n = 0; n < 2; ++n) bv[n] = (act == 2) ? *(const f32x4*)(bmerge + (col - ZC_GA) + 4 * n) : (f32x4){0.f, 0.f, 0.f, 0.f};
#pragma unroll
        for (int m = 0; m < NM; ++m) {
            const int row = row0 + m * 16;
            f32x4 v0 = a[m][0] + bv[0], v1 = a[m][1] + bv[1];
            if (act == 1) {
#pragma unroll
                for (int e = 0; e < 4; ++e) { v0[e] = silu_(v0[e]); v1[e] = silu_(v1[e]); }
            } else if (act == 2) {
#pragma unroll
                for (int e = 0; e < 4; ++e) { v0[e] = sigmoidf_(v0[e]); v1[e] = sigmoidf_(v1[e]); }
            }
            u32x4 w; w.x = cvt_pk_bf16(v0[0], v0[1]); w.y = cvt_pk_bf16(v0[2], v0[3]); w.z = cvt_pk_bf16(v1[0], v1[1]); w.w = cvt_pk_bf16(v1[2], v1[3]);
            *(u32x4*)(Z + (size_t)row * LDZ + col) = w;
            if (cs < ZC_AG) {
                if (row < MP) { const int t = row & (SEQ - 1); if (t >= SEQ - 15) { float* o = out_pp + ((size_t)((row >> 11) * 15 + (t - (SEQ - 15)))) * DPOOL + col; *(f32x4*)o = v0; *(f32x4*)(o + 4) = v1; } }
                else if (row < MP + MS) { float* o = out_ps + ((size_t)((row - MP) * 15 + 14)) * DPOOL + col; *(f32x4*)o = v0; *(f32x4*)(o + 4) = v1; }
            }
        }
    }
    template <int NM> __device__ __forceinline__ void mid(pg8::f32x4 (&)[NM][2], int, int, int) const {}
};
struct EpiPool {
    static constexpr bool PERM = true; static constexpr int MID_T = 0;
    bf16* Y; const bf16* Z; const float* pscale;
    template <int NM> __device__ __forceinline__ void core(const pg8::f32x4 (&a)[NM][2], int row0, int cs, int fq) const {
        using namespace pg8;
        const int col = cs + 8 * fq;
        const f32x4 ps0 = *(const f32x4*)(pscale + col), ps1 = *(const f32x4*)(pscale + col + 4);
#pragma unroll
        for (int m = 0; m < NM; ++m) {
            const int row = row0 + m * 16;
            const u32x4 g = *(const u32x4*)(Z + (size_t)row * LDZ + ZC_AG + col);
            f32x4 v0 = a[m][0] * ps0, v1 = a[m][1] * ps1;
            v0[0] *= bf_lo(g.x); v0[1] *= bf_hi(g.x); v0[2] *= bf_lo(g.y); v0[3] *= bf_hi(g.y);
            v1[0] *= bf_lo(g.z); v1[1] *= bf_hi(g.z); v1[2] *= bf_lo(g.w); v1[3] *= bf_hi(g.w);
            u32x4 w; w.x = cvt_pk_bf16(v0[0], v0[1]); w.y = cvt_pk_bf16(v0[2], v0[3]); w.z = cvt_pk_bf16(v1[0], v1[1]); w.w = cvt_pk_bf16(v1[2], v1[3]);
            *(u32x4*)(Y + (size_t)row * LDY + col) = w;
        }
    }
    template <int NM> __device__ __forceinline__ void mid(pg8::f32x4 (&)[NM][2], int, int, int) const {}
};
struct EpiMerge {
    static constexpr bool PERM = true; static constexpr int MID_T = 16;
    bf16* O; const bf16* Z;
    template <int NM> __device__ __forceinline__ void mid(pg8::f32x4 (&a)[NM][2], int row0, int cs, int fq) const {
        using namespace pg8;
        const bf16* zb = Z + (size_t)row0 * LDZ + ZC_GA + cs + 8 * fq;
        asm volatile("" : "+v"(zb));
#pragma unroll
        for (int m = 0; m < NM; ++m) {
            const bf16* zr = zb + (size_t)(m * 16) * LDZ;
            const u32x4 ga = *(const u32x4*)zr, gb = *(const u32x4*)(zr + (ZC_GB - ZC_GA));
            f32x4& v0 = a[m][0]; f32x4& v1 = a[m][1];
            v0[0] *= bf_lo(ga.x) * __builtin_amdgcn_rcpf(bf_lo(gb.x)); v0[1] *= bf_hi(ga.x) * __builtin_amdgcn_rcpf(bf_hi(gb.x)); v0[2] *= bf_lo(ga.y) * __builtin_amdgcn_rcpf(bf_lo(gb.y)); v0[3] *= bf_hi(ga.y) * __builtin_amdgcn_rcpf(bf_hi(gb.y));
            v1[0] *= bf_lo(ga.z) * __builtin_amdgcn_rcpf(bf_lo(gb.z)); v1[1] *= bf_hi(ga.z) * __builtin_amdgcn_rcpf(bf_hi(gb.z)); v1[2] *= bf_lo(ga.w) * __builtin_amdgcn_rcpf(bf_lo(gb.w)); v1[3] *= bf_hi(ga.w) * __builtin_amdgcn_rcpf(bf_hi(gb.w));
            if (m & 1) asm volatile("" ::: "memory");
        }
    }
    template <int NM> __device__ __forceinline__ void core(const pg8::f32x4 (&a)[NM][2], int row0, int cs, int fq) const {
        using namespace pg8;
        const int col = cs + 8 * fq;
#pragma unroll
        for (int m = 0; m < NM; ++m) {
            const int row = row0 + m * 16;
            const u32x4 g = *(const u32x4*)(Z + (size_t)row * LDZ + ZC_GB + col);
            f32x4 v0 = a[m][0], v1 = a[m][1];
            v0[0] *= bf_lo(g.x); v0[1] *= bf_hi(g.x); v0[2] *= bf_lo(g.y); v0[3] *= bf_hi(g.y);
            v1[0] *= bf_lo(g.z); v1[1] *= bf_hi(g.z); v1[2] *= bf_lo(g.w); v1[3] *= bf_hi(g.w);
            u32x4 w; w.x = cvt_pk_bf16(v0[0], v0[1]); w.y = cvt_pk_bf16(v0[2], v0[3]); w.z = cvt_pk_bf16(v1[0], v1[1]); w.w = cvt_pk_bf16(v1[2], v1[3]);
            *(u32x4*)(O + (size_t)row * DM + col) = w;
        }
    }
};
struct EpiOut {
    static constexpr bool PERM = false; static constexpr int MID_T = 0;
    float* out; float* ss;
    template <int NM> __device__ __forceinline__ void core(const pg8::f32x4 (&a)[NM][2], int row0, int cs, int fq) const {
        using namespace pg8;
#pragma unroll
        for (int m = 0; m < NM; ++m) {
            const int row = row0 + m * 16;
            float s = 0.f;
#pragma unroll
            for (int n = 0; n < 2; ++n) { const f32x4 v = a[m][n]; s += (v[0] * v[0] + v[1] * v[1]) + (v[2] * v[2] + v[3] * v[3]); }
            s += __shfl_xor(s, 16); s += __shfl_xor(s, 32);
            if (fq == 0) ss[(size_t)row * 64 + (cs >> 5)] = s;
            if (row < MP + MS) {
                float* rowp = out + (row < MP ? O_YP + (size_t)row * DM : O_YS + (size_t)(row - MP) * DM) + cs + 4 * fq;
#pragma unroll
                for (int n = 0; n < 2; ++n) *(f32x4*)(rowp + n * 16) = a[m][n];
            }
        }
    }
    template <int NM> __device__ __forceinline__ void mid(pg8::f32x4 (&)[NM][2], int, int, int) const {}
};

__device__ __forceinline__ int rot_row(int n) { const int L = n & 127, hf = L >> 6, j = L & 63; return (n & ~127) + 32 * (j >> 4) + 8 * ((j >> 2) & 3) + 4 * hf + (j & 3); }
__device__ __forceinline__ void p0_transpose_item(const float* W, int N, bf16* WT, int ldw, int row_off, int koff, int rot_lo, int rot_hi, LAS float* scr, int item, int lane) {
    const int nblk = N / 32, kb = item / nblk, nb = item % nblk, k0 = 64 * kb, n0 = 32 * nb;
#pragma unroll 8
    for (int i = 0; i < 32; ++i) { const int kk = 2 * i + (lane >> 5); scr[kk * 33 + (lane & 31)] = W[(size_t)(k0 + kk) * N + n0 + (lane & 31)]; }
    LDS_WAIT(); asm volatile("" ::: "memory");
    const int c = lane & 7;
#pragma unroll
    for (int j = 0; j < 4; ++j) { const int n = (lane >> 3) + 8 * j; const LAS float* s = scr + (8 * c) * 33 + n;
        v4u o; o.x = pk2(s[0 * 33], s[1 * 33]); o.y = pk2(s[2 * 33], s[3 * 33]); o.z = pk2(s[4 * 33], s[5 * 33]); o.w = pk2(s[6 * 33], s[7 * 33]);
        int nn = n0 + n; if (nn >= rot_lo && nn < rot_hi) nn = rot_row(nn);
        *(GAS v4u*)(WT + (size_t)(row_off + nn) * ldw + koff + k0 + 8 * c) = o; }
    LDS_WAIT(); asm volatile("" ::: "memory");
}
__device__ __forceinline__ void p0_mod_item(Frame& F, int strip) {
    const int n0 = strip * 32, lane = F.lane, fr = lane & 15, fq = lane >> 4, wave = F.wave;
    f32x4 acc[9][2];
#pragma unroll
    for (int a = 0; a < 9; ++a) { acc[a][0] = (f32x4){0.f, 0.f, 0.f, 0.f}; acc[a][1] = (f32x4){0.f, 0.f, 0.f, 0.f}; }
    for (int ks = 0; ks < 8; ++ks) {
        const int k0 = wave * 256 + ks * 32 + 8 * fq;
        bf16x8 bfr[2];
#pragma unroll
        for (int nt = 0; nt < 2; ++nt) {
            float w[8];
#pragma unroll
            for (int j = 0; j < 8; ++j) w[j] = F.ada_w[(size_t)(k0 + j) * 6144 + n0 + 16 * nt + fr];
            v4u p; p.x = pk2(w[0], w[1]); p.y = pk2(w[2], w[3]); p.z = pk2(w[4], w[5]); p.w = pk2(w[6], w[7]);
            bfr[nt] = __builtin_bit_cast(bf16x8, p);
        }
#pragma unroll
        for (int mt = 0; mt < 9; ++mt) {
            const int row = 16 * mt + fr;
            f32x4 a0 = (f32x4){0.f, 0.f, 0.f, 0.f}, a1 = a0;
            if (row < 132) { const float* cp = (row < 4 ? F.c_p + (size_t)row * DM : F.c_s + (size_t)(row - 4) * DM) + k0; a0 = *(const f32x4*)cp; a1 = *(const f32x4*)(cp + 4); }
            v4u p; p.x = pk2(silu_(a0[0]), silu_(a0[1])); p.y = pk2(silu_(a0[2]), silu_(a0[3])); p.z = pk2(silu_(a1[0]), silu_(a1[1])); p.w = pk2(silu_(a1[2]), silu_(a1[3]));
            const bf16x8 afr = __builtin_bit_cast(bf16x8, p);
            acc[mt][0] = __builtin_amdgcn_mfma_f32_16x16x32_bf16(afr, bfr[0], acc[mt][0], 0, 0, 0);
            acc[mt][1] = __builtin_amdgcn_mfma_f32_16x16x32_bf16(afr, bfr[1], acc[mt][1], 0, 0, 0);
        }
    }
    LAS float* red = (LAS float*)F.lds;
    for (int w = 0; w < 8; ++w) {
        if (wave == w) {
#pragma unroll
            for (int mt = 0; mt < 9; ++mt)
#pragma unroll
                for (int nt = 0; nt < 2; ++nt)
#pragma unroll
                    for (int r = 0; r < 4; ++r) { const int idx = (16 * mt + 4 * fq + r) * 32 + 16 * nt + fr; if (w == 0) red[idx] = acc[mt][nt][r]; else red[idx] += acc[mt][nt][r]; }
        }
        __syncthreads();
    }
    for (int i = F.tid; i < 132 * 32; i += NWAVES * 64) { const int r = i >> 5, cc = i & 31; F.mod[(size_t)r * 6144 + n0 + cc] = red[i] + F.ada_b[n0 + cc]; }
    __syncthreads();
}
__device__ __forceinline__ void rope_entry(int prow, int i, float* cosT, float* sinT) {
    double th = 1.0, bs = 0.8659643233600653;
    for (int e = i; e; e >>= 1) { if (e & 1) th *= bs; bs *= bs; }
    const double t2 = th * th; double c = 1.0, s = th, tc = 1.0, ts = th;
#pragma unroll 1
    for (int n = 1; n <= 12; ++n) { tc *= -t2 / (double)((2 * n - 1) * (2 * n)); c += tc; ts *= -t2 / (double)((2 * n) * (2 * n + 1)); s += ts; }
    const int pos = prow < SEQ ? prow : PAST;
    double rc = 1.0, rs = 0.0, bc = c, bn = s;
    for (int e = pos; e; e >>= 1) { if (e & 1) { const double t = rc * bc - rs * bn; rs = rc * bn + rs * bc; rc = t; } const double t = bc * bc - bn * bn; bn = 2.0 * bc * bn; bc = t; }
    cosT[prow * 64 + i] = (float)rc; sinT[prow * 64 + i] = (float)rs;
}
__device__ __forceinline__ void p0_prologue(Frame& F) {
    if (F.vcu < 192) for (int s = F.vcu; s < 192; s += F.G) p0_mod_item(F, s);
    LAS float* scr = (LAS float*)(F.lds + RING_OFF + F.wave * 16384);
    const int gw = F.vcu * NWAVES + F.wave, NGW = F.G * NWAVES;
    constexpr int I_IN = 32 * 256, I_MG = 32 * 128, I_A = 16 * 64, I_B = 32 * 64, I_O = 32 * 64, I_P = 4 * 8;
    constexpr int NITEMS = I_IN + I_MG + I_A + I_B + I_O + 4 * I_P;
    for (int it = gw; it < NITEMS; it += NGW) {
        int r = it;
        if (r < I_IN) { p0_transpose_item(F.w_in, DIN, F.Wcat, DM, 0, 0, ZC_Q, ZC_V, scr, r, F.lane); continue; } r -= I_IN;
        if (r < I_MG) { p0_transpose_item(F.w_merge, 4096, F.Wcat, DM, DIN, 0, 0, 0, scr, r, F.lane); continue; } r -= I_MG;
        if (r < I_A) { p0_transpose_item(F.w_a, DM, F.Wab, LDY, 0, 0, 0, 0, scr, r, F.lane); continue; } r -= I_A;
        if (r < I_B) { p0_transpose_item(F.w_b, DM, F.Wab, LDY, 0, 1024, 0, 0, scr, r, F.lane); continue; } r -= I_B;
        if (r < I_O) { p0_transpose_item(F.w_out, DM, F.Wout, DM, 0, 0, 0, 0, scr, r, F.lane); continue; } r -= I_O;
        { const int g = r / I_P; p0_transpose_item(F.pool_w + (size_t)g * 65536, 256, F.PoolW, 256, g * 256, 0, 0, 0, scr, r % I_P, F.lane); }
    }
    const int gt = F.vcu * (NWAVES * 64) + F.tid, NGT = F.G * NWAVES * 64;
    for (int e = gt; e < 2049 * 64; e += NGT) rope_entry(e >> 6, e & 63, F.ropec, F.ropes);
}

__device__ __forceinline__ void h_row(Frame& F, const float* xrow, const float* modrow, bf16* orow) {
    const GAS f32x4* xr = (const GAS f32x4*)xrow + F.lane;
    f32x4 v[8]; float s = 0.f;
#pragma unroll
    for (int j = 0; j < 8; ++j) { v[j] = xr[64 * j]; s += (v[j].x * v[j].x + v[j].y * v[j].y) + (v[j].z * v[j].z + v[j].w * v[j].w); }
    const float rstd = 1.0f / sqrtf(wave_sum(s) * (1.0f / DM) + EPS);
    GAS v2u* o8 = (GAS v2u*)orow + F.lane;
#pragma unroll
    for (int j = 0; j < 8; ++j) {
        const int col = 4 * F.lane + 256 * j;
        const f32x4 g = *(const f32x4*)(F.g_pre + col), sh = *(const f32x4*)(modrow + col), sc = *(const f32x4*)(modrow + DM + col);
        const f32x4 o = v[j] * rstd * g * (sc + 1.0f) + sh;
        v2u w; w.x = pk2(o.x, o.y); w.y = pk2(o.z, o.w); o8[64 * j] = w;
    }
}

__device__ __forceinline__ unsigned off_a(unsigned row, unsigned ch) { return 2048u * (row >> 3) + 512u * (ch >> 2) + 64u * (row & 7) + 16u * ((ch & 3) ^ ((row >> 2) & 3)); }
struct RowA { unsigned e, d; };
struct TrA { unsigned t0, t1; };
__device__ __forceinline__ RowA row_addr(unsigned lane) { RowA r; r.e = off_a(lane & 31, lane >> 5); r.d = off_a(lane & 31, 2 + (lane >> 5)) - r.e; return r; }
__device__ __forceinline__ TrA tr_addr(unsigned lane) { const unsigned h = lane >> 5, blk = (lane >> 4) & 1, q = (lane & 15) >> 2, p = lane & 3; TrA t;
    t.t0 = off_a(8 * h + q, 2 * blk + (p >> 1)) + 8 * (p & 1); t.t1 = off_a(8 * h + 4 + q, 2 * blk + (p >> 1)) + 8 * (p & 1); return t; }
__device__ __forceinline__ bf16x8 frag_row(const LAS unsigned char* img, const RowA& ra, int s) { return *(const LAS bf16x8*)(img + (ra.e + (unsigned)(s & 1) * ra.d + 512u * (unsigned)(s >> 1))); }
__device__ __forceinline__ bf16x8 frag_tr(const LAS unsigned char* img, const TrA& ta, int c, int ks) {
    const s16x4 lo = __builtin_bit_cast(s16x4, __builtin_amdgcn_ds_read_tr16_b64_v4i16((LAS s16x4*)(img + ta.t0 + 512 * c + 4096 * ks)));
    const s16x4 hi = __builtin_bit_cast(s16x4, __builtin_amdgcn_ds_read_tr16_b64_v4i16((LAS s16x4*)(img + ta.t1 + 512 * c + 4096 * ks)));
    return __builtin_shufflevector(lo, hi, 0, 1, 2, 3, 4, 5, 6, 7);
}
#define MFMA32(a, b, c) __builtin_amdgcn_mfma_f32_32x32x16_bf16((a), (b), (c), 0, 0, 0)
__device__ __forceinline__ int crow(int reg, int h) { return (reg & 3) + 8 * (reg >> 2) + 4 * h; }

__device__ __forceinline__ void ret_ab_unit(Frame& F, int unit) {
    const int bh = unit >> 1, half = unit & 1, b = bh >> 3, h = bh & 7, lane = F.lane, wave = F.wave, hh = lane >> 5;
    const float lg = lg2gamma(h);
    const float cdec = __builtin_amdgcn_exp2f(128.0f * lg);
    const int ti = wave & 3, tj = (wave >> 2) * 2;
    const TrA ta = tr_addr(lane);
    f32x16 acc[2];
#pragma unroll
    for (int e = 0; e < 16; ++e) { acc[0][e] = 0.f; acc[1][e] = 0.f; }
    const bf16* Zb = F.Z + (size_t)(b * SEQ) * LDZ;
    v4u rk[4], rv[4];
#define AB_LOAD(c) do { _Pragma("unroll") for (int i = 0; i < 4; ++i) { const int n = F.tid + 512 * i, row = n >> 4, ch = n & 15; const bf16* rp = Zb + (size_t)((c) * 128 + row) * LDZ; \
        rk[i] = *(const GAS v4u*)(rp + ZC_K + h * DK + ch * 8); rv[i] = *(const GAS v4u*)(rp + ZC_V + h * DV + half * 128 + ch * 8); } } while (0)
#define AB_STORE(buf) do { _Pragma("unroll") for (int i = 0; i < 4; ++i) { const int n = F.tid + 512 * i, row = n >> 4, ch = n & 15; \
        const float d = __builtin_amdgcn_exp2f((float)(127 - row) * lg); v4u kk = rk[i]; \
        kk.x = pk2(bflo(kk.x) * d, bfhi(kk.x) * d); kk.y = pk2(bflo(kk.y) * d, bfhi(kk.y) * d); kk.z = pk2(bflo(kk.z) * d, bfhi(kk.z) * d); kk.w = pk2(bflo(kk.w) * d, bfhi(kk.w) * d); \
        const unsigned o = (unsigned)(buf) * 65536u + (unsigned)(row >> 5) * 8192u + off_a(row & 31, ch); \
        *(LAS v4u*)(F.lds + o) = kk; *(LAS v4u*)(F.lds + 32768u + o) = rv[i]; } } while (0)
    AB_LOAD(0); AB_STORE(0); __syncthreads();
#pragma unroll 1
    for (int c = 0; c < 16; ++c) {
        if (c + 1 < 16) AB_LOAD(c + 1);
        if (c > 0) {
            bf16* sn = F.SN + ((size_t)(bh * 16 + c) * 256) * 128;
#pragma unroll
            for (int t = 0; t < 2; ++t) { const int dv = half * 128 + 32 * (tj + t) + (lane & 31);
#pragma unroll
                for (int g = 0; g < 4; ++g) { v2u w; w.x = pk2(acc[t][4 * g], acc[t][4 * g + 1]); w.y = pk2(acc[t][4 * g + 2], acc[t][4 * g + 3]);
                    *(GAS v2u*)(sn + (size_t)dv * 128 + 32 * ti + 8 * g + 4 * hh) = w; } }
        }
#pragma unroll
        for (int e = 0; e < 16; ++e) { acc[0][e] *= cdec; acc[1][e] *= cdec; }
        const LAS unsigned char* kb = F.lds + (c & 1) * 65536; const LAS unsigned char* vb = kb + 32768;
#pragma unroll
        for (int kk = 0; kk < 8; ++kk) {
            const bf16x8 a = frag_tr(kb + (kk >> 1) * 8192, ta, ti, kk & 1);
            const bf16x8 b0 = frag_tr(vb + (kk >> 1) * 8192, ta, tj, kk & 1), b1 = frag_tr(vb + (kk >> 1) * 8192, ta, tj + 1, kk & 1);
            acc[0] = MFMA32(a, b0, acc[0]); acc[1] = MFMA32(a, b1, acc[1]);
        }
        if (c + 1 < 16) AB_STORE((c + 1) & 1);
        __syncthreads();
    }
#undef AB_LOAD
#undef AB_STORE
    float* so = F.out + O_RP + (size_t)bh * (DK * DV);
#pragma unroll
    for (int t = 0; t < 2; ++t) { const int dv = half * 128 + 32 * (tj + t) + (lane & 31);
#pragma unroll
        for (int e = 0; e < 16; ++e) so[(size_t)(32 * ti + crow(e, hh)) * DV + dv] = acc[t][e]; }
}

__device__ __forceinline__ void pooled_prompt(Frame& F) {
    const int gt = F.vcu * (NWAVES * 64) + F.tid, NGT = F.G * NWAVES * 64;
    for (int it = gt; it < MP * 128; it += NGT) {
        const int row = it >> 7, q = it & 127, t = row & (SEQ - 1), w = 2 << (q >> 5), cnt = (t + 1 < w) ? t + 1 : w;
        const bf16* p = F.Z + (size_t)row * LDZ + ZC_AX + q * 8;
        float s[8], a[8];
        { const v4u x = *(const GAS v4u*)p; a[0] = bflo(x.x); a[1] = bfhi(x.x); a[2] = bflo(x.y); a[3] = bfhi(x.y); a[4] = bflo(x.z); a[5] = bfhi(x.z); a[6] = bflo(x.w); a[7] = bfhi(x.w); }
#pragma unroll
        for (int e = 0; e < 8; ++e) s[e] = a[e];
        for (int j = 1; j < cnt; ++j) { const v4u x = *(const GAS v4u*)(p - (size_t)j * LDZ);
            s[0] += bflo(x.x); s[1] += bfhi(x.x); s[2] += bflo(x.y); s[3] += bfhi(x.y); s[4] += bflo(x.z); s[5] += bfhi(x.z); s[6] += bflo(x.w); s[7] += bfhi(x.w); }
        const float inv = 1.0f / (float)cnt;
        v4u o; o.x = pk2(s[0] * inv - a[0], s[1] * inv - a[1]); o.y = pk2(s[2] * inv - a[2], s[3] * inv - a[3]); o.z = pk2(s[4] * inv - a[4], s[5] * inv - a[5]); o.w = pk2(s[6] * inv - a[6], s[7] * inv - a[7]);
        *(GAS v4u*)(F.POOLED + (size_t)row * DPOOL + q * 8) = o;
    }
}
__device__ __forceinline__ void pooled_sample(Frame& F) {
    const int gt = F.vcu * (NWAVES * 64) + F.tid, NGT = F.G * NWAVES * 64;
    for (int it = gt; it < MS * 128; it += NGT) {
        const int bs = it >> 7, q = it & 127, w = 2 << (q >> 5);
        const v4u x = *(const GAS v4u*)(F.Z + (size_t)(MP + bs) * LDZ + ZC_AX + q * 8);
        float a[8] = {bflo(x.x), bfhi(x.x), bflo(x.y), bfhi(x.y), bflo(x.z), bfhi(x.z), bflo(x.w), bfhi(x.w)}, s[8];
#pragma unroll
        for (int e = 0; e < 8; ++e) s[e] = a[e];
        const float* sp = F.st_pool + (size_t)bs * 15 * DPOOL + q * 8;
        float* op = F.out + O_PS + (size_t)bs * 15 * DPOOL + q * 8;
#pragma unroll
        for (int i = 14; i >= 0; --i) {
            const f32x4 b0 = *(const f32x4*)(sp + (size_t)i * DPOOL), b1 = *(const f32x4*)(sp + (size_t)i * DPOOL + 4);
            if (i >= 1) { *(f32x4*)(op + (size_t)(i - 1) * DPOOL) = b0; *(f32x4*)(op + (size_t)(i - 1) * DPOOL + 4) = b1; }
            if (15 - i < w) { s[0] += b0.x; s[1] += b0.y; s[2] += b0.z; s[3] += b0.w; s[4] += b1.x; s[5] += b1.y; s[6] += b1.z; s[7] += b1.w; }
        }
        const float inv = 1.0f / (float)w;
        v4u o; o.x = pk2(s[0] * inv - a[0], s[1] * inv - a[1]); o.y = pk2(s[2] * inv - a[2], s[3] * inv - a[3]); o.z = pk2(s[4] * inv - a[4], s[5] * inv - a[5]); o.w = pk2(s[6] * inv - a[6], s[7] * inv - a[7]);
        *(GAS v4u*)(F.POOLED + (size_t)(MP + bs) * DPOOL + q * 8) = o;
    }
}
__device__ __forceinline__ void ret_sample_item(Frame& F, int item) {
    const int bs = item >> 3, h = item & 7, lane = F.lane, wave = F.wave, row = MP + bs;
    const float gam = 1.0f - __builtin_amdgcn_exp2f((float)(-5 - h));
    const bf16* zr = F.Z + (size_t)row * LDZ;
    f32x4 v4; { const v2u x = *(const GAS v2u*)(zr + ZC_V + h * DV + 4 * lane); v4 = (f32x4){bflo(x.x), bfhi(x.x), bflo(x.y), bfhi(x.y)}; }
    const float* s0 = F.st_ret + ((size_t)(bs * NH + h) * DK) * DV + 4 * lane;
    float* s1 = F.out + O_RS + ((size_t)(bs * NH + h) * DK) * DV + 4 * lane;
    f32x4 o4 = (f32x4){0.f, 0.f, 0.f, 0.f};
    f32x4 sv[16];
#pragma unroll
    for (int r = 0; r < 16; ++r) sv[r] = *(const f32x4*)(s0 + (size_t)(16 * wave + r) * DV);
#pragma unroll
    for (int r = 0; r < 16; ++r) {
        const int dk = 16 * wave + r;
        const float qd = bf1(zr[ZC_Q + h * DK + dk]), kd = bf1(zr[ZC_K + h * DK + dk]);
        const f32x4 sn = sv[r] * gam + v4 * kd;
        *(f32x4*)(s1 + (size_t)dk * DV) = sn;
        o4 += sn * qd;
    }
    LAS float* part = (LAS float*)(F.lds);
    *(LAS f32x4*)(part + wave * 256 + 4 * lane) = o4;
    __syncthreads();
    if (wave == 0) {
        f32x4 o = *(LAS f32x4*)(part + 4 * lane);
#pragma unroll
        for (int w = 1; w < 8; ++w) o += *(LAS f32x4*)(part + w * 256 + 4 * lane);
        const float mu = wave_sum((o.x + o.y) + (o.z + o.w)) * (1.0f / DV);
        o = o - mu;
        const float var = wave_sum((o.x * o.x + o.y * o.y) + (o.z * o.z + o.w * o.w)) * (1.0f / DV);
        const float rstd = 1.0f / sqrtf(var + EPS);
        const f32x4 g = *(const f32x4*)(F.gn_g + h * DV + 4 * lane);
        const v2u x = *(const GAS v2u*)(zr + ZC_BG + h * DV + 4 * lane);
        o = o * rstd * g; o.x *= bflo(x.x); o.y *= bfhi(x.x); o.z *= bflo(x.y); o.w *= bfhi(x.y);
        v2u wv; wv.x = pk2(o.x, o.y); wv.y = pk2(o.z, o.w);
        *(GAS v2u*)(F.YAB + (size_t)row * LDY + 1024 + h * DV + 4 * lane) = wv;
    }
    __syncthreads();
}

__device__ __forceinline__ void ret_c_unit(Frame& F, int unit) {
    const int bh = unit >> 4, c = unit & 15, b = bh >> 3, h = bh & 7, lane = fresh_lane(), wave = F.wave, hh = lane >> 5, l31 = lane & 31, tid_ = wave * 64 + lane;
    const float lg = lg2gamma(h);
    const int ti = wave & 3, wh = wave >> 2;
    const RowA ra = row_addr(lane); const TrA ta = tr_addr(lane);
    const int rowbase = b * SEQ + c * 128;
    const bf16* Zb = F.Z + (size_t)rowbase * LDZ;
    LAS unsigned char* Qi = F.lds; LAS unsigned char* Ki = F.lds + 32768; LAS unsigned char* Vi = F.lds + 65536;
#pragma unroll
    for (int i = 0; i < 4; ++i) { const int n = tid_ + 512 * i, row = n >> 4, ch = n & 15; const bf16* rp = Zb + (size_t)row * LDZ;
        const v4u q = *(const GAS v4u*)(rp + ZC_Q + h * DK + ch * 8), k = *(const GAS v4u*)(rp + ZC_K + h * DK + ch * 8);
        const unsigned o = (unsigned)(row >> 5) * 8192u + off_a(row & 31, ch);
        *(LAS v4u*)(Qi + o) = q; *(LAS v4u*)(Ki + o) = k; }
#pragma unroll
    for (int i = 0; i < 8; ++i) { const int n = tid_ + 512 * i, row = n >> 5, ch = n & 31;
        const v4u v = *(const GAS v4u*)(Zb + (size_t)row * LDZ + ZC_V + h * DV + ch * 8);
        *(LAS v4u*)(Vi + (unsigned)((row >> 5) * 2 + (ch >> 4)) * 8192u + off_a(row & 31, ch & 15)) = v; }
    __syncthreads();
    f32x16 X[2];
#pragma unroll
    for (int t = 0; t < 2; ++t) {
        const int sj = 2 * wh + t;
#pragma unroll
        for (int e = 0; e < 16; ++e) X[t][e] = 0.f;
        if (sj <= ti) {
#pragma unroll
            for (int ks = 0; ks < 8; ++ks) X[t] = MFMA32(frag_row(Ki + sj * 8192, ra, ks), frag_row(Qi + ti * 8192, ra, ks), X[t]);
        }
    }
    __syncthreads();
#pragma unroll
    for (int t = 0; t < 2; ++t) {
        const int sj = 2 * wh + t;
        if (sj <= ti) {
            const int tt = 32 * ti + l31;
#pragma unroll
            for (int g = 0; g < 4; ++g) {
                float p[4];
#pragma unroll
                for (int e = 0; e < 4; ++e) { const int s = 32 * sj + 8 * g + 4 * hh + e; const float f = __builtin_amdgcn_exp2f(-(float)(s + 1) * lg); p[e] = (s <= tt) ? X[t][4 * g + e] * f : 0.f; }
                v2u w; w.x = pk2(p[0], p[1]); w.y = pk2(p[2], p[3]);
                *(LAS v2u*)(Ki + ti * 8192 + off_a(l31, 4 * sj + g) + 8 * hh) = w;
            }
        }
    }
    __syncthreads();
    f32x16 O[4];
#pragma unroll
    for (int j = 0; j < 4; ++j)
#pragma unroll
        for (int e = 0; e < 16; ++e) O[j][e] = 0.f;
    for (int kk = 0; kk < 2 * (ti + 1); ++kk) {
        const bf16x8 a = frag_row(Ki + ti * 8192, ra, kk);
        const LAS unsigned char* vimg = Vi + ((kk >> 1) * 2 + wh) * 8192;
#pragma unroll
        for (int j = 0; j < 4; ++j) O[j] = MFMA32(a, frag_tr(vimg, ta, j, kk & 1), O[j]);
    }
    if (c > 0) {
        const bf16* sn = F.SN + ((size_t)(bh * 16 + c) * 256) * 128;
#pragma unroll
        for (int ks = 0; ks < 8; ++ks) {
            const bf16x8 a = frag_row(Qi + ti * 8192, ra, ks);
#pragma unroll
            for (int j = 0; j < 4; ++j) {
                const int dv = 128 * wh + 32 * j + l31;
                const bf16x8 bb = __builtin_bit_cast(bf16x8, *(const GAS v4u*)(sn + (size_t)dv * 128 + 16 * ks + 8 * hh));
                O[j] = MFMA32(a, bb, O[j]);
            }
            if (ks & 1) asm volatile("" ::: "memory");
        }
    }
    LAS float* st = (LAS float*)(F.lds + STAT_OFF);
    float mu[16], rs[16];
#pragma unroll
    for (int e = 0; e < 16; ++e) {
        const float f = __builtin_amdgcn_exp2f((float)(crow(e, hh) + 32 * ti + 1) * lg);
        float s = 0.f;
#pragma unroll
        for (int j = 0; j < 4; ++j) { O[j][e] *= f; s += O[j][e]; }
        s += __shfl_xor(s, 1); s += __shfl_xor(s, 2); s += __shfl_xor(s, 4); s += __shfl_xor(s, 8); s += __shfl_xor(s, 16);
        if (l31 == 0) st[(32 * ti + crow(e, hh)) * 2 + wh] = s;
    }
    __syncthreads();
#pragma unroll
    for (int e = 0; e < 16; ++e) { const int r = 32 * ti + crow(e, hh); mu[e] = (st[r * 2] + st[r * 2 + 1]) * (1.0f / DV); }
#pragma unroll
    for (int e = 0; e < 16; ++e) {
        float s = 0.f;
#pragma unroll
        for (int j = 0; j < 4; ++j) { O[j][e] -= mu[e]; s += O[j][e] * O[j][e]; }
        s += __shfl_xor(s, 1); s += __shfl_xor(s, 2); s += __shfl_xor(s, 4); s += __shfl_xor(s, 8); s += __shfl_xor(s, 16);
        if (l31 == 0) st[256 + (32 * ti + crow(e, hh)) * 2 + wh] = s;
    }
    __syncthreads();
#pragma unroll
    for (int e = 0; e < 16; ++e) { const int r = 32 * ti + crow(e, hh); rs[e] = 1.0f / sqrtf((st[256 + r * 2] + st[256 + r * 2 + 1]) * (1.0f / DV) + EPS); }
    float gn[4];
#pragma unroll
    for (int j = 0; j < 4; ++j) gn[j] = F.gn_g[h * DV + 128 * wh + 32 * j + l31];
#pragma unroll
    for (int e = 0; e < 16; ++e) {
        const int row = rowbase + 32 * ti + crow(e, hh);
        const bf16* zr = F.Z + (size_t)row * LDZ + ZC_BG + h * DV + 128 * wh + l31;
        bf16* yr = F.YAB + (size_t)row * LDY + 1024 + h * DV + 128 * wh + l31;
#pragma unroll
        for (int j = 0; j < 4; ++j) yr[32 * j] = (bf16)f2bf(O[j][e] * rs[e] * gn[j] * bf1(zr[32 * j]));
        asm volatile("" ::: "memory");
    }
    __syncthreads();
}

__device__ __forceinline__ void final_row(Frame& F, const float* xrow, float* yrow, const float* ssrow, const float* gaterow) {
    const float s = ssrow[F.lane];
    const float rstd = 1.0f / sqrtf(wave_sum(s) * (1.0f / DM) + EPS);
#pragma unroll
    for (int j = 0; j < 8; ++j) {
        const int col = 4 * F.lane + 256 * j;
        const f32x4 x = *(const f32x4*)(xrow + col), o = *(const f32x4*)(yrow + col), g = *(const f32x4*)(F.g_post + col), gt = *(const f32x4*)(gaterow + col);
        *(f32x4*)(yrow + col) = x + gt * (o * rstd * g);
    }
}

struct Args { const float* in[19]; float* out; unsigned char* ws; int ph_lo, ph_hi; };
constexpr int N_PHASES = 8;
__global__ void __launch_bounds__(NWAVES * 64, 2) hybrid_fwd(Args args) {
    extern __shared__ __attribute__((aligned(16))) unsigned char lds[];
    Frame F;
    F.lds = (LAS unsigned char*)lds;
    F.MISC = (volatile LAS unsigned*)(F.lds + MISC_OFF);
    F.wave = __builtin_amdgcn_readfirstlane((int)threadIdx.x >> 6); F.lane = fresh_lane(); F.tid = F.wave * 64 + F.lane;
    F.G = gridDim.x; { const int bx = blockIdx.x; F.vcu = (F.G % 8 == 0) ? (bx % 8) * (F.G / 8) + bx / 8 : bx; }
    unsigned char* ws = args.ws;
    F.ctl = (gu32*)(ws + WS_CTL);
    F.x_p = args.in[0]; F.x_s = args.in[1]; F.st_pool = args.in[2]; F.st_ret = args.in[3]; F.c_p = args.in[4]; F.c_s = args.in[5]; F.ada_w = args.in[6]; F.ada_b = args.in[7];
    F.g_pre = args.in[8]; F.g_post = args.in[9]; F.w_in = args.in[10]; F.pool_w = args.in[11]; F.pool_scale = args.in[12]; F.gn_g = args.in[13]; F.w_a = args.in[14]; F.w_b = args.in[15];
    F.w_merge = args.in[16]; F.b_merge = args.in[17]; F.w_out = args.in[18]; F.out = args.out;
    F.ropec = (float*)(ws + WS_ROPE); F.ropes = F.ropec + 2049 * 64; F.mod = (float*)(ws + WS_MOD); F.ss = (float*)(ws + WS_SS);
    F.Wcat = (bf16*)(ws + WS_WCAT); F.Wab = (bf16*)(ws + WS_WAB); F.Wout = (bf16*)(ws + WS_WOUT); F.PoolW = (bf16*)(ws + WS_POOLW);
    F.H = (bf16*)(ws + WS_H); F.Z = (bf16*)(ws + WS_Z); F.YAB = (bf16*)(ws + WS_YAB); F.POOLED = (bf16*)(ws + WS_POOLED); F.SN = (bf16*)(ws + WS_SN); F.MB = (bf16*)(ws + WS_MB);
    for (int u = F.tid; u < (LDS_BYTES - LDSCTL_OFF) / 4; u += NWAVES * 64) ((LAS unsigned*)(F.lds + LDSCTL_OFF))[u] = 0u;
    __syncthreads();
    const int lo = args.ph_lo, hi = args.ph_hi;
    XcdBarrier bar; bar.bar = (unsigned*)(F.ctl + CW_BAR); bar.x = 0; bar.st = nullptr; bar.wave = F.wave;
    if (hi - lo > 1) bar = xcd_barrier_post((unsigned*)(F.ctl + CW_BAR), F.MISC + 8, F.wave);
#define IN(k) (lo <= (k) && (k) < hi)
#define PHASE_BEGIN() do { F.lane = fresh_lane(); F.tid = F.wave * 64 + F.lane; } while (0)
#define SEAM(k) do { if (IN(k) && IN((k) + 1)) xcd_barrier(bar); } while (0)
    const int gw = F.vcu * NWAVES + F.wave, NGW = F.G * NWAVES;

    if (((PH_MASK >> 0) & 1) && IN(0)) { PHASE_BEGIN(); p0_prologue(F); } SEAM(0);

    if (((PH_MASK >> 1) & 1) && IN(1)) { PHASE_BEGIN();
        for (int m = gw; m < MP + MS; m += NGW) {
            const float* xr = m < MP ? F.x_p + (size_t)m * DM : F.x_s + (size_t)(m - MP) * DM;
            const float* mr = F.mod + (size_t)(m < MP ? (m >> 11) : 4 + (m - MP)) * 6144;
            h_row(F, xr, mr, F.H + (size_t)m * DM);
        }
    } SEAM(1);

    if (((PH_MASK >> 2) & 1) && IN(2)) { PHASE_BEGIN();
        pg8::Gemm g{F.H, F.Wcat, DM, DM, DM, 0}; pg8::StaticOrder S; S.init(MP, LDZ, F.G, (int)blockIdx.x);
        EpiZ E{F.Z, F.b_merge, F.ropec, F.ropes, F.out + O_PP, F.out + O_PS};
        pg8::gemm_phase<EpiZ, pg8::StaticOrder, true, true>(F.lds + RING_OFF, g, S, E, F.tid);
        PHASE_BEGIN();
        { pg8::Gemm gs{F.H + (size_t)MP * DM, F.Wcat, DM, DM, DM, 0}; pg8::sgemm_phase<EpiZ>(F.lds + RING_OFF, gs, MP, LDZ / 64, F.vcu, F.G, E, F.tid); }
    } SEAM(2);

    if (((PH_MASK >> 3) & 1) && IN(3)) { PHASE_BEGIN();
        for (int u = F.vcu; u < 64; u += F.G) ret_ab_unit(F, u);
        PHASE_BEGIN();
        pooled_prompt(F);
        pooled_sample(F);
        PHASE_BEGIN();
        for (int it = F.vcu; it < MS * NH; it += F.G) ret_sample_item(F, it);
    } SEAM(3);

    if (((PH_MASK >> 4) & 1) && IN(4)) { PHASE_BEGIN();
        for (int u = F.vcu; u < 512; u += F.G) ret_c_unit(F, u);
        PHASE_BEGIN();
        pg8::Gemm g{F.POOLED, F.PoolW, 256, DPOOL, 256, 512}; pg8::StaticOrder S; S.init(MT, DPOOL, F.G, (int)blockIdx.x);
        EpiPool E{F.YAB, F.Z, F.pool_scale};
        pg8::gemm_phase<EpiPool, pg8::StaticOrder, true, true>(F.lds + RING_OFF, g, S, E, F.tid);
    } SEAM(4);

    if (((PH_MASK >> 5) & 1) && IN(5)) { PHASE_BEGIN();
        pg8::Gemm g{F.YAB, F.Wab, LDY, LDY, LDY, 0}; pg8::StaticOrder S; S.init(MP, DM, F.G, (int)blockIdx.x);
        EpiMerge E{F.MB, F.Z};
        pg8::gemm_phase<EpiMerge, pg8::StaticOrder, true, true>(F.lds + RING_OFF, g, S, E, F.tid);
        PHASE_BEGIN();
        { pg8::Gemm gs{F.YAB + (size_t)MP * LDY, F.Wab, LDY, LDY, LDY, 0}; pg8::sgemm_phase<EpiMerge>(F.lds + RING_OFF, gs, MP, DM / 64, F.vcu, F.G, E, F.tid); }
    } SEAM(5);

    if (((PH_MASK >> 6) & 1) && IN(6)) { PHASE_BEGIN();
        pg8::Gemm g{F.MB, F.Wout, DM, DM, DM, 0}; pg8::StaticOrder S; S.init(MP, DM, F.G, (int)blockIdx.x);
        EpiOut E{F.out, F.ss};
        pg8::gemm_phase<EpiOut, pg8::StaticOrder, true, true>(F.lds + RING_OFF, g, S, E, F.tid);
        PHASE_BEGIN();
        { pg8::Gemm gs{F.MB + (size_t)MP * DM, F.Wout, DM, DM, DM, 0}; pg8::sgemm_phase<EpiOut>(F.lds + RING_OFF, gs, MP, DM / 64, F.vcu, F.G, E, F.tid); }
    } SEAM(6);

    if (((PH_MASK >> 7) & 1) && IN(7)) { PHASE_BEGIN();
        for (int m = gw; m < MP + MS; m += NGW) {
            const float* xr = m < MP ? F.x_p + (size_t)m * DM : F.x_s + (size_t)(m - MP) * DM;
            float* yr = F.out + (m < MP ? O_YP + (size_t)m * DM : O_YS + (size_t)(m - MP) * DM);
            const float* gr = F.mod + (size_t)(m < MP ? (m >> 11) : 4 + (m - MP)) * 6144 + 2 * DM;
            final_row(F, xr, yr, F.ss + (size_t)m * 64, gr);
        }
    }
#undef IN
#undef SEAM
}

extern "C" void kernel_launch(void* const* d_in, const int* in_sizes, int n_in, void* d_out, int out_size, void* d_ws, size_t ws_size, hipStream_t stream) {
    static int grid = 0;
    if (grid == 0) {
        if (n_in != 19 || ws_size < WS_END) { fprintf(stderr, "kernel_launch: unexpected inputs (n_in %d, ws %zu)\n", n_in, ws_size); grid = -1; return; }
        int dev = 0, cus = 0, per_cu = 0;
        if (hipGetDevice(&dev) != hipSuccess || hipDeviceGetAttribute(&cus, hipDeviceAttributeMultiprocessorCount, dev) != hipSuccess) { grid = -1; return; }
        if (hipFuncSetAttribute((const void*)hybrid_fwd, hipFuncAttributeMaxDynamicSharedMemorySize, LDS_BYTES) != hipSuccess) { fprintf(stderr, "kernel_launch: hipFuncSetAttribute failed\n"); grid = -1; return; }
        if (hipOccupancyMaxActiveBlocksPerMultiprocessor(&per_cu, (const void*)hybrid_fwd, NWAVES * 64, LDS_BYTES) != hipSuccess || per_cu < 1) { fprintf(stderr, "kernel_launch: occupancy query says %d\n", per_cu); per_cu = 1; }
        (void)hipGetLastError();
        grid = cus;
    }
    if (grid < 0) return;
    (void)hipMemsetAsync((char*)d_ws + WS_CTL, 0, CTL_ZERO_BYTES, stream);
    Args a{};
    for (int i = 0; i < 19; ++i) a.in[i] = (const float*)d_in[i];
    a.out = (float*)d_out; a.ws = (unsigned char*)d_ws;
    if (MK_N_LAUNCHES == 1) { a.ph_lo = 0; a.ph_hi = N_PHASES; hipLaunchKernelGGL(hybrid_fwd, dim3(grid), dim3(NWAVES * 64), LDS_BYTES, stream, a); }
    else for (int p = 0; p < N_PHASES; ++p) { a.ph_lo = p; a.ph_hi = p + 1; hipLaunchKernelGGL(hybrid_fwd, dim3(grid), dim3(NWAVES * 64), LDS_BYTES, stream, a); }
}
```

```cpp
#include <hip/hip_runtime.h>
#include <cstdio>
#include <cstdint>

#ifndef PH_MASK
#define PH_MASK 255
#endif
#ifndef REP_PHASE
#define REP_PHASE -1
#define REP_N 1
#endif
#ifndef MK_N_LAUNCHES
#define MK_N_LAUNCHES 1
#endif

namespace pg8 {
#define PG8_LAS __attribute__((address_space(3)))
typedef unsigned short bf16_t;
typedef short bf16x8 __attribute__((ext_vector_type(8)));
typedef float f32x4 __attribute__((ext_vector_type(4)));
typedef unsigned u32x4 __attribute__((ext_vector_type(4)));
typedef unsigned u32x2 __attribute__((ext_vector_type(2)));
constexpr int BM = 256, BK = 64, HALF = 128, HTB = HALF * BK * 2  , STAGE_BYTES = 8 * HTB, NXCD = 8, WGM = 8;

__host__ __device__ __forceinline__ int lds_byte(int r, int c) { const int st = (r >> 4) * 2 + (c >> 5), rr = r & 15, cc = c & 31, ob = rr * 64 + cc * 2; return st * 1024 + (ob ^ (((ob >> 9) & 1) << 5)); }
__host__ __device__ __forceinline__ void stage_rc(int b, int& R, int& C) { const int st = b / 1024, sb = b % 1024, swz = sb ^ (((sb >> 9) & 1) << 5); R = (st >> 1) * 16 + swz / 64; C = (st & 1) * 32 + (swz % 64) / 2; }
__host__ __device__ __forceinline__ int perm32(int rho) { const int n = rho >> 4, i = rho & 15; return 8 * (i >> 2) + 4 * n + (i & 3); }

struct Unit { int pm, pn; };
struct Gemm { const bf16_t* A; const bf16_t* Bt; int K, lda, ldb, a_pn_bytes; };

struct StaticOrder {
    int nM, nN, nwg, G, c;
    __host__ __device__ void init(int M, int N, int G_, int c_) { nM = M / BM; nN = N / BM; nwg = nM * nN; G = G_; c = c_; }
    __host__ __device__ bool next(int i, Unit& u) const {
        const long L = (long)i * G + c; if (L >= nwg) return false;
        int wgid = (int)L; { const int q = nwg / NXCD, r = nwg % NXCD, xcd = wgid % NXCD, off = wgid / NXCD; wgid = (xcd < r ? xcd * (q + 1) : r * (q + 1) + (xcd - r) * q) + off; }
        const int nig = WGM * nN, gid = wgid / nig, fm = gid * WGM, gsz = (nM - fm) < WGM ? (nM - fm) : WGM;
        u.pm = fm + ((wgid % nig) % gsz); u.pn = (wgid % nig) / gsz; return true;
    }
};

__device__ __forceinline__ unsigned cvt_pk_bf16(float lo, float hi) { unsigned r; asm volatile("v_cvt_pk_bf16_f32 %0, %1, %2" : "=v"(r) : "v"(lo), "v"(hi)); return r; }
__device__ __forceinline__ float bf_lo(unsigned w) { return __uint_as_float(w << 16); }
__device__ __forceinline__ float bf_hi(unsigned w) { return __uint_as_float(w & 0xffff0000u); }
__device__ __forceinline__ float sigmoidf_(float v) { return __builtin_amdgcn_rcpf(1.0f + __builtin_amdgcn_exp2f(-1.4426950408889634f * v)); }


template <class Epi, class Sched, bool ALIGN_EPI = false, bool SP2 = false>
__device__ __forceinline__ void gemm_phase(PG8_LAS unsigned char* lds, const Gemm g, const Sched& S, const Epi& E, const int tid) {
    const int wid = __builtin_amdgcn_readfirstlane(tid >> 6), lane = tid & 63, wr = wid >> 2, wc = wid & 3, fr = lane & 15, fq = lane >> 4;
    const int K = g.K, nt = K / BK;
    unsigned voffA[2], voffB[2];
#pragma unroll
    for (int i = 0; i < 2; ++i) { int R, C; stage_rc(tid * 16 + i * 8192, R, C); const int Rb = Epi::PERM ? ((R & ~31) + perm32(R & 31)) : R;
        voffA[i] = (unsigned)(R * g.lda + C) * 2u; voffB[i] = (unsigned)(Rb * g.ldb + C) * 2u; }
    const size_t kstep = (size_t)(BK * 2);
    const size_t hstepA = (size_t)HALF * g.lda * 2, hstepB = (size_t)HALF * g.ldb * 2;
    const size_t tstepA = 2 * hstepA, tstepB = 2 * hstepB;
    const unsigned ldsw = (unsigned)wid * 1024u;
    const int aoff = lds_byte(wr * 64 + fr, fq * 8), boff = lds_byte(wc * 32 + fr, fq * 8);
#define PG8_SA(b, h) (((b) * 2 + (h)) * HTB)
#define PG8_SB(b, h) ((4 + (b) * 2 + (h)) * HTB)
#define PG8_STAGE(bufoff, gbase, voff) do { _Pragma("unroll") for (int _i = 0; _i < 2; ++_i) \
        __builtin_amdgcn_global_load_lds((const unsigned*)((const char*)(gbase) + (voff)[_i]), (PG8_LAS unsigned*)(lds + (bufoff) + ldsw + _i * 8192), 16, 0, 0); } while (0)
#define PG8_LDA(dst, b, h) do { _Pragma("unroll") for (int m = 0; m < 4; ++m) _Pragma("unroll") for (int k = 0; k < 2; ++k) dst[m][k] = *(const PG8_LAS bf16x8*)(lds + PG8_SA(b, h) + aoff + m * 2048 + k * 1024); } while (0)
#define PG8_LDB(dst, b, h) do { _Pragma("unroll") for (int n = 0; n < 2; ++n) _Pragma("unroll") for (int k = 0; k < 2; ++k) dst[n][k] = *(const PG8_LAS bf16x8*)(lds + PG8_SB(b, h) + boff + n * 2048 + k * 1024); } while (0)
#define PG8_MMA(ai, bj, At, Bt) do { __builtin_amdgcn_s_setprio(1); _Pragma("unroll") for (int m = 0; m < 4; ++m) _Pragma("unroll") for (int n = 0; n < 2; ++n) _Pragma("unroll") for (int k = 0; k < 2; ++k) \
        acc[ai][bj][m][n] = __builtin_amdgcn_mfma_f32_16x16x32_bf16(Bt[n][k], At[m][k], acc[ai][bj][m][n], 0, 0, 0); __builtin_amdgcn_s_setprio(0); } while (0)
#define PG8_WAIT_V(n) asm volatile("s_waitcnt vmcnt(" #n ")" ::: "memory")
#define PG8_WAIT_L(n) asm volatile("s_waitcnt lgkmcnt(" #n ")" ::: "memory")
#define PG8_BAR __builtin_amdgcn_s_barrier()
#define PG8_SCHED __builtin_amdgcn_sched_barrier(0)
    Unit cur, nxt; int ui = 0;
    if (!S.next(0, cur)) return;
    f32x4 acc[2][2][4][2];
#pragma unroll
    for (int a = 0; a < 2; ++a)
#pragma unroll
        for (int b = 0; b < 2; ++b)
#pragma unroll
            for (int m = 0; m < 4; ++m)
#pragma unroll
                for (int n = 0; n < 2; ++n) acc[a][b][m][n] = (f32x4){0.f, 0.f, 0.f, 0.f};
    bf16x8 At[4][2], B0[2][2], B1[2][2];
    const char* cA = (const char*)g.A + (size_t)cur.pm * tstepA + (size_t)cur.pn * g.a_pn_bytes; const char* cB = (const char*)g.Bt + (size_t)cur.pn * tstepB;
    if constexpr (SP2) {
        PG8_STAGE(PG8_SB(0, 0), cB, voffB); PG8_STAGE(PG8_SB(0, 1), cB + hstepB, voffB); PG8_STAGE(PG8_SA(0, 0), cA, voffA); PG8_STAGE(PG8_SA(0, 1), cA + hstepA, voffA);
        if (wr == 1) PG8_BAR;
        PG8_WAIT_V(2); PG8_BAR;
        PG8_STAGE(PG8_SB(1, 0), cB + kstep, voffB); PG8_STAGE(PG8_SA(1, 0), cA + kstep, voffA); PG8_STAGE(PG8_SB(1, 1), cB + hstepB + kstep, voffB);
        PG8_WAIT_V(6); PG8_BAR;
    } else {
        PG8_STAGE(PG8_SB(0, 0), cB, voffB); PG8_STAGE(PG8_SA(0, 0), cA, voffA); PG8_STAGE(PG8_SB(0, 1), cB + hstepB, voffB); PG8_STAGE(PG8_SA(0, 1), cA + hstepA, voffA);
        if (wr == 1) PG8_BAR;
        PG8_WAIT_V(4); PG8_BAR;
        PG8_STAGE(PG8_SB(1, 0), cB + kstep, voffB); PG8_STAGE(PG8_SA(1, 0), cA + kstep, voffA); PG8_STAGE(PG8_SB(1, 1), cB + hstepB + kstep, voffB);
        PG8_WAIT_V(6); PG8_BAR;
    }
    for (;;) {
        const bool has_next = S.next(ui + 1, nxt);
        const char* nA = has_next ? (const char*)g.A + (size_t)nxt.pm * tstepA + (size_t)nxt.pn * g.a_pn_bytes : cA; const char* nB = has_next ? (const char*)g.Bt + (size_t)nxt.pn * tstepB : cB;
        for (int t = 0; t < nt; t += 2) {
            if constexpr (Epi::MID_T > 0) { if (t == Epi::MID_T) {
#pragma unroll
                for (int ai = 0; ai < 2; ++ai)
#pragma unroll
                    for (int bj = 0; bj < 2; ++bj) E.template mid<4>(acc[ai][bj], cur.pm * BM + ai * HALF + wr * 64 + fr, cur.pn * BM + bj * HALF + wc * 32, fq); } }
            const bool last = (t == nt - 2);
            const char* a1 = cA + (size_t)(t + 1) * kstep;
            const char* a2 = last ? nA : cA + (size_t)(t + 2) * kstep; const char* b2 = last ? nB : cB + (size_t)(t + 2) * kstep;
            const char* a3 = a2 + kstep; const char* b3 = b2 + kstep;
            if constexpr (SP2) {
            PG8_LDB(B0, 0, 0); PG8_LDB(B1, 0, 1); PG8_SCHED; PG8_LDA(At, 0, 0); PG8_STAGE(PG8_SA(1, 1), a1 + hstepA, voffA);
            PG8_WAIT_V(8); PG8_WAIT_L(0); PG8_BAR; PG8_MMA(0, 0, At, B0); PG8_MMA(0, 1, At, B1); PG8_BAR; PG8_SCHED;
            PG8_LDA(At, 0, 1); PG8_STAGE(PG8_SB(0, 0), b2, voffB); PG8_STAGE(PG8_SB(0, 1), b2 + hstepB, voffB); PG8_STAGE(PG8_SA(0, 0), a2, voffA);
            PG8_WAIT_V(8); PG8_WAIT_L(0); PG8_BAR; PG8_MMA(1, 0, At, B0); PG8_MMA(1, 1, At, B1); PG8_BAR; PG8_SCHED;
            PG8_LDB(B0, 1, 0); PG8_LDB(B1, 1, 1); PG8_SCHED; PG8_LDA(At, 1, 0); PG8_STAGE(PG8_SA(0, 1), a2 + hstepA, voffA);
            PG8_WAIT_V(8); PG8_WAIT_L(0); PG8_BAR; PG8_MMA(0, 0, At, B0); PG8_MMA(0, 1, At, B1); PG8_BAR; PG8_SCHED;
            PG8_LDA(At, 1, 1); PG8_STAGE(PG8_SB(1, 0), b3, voffB); PG8_STAGE(PG8_SB(1, 1), b3 + hstepB, voffB); PG8_STAGE(PG8_SA(1, 0), a3, voffA);
            PG8_WAIT_V(8); PG8_WAIT_L(0); PG8_BAR; PG8_MMA(1, 0, At, B0); PG8_MMA(1, 1, At, B1); PG8_BAR; PG8_SCHED;
            } else {
            PG8_LDB(B0, 0, 0); PG8_SCHED; PG8_LDA(At, 0, 0); PG8_STAGE(PG8_SA(1, 1), a1 + hstepA, voffA);
            PG8_WAIT_L(8); PG8_BAR; PG8_WAIT_L(0); PG8_MMA(0, 0, At, B0); PG8_BAR; PG8_SCHED;
            PG8_LDB(B1, 0, 1); PG8_STAGE(PG8_SB(0, 0), b2, voffB);
            PG8_BAR; PG8_WAIT_L(0); PG8_MMA(0, 1, At, B1); PG8_BAR;
            PG8_LDA(At, 0, 1); PG8_STAGE(PG8_SA(0, 0), a2, voffA);
            PG8_BAR; PG8_WAIT_L(0); PG8_MMA(1, 0, At, B0); PG8_BAR; PG8_SCHED;
            PG8_STAGE(PG8_SB(0, 1), b2 + hstepB, voffB);
            PG8_WAIT_V(6); PG8_BAR; PG8_MMA(1, 1, At, B1); PG8_BAR;
            PG8_LDB(B0, 1, 0); PG8_SCHED; PG8_LDA(At, 1, 0); PG8_STAGE(PG8_SA(0, 1), a2 + hstepA, voffA);
            PG8_WAIT_L(8); PG8_BAR; PG8_WAIT_L(0); PG8_MMA(0, 0, At, B0); PG8_BAR; PG8_SCHED;
            PG8_LDB(B1, 1, 1); PG8_STAGE(PG8_SB(1, 0), b3, voffB);
            PG8_BAR; PG8_WAIT_L(0); PG8_MMA(0, 1, At, B1); PG8_BAR;
            PG8_LDA(At, 1, 1); PG8_STAGE(PG8_SA(1, 0), a3, voffA);
            PG8_BAR; PG8_WAIT_L(0); PG8_MMA(1, 0, At, B0); PG8_BAR; PG8_SCHED;
            PG8_STAGE(PG8_SB(1, 1), b3 + hstepB, voffB);
            PG8_WAIT_V(6); PG8_BAR; PG8_MMA(1, 1, At, B1); PG8_BAR;
            }
        }
        if constexpr (ALIGN_EPI) { if (wr == 0) PG8_BAR; }
#pragma unroll
        for (int ai = 0; ai < 2; ++ai)
#pragma unroll
            for (int bj = 0; bj < 2; ++bj) E.template core<4>(acc[ai][bj], cur.pm * BM + ai * HALF + wr * 64 + fr, cur.pn * BM + bj * HALF + wc * 32, fq);
        if (!has_next) break;
#pragma unroll
        for (int a = 0; a < 2; ++a)
#pragma unroll
            for (int b = 0; b < 2; ++b)
#pragma unroll
                for (int m = 0; m < 4; ++m)
#pragma unroll
                    for (int n = 0; n < 2; ++n) acc[a][b][m][n] = (f32x4){0.f, 0.f, 0.f, 0.f};
        cur = nxt; cA = nA; cB = nB; ++ui;
        if constexpr (ALIGN_EPI) { if (wr == 1) PG8_BAR; }
    }
    PG8_WAIT_V(0);
    if constexpr (!ALIGN_EPI) { if (wr == 0) PG8_BAR; }
    PG8_BAR;
#undef PG8_SA
#undef PG8_SB
#undef PG8_STAGE
#undef PG8_LDA
#undef PG8_LDB
#undef PG8_MMA
#undef PG8_WAIT_V
#undef PG8_WAIT_L
#undef PG8_BAR
#undef PG8_SCHED
}

template <class Epi>
__device__ __forceinline__ void sgemm_phase(PG8_LAS unsigned char* lds, const Gemm g, const int row_base, const int n_units, const int first, const int stride, const Epi& E, const int tid) {
    const int wid = __builtin_amdgcn_readfirstlane(tid >> 6), lane = tid & 63, wr = wid >> 1, wc = wid & 1, fr = lane & 15, fq = lane >> 4;
    const int nt = g.K / BK;
    unsigned voffA[2], voffB;
#pragma unroll
    for (int i = 0; i < 2; ++i) { int R, C; stage_rc(tid * 16 + i * 8192, R, C); voffA[i] = (unsigned)(R * g.lda + C) * 2u;
        if (i == 0) { const int Rb = Epi::PERM ? ((R & ~31) + perm32(R & 31)) : R; voffB = (unsigned)(Rb * g.ldb + C) * 2u; } }
    const unsigned ldsw = (unsigned)wid * 1024u;
    const int aoff = lds_byte(wr * 32 + fr, fq * 8), boff = 16384 + lds_byte(wc * 32 + fr, fq * 8);
    constexpr int SLOT = 24576;
#define SG_STAGE(slot, pa, pb) do { \
        __builtin_amdgcn_global_load_lds((const unsigned*)((pa) + voffA[0]), (PG8_LAS unsigned*)(lds + (slot) * SLOT + ldsw), 16, 0, 0); \
        __builtin_amdgcn_global_load_lds((const unsigned*)((pa) + voffA[1]), (PG8_LAS unsigned*)(lds + (slot) * SLOT + ldsw + 8192), 16, 0, 0); \
        __builtin_amdgcn_global_load_lds((const unsigned*)((pb) + voffB), (PG8_LAS unsigned*)(lds + (slot) * SLOT + 16384 + ldsw), 16, 0, 0); } while (0)
    const char* cA = (const char*)g.A;
    for (int ui = first; ui < n_units; ui += stride) {
        const char* cB = (const char*)g.Bt + (size_t)ui * 64 * g.ldb * 2;
        f32x4 acc[2][2];
#pragma unroll
        for (int m = 0; m < 2; ++m)
#pragma unroll
            for (int n = 0; n < 2; ++n) acc[m][n] = (f32x4){0.f, 0.f, 0.f, 0.f};
        SG_STAGE(0, cA, cB); SG_STAGE(1, cA + 128, cB + 128); SG_STAGE(2, cA + 256, cB + 256);
        for (int t = 0; t < nt; ++t) {
            if constexpr (Epi::MID_T > 0) { if (t == Epi::MID_T) E.template mid<2>(acc, row_base + wr * 32 + fr, ui * 64 + wc * 32, fq); }
            asm volatile("s_waitcnt vmcnt(6)" ::: "memory"); __builtin_amdgcn_s_barrier();
            { const int tn = (t + 3 < nt) ? t + 3 : nt - 1; const int sl = (t + 3) & 3; SG_STAGE(sl, cA + (size_t)tn * 128, cB + (size_t)tn * 128); }
            const PG8_LAS unsigned char* sp = lds + (t & 3) * SLOT;
            bf16x8 At[2][2], Bt[2][2];
#pragma unroll
            for (int m = 0; m < 2; ++m)
#pragma unroll
                for (int k = 0; k < 2; ++k) At[m][k] = *(const PG8_LAS bf16x8*)(sp + aoff + m * 2048 + k * 1024);
#pragma unroll
            for (int n = 0; n < 2; ++n)
#pragma unroll
                for (int k = 0; k < 2; ++k) Bt[n][k] = *(const PG8_LAS bf16x8*)(sp + boff + n * 2048 + k * 1024);
            asm volatile("s_waitcnt lgkmcnt(0)" ::: "memory");
            __builtin_amdgcn_sched_barrier(0);
#pragma unroll
            for (int m = 0; m < 2; ++m)
#pragma unroll
                for (int n = 0; n < 2; ++n)
#pragma unroll
                    for (int k = 0; k < 2; ++k) acc[m][n] = __builtin_amdgcn_mfma_f32_16x16x32_bf16(Bt[n][k], At[m][k], acc[m][n], 0, 0, 0);
        }
        asm volatile("s_waitcnt vmcnt(0)" ::: "memory"); __builtin_amdgcn_s_barrier();
        E.template core<2>(acc, row_base + wr * 32 + fr, ui * 64 + wc * 32, fq);
    }
#undef SG_STAGE
}
}

constexpr int NWAVES = 8;
constexpr int DM = 2048, MP = 8192, MS = 128, SEQ = 2048, MT = 8448;
constexpr int DPOOL = 1024, NH = 8, DK = 128, DV = 256, DIN = 8192, LDZ = 12288, LDY = 3072;
constexpr int ZC_AX = 0, ZC_AG = 1024, ZC_Q = 2048, ZC_K = 3072, ZC_V = 4096, ZC_BG = 6144, ZC_GA = 8192, ZC_GB = 10240;
constexpr float EPS = 1e-6f;
constexpr int PAST = 16384;
constexpr size_t O_YP = 0, O_YS = 16777216, O_PP = 17039360, O_RP = 17100800, O_PS = 18149376, O_RS = 20115456;

constexpr size_t MiB = 1u << 20;
constexpr size_t WS_CTL = 0, CTL_ZERO_BYTES = 1 * MiB;
constexpr size_t WS_ROPE = 1 * MiB;
constexpr size_t WS_MOD = 3 * MiB;
constexpr size_t WS_SS = 7 * MiB;
constexpr size_t WS_WCAT = 16 * MiB;
constexpr size_t WS_WAB = 64 * MiB;
constexpr size_t WS_WOUT = 76 * MiB;
constexpr size_t WS_POOLW = 84 * MiB;
constexpr size_t WS_H = 96 * MiB;
constexpr size_t WS_Z = 130 * MiB;
constexpr size_t WS_YAB = 328 * MiB;
constexpr size_t WS_POOLED = 378 * MiB;
constexpr size_t WS_SN = 396 * MiB;
constexpr size_t WS_MB = 428 * MiB;
constexpr size_t WS_END = 462 * MiB;
constexpr int CW_BAR = 4096;

constexpr int RING_OFF = 0, RING_BYTES = 131072;
constexpr int LDSCTL_OFF = RING_BYTES, MISC_OFF = LDSCTL_OFF + 320;
constexpr int STAT_OFF = RING_BYTES + 1024;
constexpr int LDS_BYTES = 147456;

#define GAS __attribute__((address_space(1)))
#define LAS __attribute__((address_space(3)))
typedef unsigned short bf16;
typedef unsigned v4u __attribute__((ext_vector_type(4)));
typedef unsigned v2u __attribute__((ext_vector_type(2)));
typedef float f32x4 __attribute__((ext_vector_type(4)));
typedef float f32x16 __attribute__((ext_vector_type(16)));
typedef short bf16x8 __attribute__((ext_vector_type(8)));
typedef short s16x4 __attribute__((ext_vector_type(4)));
typedef GAS unsigned gu32;
#define RLX_AGENT __ATOMIC_RELAXED, __HIP_MEMORY_SCOPE_AGENT
#define LDS_WAIT() asm volatile("s_waitcnt lgkmcnt(0)" ::: "memory")
#define VM_WAIT() asm volatile("s_waitcnt vmcnt(0)" ::: "memory")
__device__ __forceinline__ unsigned f2bf(float f) { unsigned u = __builtin_bit_cast(unsigned, f); return (u + 0x7fffu + ((u >> 16) & 1u)) >> 16; }
__device__ __forceinline__ unsigned pk2(float lo, float hi) { return f2bf(lo) | (f2bf(hi) << 16); }
__device__ __forceinline__ float bflo(unsigned w) { return __uint_as_float(w << 16); }
__device__ __forceinline__ float bfhi(unsigned w) { return __uint_as_float(w & 0xffff0000u); }
__device__ __forceinline__ float bf1(bf16 b) { return __uint_as_float((unsigned)b << 16); }
__device__ __forceinline__ float silu_(float v) { return v * __builtin_amdgcn_rcpf(1.0f + __builtin_amdgcn_exp2f(-1.4426950408889634f * v)); }
__device__ __forceinline__ float wave_sum(float v) {
#pragma unroll
    for (int o = 1; o < 64; o <<= 1) v += __shfl_xor(v, o);
    return v;
}
__device__ __forceinline__ float lg2gamma(int h) {
    const float t[8] = {-0.04580368961312479f, -0.02272007650008353f, -0.011315313227834146f, -0.005646563141142063f, -0.0028205190623786626f, -0.0014095702546713536f, -0.0007046129765893727f, -0.0003522634716290214f};
    float r = t[0];
#pragma unroll
    for (int i = 1; i < 8; ++i) r = (h == i) ? t[i] : r;
    return r;
}

__device__ __forceinline__ int fresh_lane() { unsigned m_ = ~0u; asm volatile("" : "+s"(m_)); return (int)__builtin_amdgcn_mbcnt_hi(m_, __builtin_amdgcn_mbcnt_lo(m_, 0u)); }
#define XB_TMO      128
#define XB_XCNT(j)  (256  + 64 * (j))
#define XB_XSUB(j)  (1280 + 64 * (j))
#define XB_XGEN(j)  (2304 + 64 * (j))
#define XB_TOP      3328
#define XB_TOPGEN   3392
#define XCD_BAR_WORDS 3456
#define XB_SPIN_CAP (1u << 18)
__device__ __forceinline__ unsigned xb_ld(unsigned* p)              { return __hip_atomic_load(p, __ATOMIC_RELAXED, __HIP_MEMORY_SCOPE_AGENT); }
__device__ __forceinline__ unsigned xb_add(unsigned* p, unsigned v) { return __hip_atomic_fetch_add(p, v, __ATOMIC_RELAXED, __HIP_MEMORY_SCOPE_AGENT); }
__device__ __forceinline__ unsigned xb_xcc_id() { return (unsigned)__builtin_amdgcn_s_getreg((3 << 11) | 20) & 0xFu; }
#define XB_SPIN(cond, bar) do { unsigned _sp = 0; while (cond) { __builtin_amdgcn_s_sleep(1); \
    if ((++_sp & 255u) == 0u) { if (xb_ld(&(bar)[XB_TMO])) break; if (_sp > XB_SPIN_CAP) { atomicAdd(&(bar)[XB_TMO], 1u); break; } } } } while (0)
struct XcdBarrier { unsigned* bar; unsigned x; volatile LAS unsigned* st; int wave; };
__device__ __forceinline__ XcdBarrier xcd_barrier_post(unsigned* bar, volatile LAS unsigned* st, int wave) {
    XcdBarrier b; b.bar = bar; b.x = xb_xcc_id(); b.st = st; b.wave = wave;
    if (wave == 0 && fresh_lane() == 0) (void)xb_add(&bar[XB_XCNT(b.x)], 1u);
    return b;
}
__device__ __forceinline__ void xcd_barrier_complete(unsigned* bar, unsigned x, unsigned& nloc, unsigned& nx) {
    const unsigned G = gridDim.x * gridDim.y * gridDim.z;
    unsigned sum, cnt, mine, sp = 0u;
    for (;;) {
        sum = 0u; cnt = 0u; mine = 0u;
#pragma unroll
        for (unsigned j = 0; j < 16; ++j) { const unsigned c = xb_ld(&bar[XB_XCNT(j)]); sum += c; cnt += (c > 0u) ? 1u : 0u; mine = (j == x) ? c : mine; }
        if (sum == G) break;
        __builtin_amdgcn_s_sleep(1);
        if ((++sp & 255u) == 0u) { if (xb_ld(&bar[XB_TMO])) break; if (sp > XB_SPIN_CAP) { atomicAdd(&bar[XB_TMO], 1u); break; } }
    }
    nloc = mine > 0u ? mine : 1u; nx = cnt > 0u ? cnt : 1u;
}
__device__ __forceinline__ void xcd_barrier(const XcdBarrier& b) {
    asm volatile("s_waitcnt vmcnt(0)" ::: "memory");
    __syncthreads();
    if (b.wave == 0 && fresh_lane() == 0) {
        unsigned* bar = b.bar;
        __builtin_amdgcn_s_waitcnt(0);
        unsigned nloc = b.st[0], nx = b.st[1];
        if (nloc == 0u) { xcd_barrier_complete(bar, b.x, nloc, nx); b.st[0] = nloc; b.st[1] = nx; }
        const unsigned old = xb_add(&bar[XB_XSUB(b.x)], 1u);
        const unsigned gen = old / nloc;
        if (old + 1u == (gen + 1u) * nloc) {
            __builtin_amdgcn_fence(__ATOMIC_RELEASE, "agent");
            asm volatile("s_waitcnt vmcnt(0)" ::: "memory");
            const unsigned og = xb_add(&bar[XB_TOP], 1u);
            const unsigned tg = og / nx;
            if (og + 1u == (tg + 1u) * nx) xb_add(&bar[XB_TOPGEN], 1u);
            else XB_SPIN(xb_ld(&bar[XB_TOPGEN]) == tg, bar);
            __builtin_amdgcn_fence(__ATOMIC_ACQUIRE, "agent");
            xb_add(&bar[XB_XGEN(b.x)], 1u);
            asm volatile("s_waitcnt vmcnt(0)" ::: "memory");
        } else {
            XB_SPIN(xb_ld(&bar[XB_XGEN(b.x)]) == gen, bar);
            __builtin_amdgcn_fence(__ATOMIC_ACQUIRE, "agent");
            asm volatile("s_waitcnt vmcnt(0)" ::: "memory");
        }
    }
    __syncthreads();
}

struct Frame {
    LAS unsigned char* lds;
    volatile LAS unsigned* MISC;
    gu32* ctl;
    int tid, lane, wave;
    int vcu, G;
    const float *x_p, *x_s, *st_pool, *st_ret, *c_p, *c_s, *ada_w, *ada_b, *g_pre, *g_post, *w_in, *pool_w, *pool_scale, *gn_g, *w_a, *w_b, *w_merge, *b_merge, *w_out;
    float* out;
    float *ropec, *ropes, *mod, *ss;
    bf16 *Wcat, *Wab, *Wout, *PoolW, *H, *Z, *YAB, *POOLED, *SN, *MB;
};

struct EpiZ {
    static constexpr bool PERM = true; static constexpr int MID_T = 0;
    bf16* Z; const float* bmerge; const float* ropec; const float* ropes; float* out_pp; float* out_ps;
    template <int NM> __device__ __forceinline__ void core(const pg8::f32x4 (&a)[NM][2], int row0, int cs, int fq) const {
        using namespace pg8;
        if (cs >= ZC_Q && cs < ZC_V) {
            const float ksc = (cs >= ZC_K) ? 0.08838834764831845f : 1.0f;
            const int j0 = 16 * ((cs & 127) >> 5) + 4 * fq, hb = cs & ~127;
#pragma unroll
            for (int m = 0; m < NM; ++m) {
                const int row = row0 + m * 16; const int pos = row < MP ? (row & (SEQ - 1)) : SEQ;
                const f32x4 c4 = *(const f32x4*)(ropec + pos * 64 + j0), s4 = *(const f32x4*)(ropes + pos * 64 + j0);
                bf16* rowp = Z + (size_t)row * LDZ + hb + j0;
                const f32x4 v0 = a[m][0], v1 = a[m][1];
                const f32x4 o1 = (v0 * c4 - v1 * s4) * ksc, o2 = (v0 * s4 + v1 * c4) * ksc;
                u32x2 w1, w2; w1.x = cvt_pk_bf16(o1[0], o1[1]); w1.y = cvt_pk_bf16(o1[2], o1[3]); w2.x = cvt_pk_bf16(o2[0], o2[1]); w2.y = cvt_pk_bf16(o2[2], o2[3]);
                *(u32x2*)rowp = w1; *(u32x2*)(rowp + 64) = w2;
            }
            return;
        }
        const int act = (cs >= ZC_GA) ? 2 : (((cs >= ZC_AG && cs < ZC_Q) || (cs >= ZC_BG)) ? 1 : 0);
        const int col = cs + 8 * fq;
        f32x4 bv[2];
#pragma unroll
        for (int n = 0; n < 2; ++n) bv[n] = (act == 2) ? *(const f32x4*)(bmerge + (col - ZC_GA) + 4 * n) : (f32x4){0.f, 0.f, 0.f, 0.f};
#pragma unroll
        for (int m = 0; m < NM; ++m) {
            const int row = row0 + m * 16;
            f32x4 v0 = a[m][0] + bv[0], v1 = a[m][1] + bv[1];
            if (act == 1) {
#pragma unroll
                for (int e = 0; e < 4; ++e) { v0[e] = silu_(v0[e]); v1[e] = silu_(v1[e]); }
            } else if (act == 2) {
#pragma unroll
                for (int e = 0; e < 4; ++e) { v0[e] = sigmoidf_(v0[e]); v1[e] = sigmoidf_(v1[e]); }
            }
            u32x4 w; w.x = cvt_pk_bf16(v0[0], v0[1]); w.y = cvt_pk_bf16(v0[2], v0[3]); w.z = cvt_pk_bf16(v1[0], v1[1]); w.w = cvt_pk_bf16(v1[2], v1[3]);
            *(u32x4*)(Z + (size_t)row * LDZ + col) = w;
            if (cs < ZC_AG) {
                if (row < MP) { const int t = row & (SEQ - 1); if (t >= SEQ - 15) { float* o = out_pp + ((size_t)((row >> 11) * 15 + (t - (SEQ - 15)))) * DPOOL + col; *(f32x4*)o = v0; *(f32x4*)(o + 4) = v1; } }
                else if (row < MP + MS) { float* o = out_ps + ((size_t)((row - MP) * 15 + 14)) * DPOOL + col; *(f32x4*)o = v0; *(f32x4*)(o + 4) = v1; }
            }
        }
    }
    template <int NM> __device__ __forceinline__ void mid(pg8::f32x4 (&)[NM][2], int, int, int) const {}
};
struct EpiPool {
    static constexpr bool PERM = true; static constexpr int MID_T = 0;
    bf16* Y; const bf16* Z; const float* pscale;
    template <int NM> __device__ __forceinline__ void core(const pg8::f32x4 (&a)[NM][2], int row0, int cs, int fq) const {
        using namespace pg8;
        const int col = cs + 8 * fq;
        const f32x4 ps0 = *(const f32x4*)(pscale + col), ps1 = *(const f32x4*)(pscale + col + 4);
#pragma unroll
        for (int m = 0; m < NM; ++m) {
            const int row = row0 + m * 16;
            const u32x4 g = *(const u32x4*)(Z + (size_t)row * LDZ + ZC_AG + col);
            f32x4 v0 = a[m][0] * ps0, v1 = a[m][1] * ps1;
            v0[0] *= bf_lo(g.x); v0[1] *= bf_hi(g.x); v0[2] *= bf_lo(g.y); v0[3] *= bf_hi(g.y);
            v1[0] *= bf_lo(g.z); v1[1] *= bf_hi(g.z); v1[2] *= bf_lo(g.w); v1[3] *= bf_hi(g.w);
            u32x4 w; w.x = cvt_pk_bf16(v0[0], v0[1]); w.y = cvt_pk_bf16(v0[2], v0[3]); w.z = cvt_pk_bf16(v1[0], v1[1]); w.w = cvt_pk_bf16(v1[2], v1[3]);
            *(u32x4*)(Y + (size_t)row * LDY + col) = w;
        }
    }
    template <int NM> __device__ __forceinline__ void mid(pg8::f32x4 (&)[NM][2], int, int, int) const {}
};
struct EpiMerge {
    static constexpr bool PERM = true; static constexpr int MID_T = 16;
    bf16* O; const bf16* Z;
    template <int NM> __device__ __forceinline__ void mid(pg8::f32x4 (&a)[NM][2], int row0, int cs, int fq) const {
        using namespace pg8;
        const bf16* zb = Z + (size_t)row0 * LDZ + ZC_GA + cs + 8 * fq;
        asm volatile("" : "+v"(zb));
#pragma unroll
        for (int m = 0; m < NM; ++m) {
            const bf16* zr = zb + (size_t)(m * 16) * LDZ;
            const u32x4 ga = *(const u32x4*)zr, gb = *(const u32x4*)(zr + (ZC_GB - ZC_GA));
            f32x4& v0 = a[m][0]; f32x4& v1 = a[m][1];
            v0[0] *= bf_lo(ga.x) * __builtin_amdgcn_rcpf(bf_lo(gb.x)); v0[1] *= bf_hi(ga.x) * __builtin_amdgcn_rcpf(bf_hi(gb.x)); v0[2] *= bf_lo(ga.y) * __builtin_amdgcn_rcpf(bf_lo(gb.y)); v0[3] *= bf_hi(ga.y) * __builtin_amdgcn_rcpf(bf_hi(gb.y));
            v1[0] *= bf_lo(ga.z) * __builtin_amdgcn_rcpf(bf_lo(gb.z)); v1[1] *= bf_hi(ga.z) * __builtin_amdgcn_rcpf(bf_hi(gb.z)); v1[2] *= bf_lo(ga.w) * __builtin_amdgcn_rcpf(bf_lo(gb.w)); v1[3] *= bf_hi(ga.w) * __builtin_amdgcn_rcpf(bf_hi(gb.w));
            if (m & 1) asm volatile("" ::: "memory");
        }
    }
    template <int NM> __device__ __forceinline__ void core(const pg8::f32x4 (&a)[NM][2], int row0, int cs, int fq) const {
        using namespace pg8;
        const int col = cs + 8 * fq;
#pragma unroll
        for (int m = 0; m < NM; ++m) {
            const int row = row0 + m * 16;
            const u32x4 g = *(const u32x4*)(Z + (size_t)row * LDZ + ZC_GB + col);
            f32x4 v0 = a[m][0], v1 = a[m][1];
            v0[0] *= bf_lo(g.x); v0[1] *= bf_hi(g.x); v0[2] *= bf_lo(g.y); v0[3] *= bf_hi(g.y);
            v1[0] *= bf_lo(g.z); v1[1] *= bf_hi(g.z); v1[2] *= bf_lo(g.w); v1[3] *= bf_hi(g.w);
            u32x4 w; w.x = cvt_pk_bf16(v0[0], v0[1]); w.y = cvt_pk_bf16(v0[2], v0[3]); w.z = cvt_pk_bf16(v1[0], v1[1]); w.w = cvt_pk_bf16(v1[2], v1[3]);
            *(u32x4*)(O + (size_t)row * DM + col) = w;
        }
    }
};
struct EpiOut {
    static constexpr bool PERM = false; static constexpr int MID_T = 0;
    float* out; float* ss;
    template <int NM> __device__ __forceinline__ void core(const pg8::f32x4 (&a)[NM][2], int row0, int cs, int fq) const {
        using namespace pg8;
#pragma unroll
        for (int m = 0; m < NM; ++m) {
            const int row = row0 + m * 16;
            float s = 0.f;
#pragma unroll
            for (int n = 0; n < 2; ++n) { const f32x4 v = a[m][n]; s += (v[0] * v[0] + v[1] * v[1]) + (v[2] * v[2] + v[3] * v[3]); }
            s += __shfl_xor(s, 16); s += __shfl_xor(s, 32);
            if (fq == 0) ss[(size_t)row * 64 + (cs >> 5)] = s;
            if (row < MP + MS) {
                float* rowp = out + (row < MP ? O_YP + (size_t)row * DM : O_YS + (size_t)(row - MP) * DM) + cs + 4 * fq;
#pragma unroll
                for (int n = 0; n < 2; ++n) *(f32x4*)(rowp + n * 16) = a[m][n];
            }
        }
    }
    template <int NM> __device__ __forceinline__ void mid(pg8::f32x4 (&)[NM][2], int, int, int) const {}
};

__device__ __forceinline__ int rot_row(int n) { const int L = n & 127, hf = L >> 6, j = L & 63; return (n & ~127) + 32 * (j >> 4) + 8 * ((j >> 2) & 3) + 4 * hf + (j & 3); }
__device__ __forceinline__ void p0_transpose_item(const float* W, int N, bf16* WT, int ldw, int row_off, int koff, int rot_lo, int rot_hi, LAS float* scr, int item, int lane) {
    const int nblk = N / 32, kb = item / nblk, nb = item % nblk, k0 = 64 * kb, n0 = 32 * nb;
#pragma unroll 8
    for (int i = 0; i < 32; ++i) { const int kk = 2 * i + (lane >> 5); scr[kk * 33 + (lane & 31)] = W[(size_t)(k0 + kk) * N + n0 + (lane & 31)]; }
    LDS_WAIT(); asm volatile("" ::: "memory");
    const int c = lane & 7;
#pragma unroll
    for (int j = 0; j < 4; ++j) { const int n = (lane >> 3) + 8 * j; const LAS float* s = scr + (8 * c) * 33 + n;
        v4u o; o.x = pk2(s[0 * 33], s[1 * 33]); o.y = pk2(s[2 * 33], s[3 * 33]); o.z = pk2(s[4 * 33], s[5 * 33]); o.w = pk2(s[6 * 33], s[7 * 33]);
        int nn = n0 + n; if (nn >= rot_lo && nn < rot_hi) nn = rot_row(nn);
        *(GAS v4u*)(WT + (size_t)(row_off + nn) * ldw + koff + k0 + 8 * c) = o; }
    LDS_WAIT(); asm volatile("" ::: "memory");
}
__device__ __forceinline__ void p0_mod_item(Frame& F, int strip) {
    const int n0 = strip * 32, lane = F.lane, fr = lane & 15, fq = lane >> 4, wave = F.wave;
    f32x4 acc[9][2];
#pragma unroll
    for (int a = 0; a < 9; ++a) { acc[a][0] = (f32x4){0.f, 0.f, 0.f, 0.f}; acc[a][1] = (f32x4){0.f, 0.f, 0.f, 0.f}; }
    for (int ks = 0; ks < 8; ++ks) {
        const int k0 = wave * 256 + ks * 32 + 8 * fq;
        bf16x8 bfr[2];
#pragma unroll
        for (int nt = 0; nt < 2; ++nt) {
            float w[8];
#pragma unroll
            for (int j = 0; j < 8; ++j) w[j] = F.ada_w[(size_t)(k0 + j) * 6144 + n0 + 16 * nt + fr];
            v4u p; p.x = pk2(w[0], w[1]); p.y = pk2(w[2], w[3]); p.z = pk2(w[4], w[5]); p.w = pk2(w[6], w[7]);
            bfr[nt] = __builtin_bit_cast(bf16x8, p);
        }
#pragma unroll
        for (int mt = 0; mt < 9; ++mt) {
            const int row = 16 * mt + fr;
            f32x4 a0 = (f32x4){0.f, 0.f, 0.f, 0.f}, a1 = a0;
            if (row < 132) { const float* cp = (row < 4 ? F.c_p + (size_t)row * DM : F.c_s + (size_t)(row - 4) * DM) + k0; a0 = *(const f32x4*)cp; a1 = *(const f32x4*)(cp + 4); }
            v4u p; p.x = pk2(silu_(a0[0]), silu_(a0[1])); p.y = pk2(silu_(a0[2]), silu_(a0[3])); p.z = pk2(silu_(a1[0]), silu_(a1[1])); p.w = pk2(silu_(a1[2]), silu_(a1[3]));
            const bf16x8 afr = __builtin_bit_cast(bf16x8, p);
            acc[mt][0] = __builtin_amdgcn_mfma_f32_16x16x32_bf16(afr, bfr[0], acc[mt][0], 0, 0, 0);
            acc[mt][1] = __builtin_amdgcn_mfma_f32_16x16x32_bf16(afr, bfr[1], acc[mt][1], 0, 0, 0);
        }
    }
    LAS float* red = (LAS float*)F.lds;
    for (int w = 0; w < 8; ++w) {
        if (wave == w) {
#pragma unroll
            for (int mt = 0; mt < 9; ++mt)
#pragma unroll
                for (int nt = 0; nt < 2; ++nt)
#pragma unroll
                    for (int r = 0; r < 4; ++r) { const int idx = (16 * mt + 4 * fq + r) * 32 + 16 * nt + fr; if (w == 0) red[idx] = acc[mt][nt][r]; else red[idx] += acc[mt][nt][r]; }
        }
        __syncthreads();
    }
    for (int i = F.tid; i < 132 * 32; i += NWAVES * 64) { const int r = i >> 5, cc = i & 31; F.mod[(size_t)r * 6144 + n0 + cc] = red[i] + F.ada_b[n0 + cc]; }
    __syncthreads();
}
__device__ __forceinline__ void rope_entry(int prow, int i, float* cosT, float* sinT) {
    double th = 1.0, bs = 0.8659643233600653;
    for (int e = i; e; e >>= 1) { if (e & 1) th *= bs; bs *= bs; }
    const double t2 = th * th; double c = 1.0, s = th, tc = 1.0, ts = th;
#pragma unroll 1
    for (int n = 1; n <= 12; ++n) { tc *= -t2 / (double)((2 * n - 1) * (2 * n)); c += tc; ts *= -t2 / (double)((2 * n) * (2 * n + 1)); s += ts; }
    const int pos = prow < SEQ ? prow : PAST;
    double rc = 1.0, rs = 0.0, bc = c, bn = s;
    for (int e = pos; e; e >>= 1) { if (e & 1) { const double t = rc * bc - rs * bn; rs = rc * bn + rs * bc; rc = t; } const double t = bc * bc - bn * bn; bn = 2.0 * bc * bn; bc = t; }
    cosT[prow * 64 + i] = (float)rc; sinT[prow * 64 + i] = (float)rs;
}
__device__ __forceinline__ void p0_prologue(Frame& F) {
    if (F.vcu < 192) for (int s = F.vcu; s < 192; s += F.G) p0_mod_item(F, s);
    LAS float* scr = (LAS float*)(F.lds + RING_OFF + F.wave * 16384);
    const int gw = F.vcu * NWAVES + F.wave, NGW = F.G * NWAVES;
    constexpr int I_IN = 32 * 256, I_MG = 32 * 128, I_A = 16 * 64, I_B = 32 * 64, I_O = 32 * 64, I_P = 4 * 8;
    constexpr int NITEMS = I_IN + I_MG + I_A + I_B + I_O + 4 * I_P;
    for (int it = gw; it < NITEMS; it += NGW) {
        int r = it;
        if (r < I_IN) { p0_transpose_item(F.w_in, DIN, F.Wcat, DM, 0, 0, ZC_Q, ZC_V, scr, r, F.lane); continue; } r -= I_IN;
        if (r < I_MG) { p0_transpose_item(F.w_merge, 4096, F.Wcat, DM, DIN, 0, 0, 0, scr, r, F.lane); continue; } r -= I_MG;
        if (r < I_A) { p0_transpose_item(F.w_a, DM, F.Wab, LDY, 0, 0, 0, 0, scr, r, F.lane); continue; } r -= I_A;
        if (r < I_B) { p0_transpose_item(F.w_b, DM, F.Wab, LDY, 0, 1024, 0, 0, scr, r, F.lane); continue; } r -= I_B;
        if (r < I_O) { p0_transpose_item(F.w_out, DM, F.Wout, DM, 0, 0, 0, 0, scr, r, F.lane); continue; } r -= I_O;
        { const int g = r / I_P; p0_transpose_item(F.pool_w + (size_t)g * 65536, 256, F.PoolW, 256, g * 256, 0, 0, 0, scr, r % I_P, F.lane); }
    }
    const int gt = F.vcu * (NWAVES * 64) + F.tid, NGT = F.G * NWAVES * 64;
    for (int e = gt; e < 2049 * 64; e += NGT) rope_entry(e >> 6, e & 63, F.ropec, F.ropes);
}

__device__ __forceinline__ void h_row(Frame& F, const float* xrow, const float* modrow, bf16* orow) {
    const GAS f32x4* xr = (const GAS f32x4*)xrow + F.lane;
    f32x4 v[8]; float s = 0.f;
#pragma unroll
    for (int j = 0; j < 8; ++j) { v[j] = xr[64 * j]; s += (v[j].x * v[j].x + v[j].y * v[j].y) + (v[j].z * v[j].z + v[j].w * v[j].w); }
    const float rstd = 1.0f / sqrtf(wave_sum(s) * (1.0f / DM) + EPS);
    GAS v2u* o8 = (GAS v2u*)orow + F.lane;
#pragma unroll
    for (int j = 0; j < 8; ++j) {
        const int col = 4 * F.lane + 256 * j;
        const f32x4 g = *(const f32x4*)(F.g_pre + col), sh = *(const f32x4*)(modrow + col), sc = *(const f32x4*)(modrow + DM + col);
        const f32x4 o = v[j] * rstd * g * (sc + 1.0f) + sh;
        v2u w; w.x = pk2(o.x, o.y); w.y = pk2(o.z, o.w); o8[64 * j] = w;
    }
}

__device__ __forceinline__ unsigned off_a(unsigned row, unsigned ch) { return 2048u * (row >> 3) + 512u * (ch >> 2) + 64u * (row & 7) + 16u * ((ch & 3) ^ ((row >> 2) & 3)); }
struct RowA { unsigned e, d; };
struct TrA { unsigned t0, t1; };
__device__ __forceinline__ RowA row_addr(unsigned lane) { RowA r; r.e = off_a(lane & 31, lane >> 5); r.d = off_a(lane & 31, 2 + (lane >> 5)) - r.e; return r; }
__device__ __forceinline__ TrA tr_addr(unsigned lane) { const unsigned h = lane >> 5, blk = (lane >> 4) & 1, q = (lane & 15) >> 2, p = lane & 3; TrA t;
    t.t0 = off_a(8 * h + q, 2 * blk + (p >> 1)) + 8 * (p & 1); t.t1 = off_a(8 * h + 4 + q, 2 * blk + (p >> 1)) + 8 * (p & 1); return t; }
__device__ __forceinline__ bf16x8 frag_row(const LAS unsigned char* img, const RowA& ra, int s) { return *(const LAS bf16x8*)(img + (ra.e + (unsigned)(s & 1) * ra.d + 512u * (unsigned)(s >> 1))); }
__device__ __forceinline__ bf16x8 frag_tr(const LAS unsigned char* img, const TrA& ta, int c, int ks) {
    const s16x4 lo = __builtin_bit_cast(s16x4, __builtin_amdgcn_ds_read_tr16_b64_v4i16((LAS s16x4*)(img + ta.t0 + 512 * c + 4096 * ks)));
    const s16x4 hi = __builtin_bit_cast(s16x4, __builtin_amdgcn_ds_read_tr16_b64_v4i16((LAS s16x4*)(img + ta.t1 + 512 * c + 4096 * ks)));
    return __builtin_shufflevector(lo, hi, 0, 1, 2, 3, 4, 5, 6, 7);
}
#define MFMA32(a, b, c) __builtin_amdgcn_mfma_f32_32x32x16_bf16((a), (b), (c), 0, 0, 0)
__device__ __forceinline__ int crow(int reg, int h) { return (reg & 3) + 8 * (reg >> 2) + 4 * h; }

__device__ __forceinline__ void ret_ab_unit(Frame& F, int unit) {
    const int bh = unit >> 3, dh = (unit >> 2) & 1, dq = unit & 3, b = bh >> 3, h = bh & 7, lane = fresh_lane(), wave = F.wave, hh = lane >> 5, tid_ = wave * 64 + lane;
    const float lg = lg2gamma(h);
    const float cdec = __builtin_amdgcn_exp2f(128.0f * lg);
    const int di = wave & 1, dj = (wave >> 1) & 1;
    const TrA ta = tr_addr(lane);
    f32x16 acc;
#pragma unroll
    for (int e = 0; e < 16; ++e) acc[e] = 0.f;
    const bf16* Zb = F.Z + (size_t)(b * SEQ) * LDZ;
    v4u r0[4], r1[4];
#define AB_LOAD(c, R) do { _Pragma("unroll") for (int i = 0; i < 2; ++i) { const int n = tid_ + 512 * i, row = n >> 3, ch = n & 7; const bf16* rp = Zb + (size_t)((c) * 128 + row) * LDZ; \
        R[i] = *(const GAS v4u*)(rp + ZC_K + h * DK + dh * 64 + ch * 8); R[2 + i] = *(const GAS v4u*)(rp + ZC_V + h * DV + dq * 64 + ch * 8); } } while (0)
#define AB_STORE(buf, R) do { _Pragma("unroll") for (int i = 0; i < 2; ++i) { const int n = tid_ + 512 * i, row = n >> 3, ch = n & 7; \
        const float d = __builtin_amdgcn_exp2f((float)(127 - row) * lg); v4u kk = R[i]; \
        kk.x = pk2(bflo(kk.x) * d, bfhi(kk.x) * d); kk.y = pk2(bflo(kk.y) * d, bfhi(kk.y) * d); kk.z = pk2(bflo(kk.z) * d, bfhi(kk.z) * d); kk.w = pk2(bflo(kk.w) * d, bfhi(kk.w) * d); \
        const unsigned o = (unsigned)(buf) * 65536u + (unsigned)(row >> 5) * 8192u + off_a(row & 31, ch); \
        *(LAS v4u*)(F.lds + o) = kk; *(LAS v4u*)(F.lds + 32768u + o) = R[2 + i]; } } while (0)
#define AB_STEP(c, RC, RN) do { \
        if ((c) + 2 < 16) AB_LOAD((c) + 2, RC); \
        if (wave < 4) { \
            if ((c) > 0) { v4u w0, w1; w0.x = pk2(acc[0], acc[1]); w0.y = pk2(acc[2], acc[3]); w0.z = pk2(acc[4], acc[5]); w0.w = pk2(acc[6], acc[7]); \
                w1.x = pk2(acc[8], acc[9]); w1.y = pk2(acc[10], acc[11]); w1.z = pk2(acc[12], acc[13]); w1.w = pk2(acc[14], acc[15]); \
                bf16* sn = F.SN + ((((size_t)(bh * 16 + (c)) * 32 + (2 * dh + di) * 8 + (2 * dq + dj)) * 64 + lane) * 16); \
                *(GAS v4u*)sn = w0; *(GAS v4u*)(sn + 8) = w1; } \
            _Pragma("unroll") for (int e = 0; e < 16; ++e) acc[e] *= cdec; \
            const LAS unsigned char* kb = F.lds + ((c) & 1) * 65536; const LAS unsigned char* vb = kb + 32768; \
            _Pragma("unroll") for (int kk = 0; kk < 8; ++kk) acc = MFMA32(frag_tr(kb + (kk >> 1) * 8192, ta, di, kk & 1), frag_tr(vb + (kk >> 1) * 8192, ta, dj, kk & 1), acc); \
        } \
        if ((c) + 1 < 16) AB_STORE(((c) + 1) & 1, RN); \
        __syncthreads(); } while (0)
    AB_LOAD(0, r0); AB_LOAD(1, r1); AB_STORE(0, r0); __syncthreads();
#pragma unroll 1
    for (int c = 0; c < 16; c += 2) { AB_STEP(c, r0, r1); AB_STEP(c + 1, r1, r0); }
#undef AB_LOAD
#undef AB_STORE
#undef AB_STEP
    if (wave < 4) {
        float* so = F.out + O_RP + (size_t)bh * (DK * DV);
        const int dv = 64 * dq + 32 * dj + (lane & 31);
#pragma unroll
        for (int e = 0; e < 16; ++e) so[(size_t)(64 * dh + 32 * di + crow(e, hh)) * DV + dv] = acc[e];
    }
}

__device__ __forceinline__ void pooled_prompt(Frame& F) {
    const int gt = F.vcu * (NWAVES * 64) + F.tid, NGT = F.G * NWAVES * 64;
    for (int it = gt; it < MP * 128; it += NGT) {
        const int row = it >> 7, q = it & 127, t = row & (SEQ - 1), w = 2 << (q >> 5), cnt = (t + 1 < w) ? t + 1 : w;
        const bf16* p = F.Z + (size_t)row * LDZ + ZC_AX + q * 8;
        v4u x[16];
#pragma unroll
        for (int j = 0; j < 16; ++j) x[j] = (j < cnt) ? *(const GAS v4u*)(p - (size_t)j * LDZ) : (v4u){0u, 0u, 0u, 0u};
        float s[8] = {0.f, 0.f, 0.f, 0.f, 0.f, 0.f, 0.f, 0.f};
#pragma unroll
        for (int j = 0; j < 16; ++j) { s[0] += bflo(x[j].x); s[1] += bfhi(x[j].x); s[2] += bflo(x[j].y); s[3] += bfhi(x[j].y); s[4] += bflo(x[j].z); s[5] += bfhi(x[j].z); s[6] += bflo(x[j].w); s[7] += bfhi(x[j].w); }
        const float inv = 1.0f / (float)cnt;
        const float a[8] = {bflo(x[0].x), bfhi(x[0].x), bflo(x[0].y), bfhi(x[0].y), bflo(x[0].z), bfhi(x[0].z), bflo(x[0].w), bfhi(x[0].w)};
        v4u o; o.x = pk2(s[0] * inv - a[0], s[1] * inv - a[1]); o.y = pk2(s[2] * inv - a[2], s[3] * inv - a[3]); o.z = pk2(s[4] * inv - a[4], s[5] * inv - a[5]); o.w = pk2(s[6] * inv - a[6], s[7] * inv - a[7]);
        *(GAS v4u*)(F.POOLED + (size_t)row * DPOOL + q * 8) = o;
    }
}
__device__ __forceinline__ void pooled_sample(Frame& F) {
    const int gt = F.vcu * (NWAVES * 64) + F.tid, NGT = F.G * NWAVES * 64;
    for (int it = gt; it < MS * 128; it += NGT) {
        const int bs = it >> 7, q = it & 127, w = 2 << (q >> 5);
        const v4u x = *(const GAS v4u*)(F.Z + (size_t)(MP + bs) * LDZ + ZC_AX + q * 8);
        float a[8] = {bflo(x.x), bfhi(x.x), bflo(x.y), bfhi(x.y), bflo(x.z), bfhi(x.z), bflo(x.w), bfhi(x.w)}, s[8];
#pragma unroll
        for (int e = 0; e < 8; ++e) s[e] = a[e];
        const float* sp = F.st_pool + (size_t)bs * 15 * DPOOL + q * 8;
        float* op = F.out + O_PS + (size_t)bs * 15 * DPOOL + q * 8;
#pragma unroll
        for (int i = 14; i >= 0; --i) {
            const f32x4 b0 = *(const f32x4*)(sp + (size_t)i * DPOOL), b1 = *(const f32x4*)(sp + (size_t)i * DPOOL + 4);
            if (i >= 1) { *(f32x4*)(op + (size_t)(i - 1) * DPOOL) = b0; *(f32x4*)(op + (size_t)(i - 1) * DPOOL + 4) = b1; }
            if (15 - i < w) { s[0] += b0.x; s[1] += b0.y; s[2] += b0.z; s[3] += b0.w; s[4] += b1.x; s[5] += b1.y; s[6] += b1.z; s[7] += b1.w; }
        }
        const float inv = 1.0f / (float)w;
        v4u o; o.x = pk2(s[0] * inv - a[0], s[1] * inv - a[1]); o.y = pk2(s[2] * inv - a[2], s[3] * inv - a[3]); o.z = pk2(s[4] * inv - a[4], s[5] * inv - a[5]); o.w = pk2(s[6] * inv - a[6], s[7] * inv - a[7]);
        *(GAS v4u*)(F.POOLED + (size_t)(MP + bs) * DPOOL + q * 8) = o;
    }
}
__device__ __forceinline__ void ret_sample_item(Frame& F, int item) {
    const int bs = item >> 3, h = item & 7, lane = F.lane, wave = F.wave, row = MP + bs;
    const float gam = 1.0f - __builtin_amdgcn_exp2f((float)(-5 - h));
    const bf16* zr = F.Z + (size_t)row * LDZ;
    f32x4 v4; { const v2u x = *(const GAS v2u*)(zr + ZC_V + h * DV + 4 * lane); v4 = (f32x4){bflo(x.x), bfhi(x.x), bflo(x.y), bfhi(x.y)}; }
    const float* s0 = F.st_ret + ((size_t)(bs * NH + h) * DK) * DV + 4 * lane;
    float* s1 = F.out + O_RS + ((size_t)(bs * NH + h) * DK) * DV + 4 * lane;
    f32x4 o4 = (f32x4){0.f, 0.f, 0.f, 0.f};
    f32x4 sv[16];
#pragma unroll
    for (int r = 0; r < 16; ++r) sv[r] = *(const f32x4*)(s0 + (size_t)(16 * wave + r) * DV);
#pragma unroll
    for (int r = 0; r < 16; ++r) {
        const int dk = 16 * wave + r;
        const float qd = bf1(zr[ZC_Q + h * DK + dk]), kd = bf1(zr[ZC_K + h * DK + dk]);
        const f32x4 sn = sv[r] * gam + v4 * kd;
        *(f32x4*)(s1 + (size_t)dk * DV) = sn;
        o4 += sn * qd;
    }
    LAS float* part = (LAS float*)(F.lds);
    *(LAS f32x4*)(part + wave * 256 + 4 * lane) = o4;
    __syncthreads();
    if (wave == 0) {
        f32x4 o = *(LAS f32x4*)(part + 4 * lane);
#pragma unroll
        for (int w = 1; w < 8; ++w) o += *(LAS f32x4*)(part + w * 256 + 4 * lane);
        const float mu = wave_sum((o.x + o.y) + (o.z + o.w)) * (1.0f / DV);
        o = o - mu;
        const float var = wave_sum((o.x * o.x + o.y * o.y) + (o.z * o.z + o.w * o.w)) * (1.0f / DV);
        const float rstd = 1.0f / sqrtf(var + EPS);
        const f32x4 g = *(const f32x4*)(F.gn_g + h * DV + 4 * lane);
        const v2u x = *(const GAS v2u*)(zr + ZC_BG + h * DV + 4 * lane);
        o = o * rstd * g; o.x *= bflo(x.x); o.y *= bfhi(x.x); o.z *= bflo(x.y); o.w *= bfhi(x.y);
        v2u wv; wv.x = pk2(o.x, o.y); wv.y = pk2(o.z, o.w);
        *(GAS v2u*)(F.YAB + (size_t)row * LDY + 1024 + h * DV + 4 * lane) = wv;
    }
    __syncthreads();
}

__device__ __forceinline__ void ret_c_unit(Frame& F, int unit) {
    const int bh = unit >> 4, c = unit & 15, b = bh >> 3, h = bh & 7, lane = fresh_lane(), wave = F.wave, hh = lane >> 5, l31 = lane & 31, tid_ = wave * 64 + lane;
    const float lg = lg2gamma(h);
    const int ti = wave & 3, wh = wave >> 2;
    const RowA ra = row_addr(lane); const TrA ta = tr_addr(lane);
    const int rowbase = b * SEQ + c * 128;
    const bf16* Zb = F.Z + (size_t)rowbase * LDZ;
    LAS unsigned char* Qi = F.lds; LAS unsigned char* Ki = F.lds + 32768; LAS unsigned char* Vi = F.lds + 65536;
    {
        v4u rq[4], rk[4], rv[8];
#pragma unroll
        for (int i = 0; i < 4; ++i) { const int n = tid_ + 512 * i, row = n >> 4, ch = n & 15; const bf16* rp = Zb + (size_t)row * LDZ;
            rq[i] = *(const GAS v4u*)(rp + ZC_Q + h * DK + ch * 8); rk[i] = *(const GAS v4u*)(rp + ZC_K + h * DK + ch * 8); }
#pragma unroll
        for (int i = 0; i < 8; ++i) { const int n = tid_ + 512 * i, row = n >> 5, ch = n & 31; rv[i] = *(const GAS v4u*)(Zb + (size_t)row * LDZ + ZC_V + h * DV + ch * 8); }
#pragma unroll
        for (int i = 0; i < 4; ++i) { const int n = tid_ + 512 * i, row = n >> 4, ch = n & 15; const unsigned o = (unsigned)(row >> 5) * 8192u + off_a(row & 31, ch);
            *(LAS v4u*)(Qi + o) = rq[i]; *(LAS v4u*)(Ki + o) = rk[i]; }
#pragma unroll
        for (int i = 0; i < 8; ++i) { const int n = tid_ + 512 * i, row = n >> 5, ch = n & 31;
            *(LAS v4u*)(Vi + (unsigned)((row >> 5) * 2 + (ch >> 4)) * 8192u + off_a(row & 31, ch & 15)) = rv[i]; }
    }
    const bf16* snb = F.SN + (((size_t)(bh * 16 + c) * 32) * 64 + lane) * 16;
    v4u sf[2][2][4];
    if (c > 0) {
#pragma unroll
        for (int i = 0; i < 2; ++i)
#pragma unroll
            for (int s2 = 0; s2 < 2; ++s2)
#pragma unroll
                for (int j = 0; j < 4; ++j) sf[i][s2][j] = *(const GAS v4u*)(snb + (size_t)(i * 8 + 4 * wh + j) * 1024 + 8 * s2);
    }
    __syncthreads();
    f32x16 X[2];
#pragma unroll
    for (int t = 0; t < 2; ++t) {
        const int sj = 2 * wh + t;
#pragma unroll
        for (int e = 0; e < 16; ++e) X[t][e] = 0.f;
        if (sj <= ti) {
#pragma unroll
            for (int ks = 0; ks < 8; ++ks) X[t] = MFMA32(frag_row(Ki + sj * 8192, ra, ks), frag_row(Qi + ti * 8192, ra, ks), X[t]);
        }
    }
    __syncthreads();
#pragma unroll
    for (int t = 0; t < 2; ++t) {
        const int sj = 2 * wh + t;
        if (sj <= ti) {
            const int tt = 32 * ti + l31;
#pragma unroll
            for (int g = 0; g < 4; ++g) {
                float p[4];
#pragma unroll
                for (int e = 0; e < 4; ++e) { const int s = 32 * sj + 8 * g + 4 * hh + e; const float f = __builtin_amdgcn_exp2f(-(float)(s + 1) * lg); p[e] = (s <= tt) ? X[t][4 * g + e] * f : 0.f; }
                v2u w; w.x = pk2(p[0], p[1]); w.y = pk2(p[2], p[3]);
                *(LAS v2u*)(Ki + ti * 8192 + off_a(l31, 4 * sj + g) + 8 * hh) = w;
            }
        }
    }
    f32x16 O[4];
#pragma unroll
    for (int j = 0; j < 4; ++j)
#pragma unroll
        for (int e = 0; e < 16; ++e) O[j][e] = 0.f;
    const unsigned qb = 2048u * (l31 >> 3) + 64u * (l31 & 7) + 8u * hh, qm = (l31 >> 2) & 3;
    const LAS unsigned char* Qt = Qi + ti * 8192 + qb;
#define QFRAG(i, s2) __builtin_shufflevector(*(const LAS s16x4*)(Qt + 512 * (i) + 16 * ((2 * (s2)) ^ qm)), *(const LAS s16x4*)(Qt + 512 * (i) + 16 * ((2 * (s2) + 1) ^ qm)), 0, 1, 2, 3, 4, 5, 6, 7)
    if (c > 0) {
#pragma unroll
        for (int i = 0; i < 2; ++i)
#pragma unroll
            for (int s2 = 0; s2 < 2; ++s2) { const bf16x8 a = QFRAG(i, s2);
#pragma unroll
                for (int j = 0; j < 4; ++j) O[j] = MFMA32(a, __builtin_bit_cast(bf16x8, sf[i][s2][j]), O[j]); }
#pragma unroll
        for (int i = 0; i < 2; ++i)
#pragma unroll
            for (int s2 = 0; s2 < 2; ++s2)
#pragma unroll
                for (int j = 0; j < 4; ++j) sf[i][s2][j] = *(const GAS v4u*)(snb + (size_t)((i + 2) * 8 + 4 * wh + j) * 1024 + 8 * s2);
    }
    __syncthreads();
    for (int kk = 0; kk < 2 * (ti + 1); ++kk) {
        const bf16x8 a = frag_row(Ki + ti * 8192, ra, kk);
        const LAS unsigned char* vimg = Vi + ((kk >> 1) * 2 + wh) * 8192;
#pragma unroll
        for (int j = 0; j < 4; ++j) O[j] = MFMA32(a, frag_tr(vimg, ta, j, kk & 1), O[j]);
    }
    if (c > 0) {
#pragma unroll
        for (int i = 0; i < 2; ++i)
#pragma unroll
            for (int s2 = 0; s2 < 2; ++s2) { const bf16x8 a = QFRAG(i + 2, s2);
#pragma unroll
                for (int j = 0; j < 4; ++j) O[j] = MFMA32(a, __builtin_bit_cast(bf16x8, sf[i][s2][j]), O[j]); }
    }
#undef QFRAG
    LAS float* st = (LAS float*)(F.lds + STAT_OFF);
    float mu[16], rs[16];
#pragma unroll
    for (int e = 0; e < 16; ++e) {
        const float f = __builtin_amdgcn_exp2f((float)(crow(e, hh) + 32 * ti + 1) * lg);
        float s = 0.f;
#pragma unroll
        for (int j = 0; j < 4; ++j) { O[j][e] *= f; s += O[j][e]; }
        s += __shfl_xor(s, 1); s += __shfl_xor(s, 2); s += __shfl_xor(s, 4); s += __shfl_xor(s, 8); s += __shfl_xor(s, 16);
        if (l31 == 0) st[(32 * ti + crow(e, hh)) * 2 + wh] = s;
    }
    __syncthreads();
#pragma unroll
    for (int e = 0; e < 16; ++e) { const int r = 32 * ti + crow(e, hh); mu[e] = (st[r * 2] + st[r * 2 + 1]) * (1.0f / DV); }
#pragma unroll
    for (int e = 0; e < 16; ++e) {
        float s = 0.f;
#pragma unroll
        for (int j = 0; j < 4; ++j) { O[j][e] -= mu[e]; s += O[j][e] * O[j][e]; }
        s += __shfl_xor(s, 1); s += __shfl_xor(s, 2); s += __shfl_xor(s, 4); s += __shfl_xor(s, 8); s += __shfl_xor(s, 16);
        if (l31 == 0) st[256 + (32 * ti + crow(e, hh)) * 2 + wh] = s;
    }
    __syncthreads();
#pragma unroll
    for (int e = 0; e < 16; ++e) { const int r = 32 * ti + crow(e, hh); rs[e] = 1.0f / sqrtf((st[256 + r * 2] + st[256 + r * 2 + 1]) * (1.0f / DV) + EPS); }
    LAS float* T = (LAS float*)F.lds;
#pragma unroll
    for (int j = 0; j < 4; ++j) {
        const float g = F.gn_g[h * DV + 128 * wh + 32 * j + l31];
#pragma unroll
        for (int e = 0; e < 16; ++e) T[(32 * ti + crow(e, hh)) * 256 + 128 * wh + 32 * j + l31] = O[j][e] * rs[e] * g;
    }
    __syncthreads();
    {
        v4u bg[8];
#pragma unroll
        for (int i = 0; i < 8; ++i) { const int n = tid_ + 512 * i, row = n >> 5, ch = n & 31; bg[i] = *(const GAS v4u*)(Zb + (size_t)row * LDZ + ZC_BG + h * DV + ch * 8); }
#pragma unroll
        for (int i = 0; i < 8; ++i) { const int n = tid_ + 512 * i, row = n >> 5, ch = n & 31;
            const f32x4 t0 = *(const LAS f32x4*)(T + row * 256 + ch * 8), t1 = *(const LAS f32x4*)(T + row * 256 + ch * 8 + 4);
            v4u o; o.x = pk2(t0.x * bflo(bg[i].x), t0.y * bfhi(bg[i].x)); o.y = pk2(t0.z * bflo(bg[i].y), t0.w * bfhi(bg[i].y));
            o.z = pk2(t1.x * bflo(bg[i].z), t1.y * bfhi(bg[i].z)); o.w = pk2(t1.z * bflo(bg[i].w), t1.w * bfhi(bg[i].w));
            *(GAS v4u*)(F.YAB + (size_t)(rowbase + row) * LDY + 1024 + h * DV + ch * 8) = o; }
    }
    __syncthreads();
}

__device__ __forceinline__ void final_row(Frame& F, const float* xrow, float* yrow, const float* ssrow, const float* gaterow) {
    const float s = ssrow[F.lane];
    const float rstd = 1.0f / sqrtf(wave_sum(s) * (1.0f / DM) + EPS);
#pragma unroll
    for (int j = 0; j < 8; ++j) {
        const int col = 4 * F.lane + 256 * j;
        const f32x4 x = *(const f32x4*)(xrow + col), o = *(const f32x4*)(yrow + col), g = *(const f32x4*)(F.g_post + col), gt = *(const f32x4*)(gaterow + col);
        *(f32x4*)(yrow + col) = x + gt * (o * rstd * g);
    }
}

struct Args { const float* in[19]; float* out; unsigned char* ws; int ph_lo, ph_hi; };
constexpr int N_PHASES = 8;
__global__ void __launch_bounds__(NWAVES * 64, 2) hybrid_fwd(Args args) {
    extern __shared__ __attribute__((aligned(16))) unsigned char lds[];
    Frame F;
    F.lds = (LAS unsigned char*)lds;
    F.MISC = (volatile LAS unsigned*)(F.lds + MISC_OFF);
    F.wave = __builtin_amdgcn_readfirstlane((int)threadIdx.x >> 6); F.lane = fresh_lane(); F.tid = F.wave * 64 + F.lane;
    F.G = gridDim.x; { const int bx = blockIdx.x; F.vcu = (F.G % 8 == 0) ? (bx % 8) * (F.G / 8) + bx / 8 : bx; }
    unsigned char* ws = args.ws;
    F.ctl = (gu32*)(ws + WS_CTL);
    F.x_p = args.in[0]; F.x_s = args.in[1]; F.st_pool = args.in[2]; F.st_ret = args.in[3]; F.c_p = args.in[4]; F.c_s = args.in[5]; F.ada_w = args.in[6]; F.ada_b = args.in[7];
    F.g_pre = args.in[8]; F.g_post = args.in[9]; F.w_in = args.in[10]; F.pool_w = args.in[11]; F.pool_scale = args.in[12]; F.gn_g = args.in[13]; F.w_a = args.in[14]; F.w_b = args.in[15];
    F.w_merge = args.in[16]; F.b_merge = args.in[17]; F.w_out = args.in[18]; F.out = args.out;
    F.ropec = (float*)(ws + WS_ROPE); F.ropes = F.ropec + 2049 * 64; F.mod = (float*)(ws + WS_MOD); F.ss = (float*)(ws + WS_SS);
    F.Wcat = (bf16*)(ws + WS_WCAT); F.Wab = (bf16*)(ws + WS_WAB); F.Wout = (bf16*)(ws + WS_WOUT); F.PoolW = (bf16*)(ws + WS_POOLW);
    F.H = (bf16*)(ws + WS_H); F.Z = (bf16*)(ws + WS_Z); F.YAB = (bf16*)(ws + WS_YAB); F.POOLED = (bf16*)(ws + WS_POOLED); F.SN = (bf16*)(ws + WS_SN); F.MB = (bf16*)(ws + WS_MB);
    for (int u = F.tid; u < (LDS_BYTES - LDSCTL_OFF) / 4; u += NWAVES * 64) ((LAS unsigned*)(F.lds + LDSCTL_OFF))[u] = 0u;
    __syncthreads();
    const int lo = args.ph_lo, hi = args.ph_hi;
    XcdBarrier bar; bar.bar = (unsigned*)(F.ctl + CW_BAR); bar.x = 0; bar.st = nullptr; bar.wave = F.wave;
    if (hi - lo > 1) bar = xcd_barrier_post((unsigned*)(F.ctl + CW_BAR), F.MISC + 8, F.wave);
#define IN(k) (lo <= (k) && (k) < hi)
#define PHASE_BEGIN() do { F.lane = fresh_lane(); F.tid = F.wave * 64 + F.lane; } while (0)
#define SEAM(k) do { if (IN(k) && IN((k) + 1)) xcd_barrier(bar); } while (0)
    const int gw = F.vcu * NWAVES + F.wave, NGW = F.G * NWAVES;

    if (((PH_MASK >> 0) & 1) && IN(0)) for (int rep_ = 0; rep_ < (REP_PHASE == 0 ? REP_N : 1); ++rep_) { PHASE_BEGIN(); p0_prologue(F); } SEAM(0);

    if (((PH_MASK >> 1) & 1) && IN(1)) for (int rep_ = 0; rep_ < (REP_PHASE == 1 ? REP_N : 1); ++rep_) { PHASE_BEGIN();
        for (int m = gw; m < MP + MS; m += NGW) {
            const float* xr = m < MP ? F.x_p + (size_t)m * DM : F.x_s + (size_t)(m - MP) * DM;
            const float* mr = F.mod + (size_t)(m < MP ? (m >> 11) : 4 + (m - MP)) * 6144;
            h_row(F, xr, mr, F.H + (size_t)m * DM);
        }
    } SEAM(1);

    if (((PH_MASK >> 2) & 1) && IN(2)) for (int rep_ = 0; rep_ < (REP_PHASE == 2 ? REP_N : 1); ++rep_) { PHASE_BEGIN();
        pg8::Gemm g{F.H, F.Wcat, DM, DM, DM, 0}; pg8::StaticOrder S; S.init(MP, LDZ, F.G, (int)blockIdx.x);
        EpiZ E{F.Z, F.b_merge, F.ropec, F.ropes, F.out + O_PP, F.out + O_PS};
        pg8::gemm_phase<EpiZ, pg8::StaticOrder, true, true>(F.lds + RING_OFF, g, S, E, F.tid);
        PHASE_BEGIN();
        { pg8::Gemm gs{F.H + (size_t)MP * DM, F.Wcat, DM, DM, DM, 0}; pg8::sgemm_phase<EpiZ>(F.lds + RING_OFF, gs, MP, LDZ / 64, F.vcu, F.G, E, F.tid); }
    } SEAM(2);

    if (((PH_MASK >> 3) & 1) && IN(3)) for (int rep_ = 0; rep_ < (REP_PHASE == 3 ? REP_N : 1); ++rep_) { PHASE_BEGIN();
        for (int u = F.vcu; u < 256; u += F.G) ret_ab_unit(F, u);
        PHASE_BEGIN();
        pooled_prompt(F);
        pooled_sample(F);
        PHASE_BEGIN();
        for (int it = F.vcu; it < MS * NH; it += F.G) ret_sample_item(F, it);
    } SEAM(3);

    if (((PH_MASK >> 4) & 1) && IN(4)) for (int rep_ = 0; rep_ < (REP_PHASE == 4 ? REP_N : 1); ++rep_) { PHASE_BEGIN();
        for (int u = F.vcu; u < 512; u += F.G) ret_c_unit(F, u);
        PHASE_BEGIN();
        pg8::Gemm g{F.POOLED, F.PoolW, 256, DPOOL, 256, 512}; pg8::StaticOrder S; S.init(MT, DPOOL, F.G, (int)blockIdx.x);
        EpiPool E{F.YAB, F.Z, F.pool_scale};
        pg8::gemm_phase<EpiPool, pg8::StaticOrder, true, true>(F.lds + RING_OFF, g, S, E, F.tid);
    } SEAM(4);

    if (((PH_MASK >> 5) & 1) && IN(5)) for (int rep_ = 0; rep_ < (REP_PHASE == 5 ? REP_N : 1); ++rep_) { PHASE_BEGIN();
        pg8::Gemm g{F.YAB, F.Wab, LDY, LDY, LDY, 0}; pg8::StaticOrder S; S.init(MP, DM, F.G, (int)blockIdx.x);
        EpiMerge E{F.MB, F.Z};
        pg8::gemm_phase<EpiMerge, pg8::StaticOrder, true, true>(F.lds + RING_OFF, g, S, E, F.tid);
        PHASE_BEGIN();
        { pg8::Gemm gs{F.YAB + (size_t)MP * LDY, F.Wab, LDY, LDY, LDY, 0}; pg8::sgemm_phase<EpiMerge>(F.lds + RING_OFF, gs, MP, DM / 64, F.vcu, F.G, E, F.tid); }
    } SEAM(5);

    if (((PH_MASK >> 6) & 1) && IN(6)) for (int rep_ = 0; rep_ < (REP_PHASE == 6 ? REP_N : 1); ++rep_) { PHASE_BEGIN();
        pg8::Gemm g{F.MB, F.Wout, DM, DM, DM, 0}; pg8::StaticOrder S; S.init(MP, DM, F.G, (int)blockIdx.x);
        EpiOut E{F.out, F.ss};
        pg8::gemm_phase<EpiOut, pg8::StaticOrder, true, true>(F.lds + RING_OFF, g, S, E, F.tid);
        PHASE_BEGIN();
        { pg8::Gemm gs{F.MB + (size_t)MP * DM, F.Wout, DM, DM, DM, 0}; pg8::sgemm_phase<EpiOut>(F.lds + RING_OFF, gs, MP, DM / 64, F.vcu, F.G, E, F.tid); }
    } SEAM(6);

    if (((PH_MASK >> 7) & 1) && IN(7)) for (int rep_ = 0; rep_ < (REP_PHASE == 7 ? REP_N : 1); ++rep_) { PHASE_BEGIN();
        for (int m = gw; m < MP + MS; m += NGW) {
            const float* xr = m < MP ? F.x_p + (size_t)m * DM : F.x_s + (size_t)(m - MP) * DM;
            float* yr = F.out + (m < MP ? O_YP + (size_t)m * DM : O_YS + (size_t)(m - MP) * DM);
            const float* gr = F.mod + (size_t)(m < MP ? (m >> 11) : 4 + (m - MP)) * 6144 + 2 * DM;
            final_row(F, xr, yr, F.ss + (size_t)m * 64, gr);
        }
    }
#undef IN
#undef SEAM
}

extern "C" void kernel_launch(void* const* d_in, const int* in_sizes, int n_in, void* d_out, int out_size, void* d_ws, size_t ws_size, hipStream_t stream) {
    static int grid = 0;
    if (grid == 0) {
        if (n_in != 19 || ws_size < WS_END) { fprintf(stderr, "kernel_launch: unexpected inputs (n_in %d, ws %zu)\n", n_in, ws_size); grid = -1; return; }
        int dev = 0, cus = 0, per_cu = 0;
        if (hipGetDevice(&dev) != hipSuccess || hipDeviceGetAttribute(&cus, hipDeviceAttributeMultiprocessorCount, dev) != hipSuccess) { grid = -1; return; }
        if (hipFuncSetAttribute((const void*)hybrid_fwd, hipFuncAttributeMaxDynamicSharedMemorySize, LDS_BYTES) != hipSuccess) { fprintf(stderr, "kernel_launch: hipFuncSetAttribute failed\n"); grid = -1; return; }
        if (hipOccupancyMaxActiveBlocksPerMultiprocessor(&per_cu, (const void*)hybrid_fwd, NWAVES * 64, LDS_BYTES) != hipSuccess || per_cu < 1) { fprintf(stderr, "kernel_launch: occupancy query says %d\n", per_cu); per_cu = 1; }
        (void)hipGetLastError();
        grid = cus;
    }
    if (grid < 0) return;
    (void)hipMemsetAsync((char*)d_ws + WS_CTL, 0, CTL_ZERO_BYTES, stream);
    Args a{};
    for (int i = 0; i < 19; ++i) a.in[i] = (const float*)d_in[i];
    a.out = (float*)d_out; a.ws = (unsigned char*)d_ws;
    if (MK_N_LAUNCHES == 1) { a.ph_lo = 0; a.ph_hi = N_PHASES; hipLaunchKernelGGL(hybrid_fwd, dim3(grid), dim3(NWAVES * 64), LDS_BYTES, stream, a); }
    else for (int p = 0; p < N_PHASES; ++p) { a.ph_lo = p; a.ph_hi = p + 1; hipLaunchKernelGGL(hybrid_fwd, dim3(grid), dim3(NWAVES * 64), LDS_BYTES, stream, a); }
}
```

```cpp
#include <hip/hip_runtime.h>
#include <cstdio>
#include <cstdint>

#ifndef PH_MASK
#define PH_MASK 255
#endif
#ifndef REP_PHASE
#define REP_PHASE -1
#define REP_N 1
#endif
#ifndef MK_N_LAUNCHES
#define MK_N_LAUNCHES 1
#endif

namespace pg8 {
#define PG8_LAS __attribute__((address_space(3)))
typedef unsigned short bf16_t;
typedef short bf16x8 __attribute__((ext_vector_type(8)));
typedef float f32x4 __attribute__((ext_vector_type(4)));
typedef unsigned u32x4 __attribute__((ext_vector_type(4)));
typedef unsigned u32x2 __attribute__((ext_vector_type(2)));
constexpr int BM = 256, BK = 64, HALF = 128, HTB = HALF * BK * 2  , STAGE_BYTES = 8 * HTB, NXCD = 8, WGM = 8;

__host__ __device__ __forceinline__ int lds_byte(int r, int c) { const int st = (r >> 4) * 2 + (c >> 5), rr = r & 15, cc = c & 31, ob = rr * 64 + cc * 2; return st * 1024 + (ob ^ (((ob >> 9) & 1) << 5)); }
__host__ __device__ __forceinline__ void stage_rc(int b, int& R, int& C) { const int st = b / 1024, sb = b % 1024, swz = sb ^ (((sb >> 9) & 1) << 5); R = (st >> 1) * 16 + swz / 64; C = (st & 1) * 32 + (swz % 64) / 2; }
__host__ __device__ __forceinline__ int perm32(int rho) { const int n = rho >> 4, i = rho & 15; return 8 * (i >> 2) + 4 * n + (i & 3); }

struct Unit { int pm, pn; };
struct Gemm { const bf16_t* A; const bf16_t* Bt; int K, lda, ldb, a_pn_bytes; };

struct StaticOrder {
    int nM, nN, nwg, G, c;
    __host__ __device__ void init(int M, int N, int G_, int c_) { nM = M / BM; nN = N / BM; nwg = nM * nN; G = G_; c = c_; }
    __host__ __device__ bool next(int i, Unit& u) const {
        const long L = (long)i * G + c; if (L >= nwg) return false;
        int wgid = (int)L; { const int q = nwg / NXCD, r = nwg % NXCD, xcd = wgid % NXCD, off = wgid / NXCD; wgid = (xcd < r ? xcd * (q + 1) : r * (q + 1) + (xcd - r) * q) + off; }
        const int nig = WGM * nN, gid = wgid / nig, fm = gid * WGM, gsz = (nM - fm) < WGM ? (nM - fm) : WGM;
        u.pm = fm + ((wgid % nig) % gsz); u.pn = (wgid % nig) / gsz; return true;
    }
};

__device__ __forceinline__ unsigned cvt_pk_bf16(float lo, float hi) { unsigned r; asm volatile("v_cvt_pk_bf16_f32 %0, %1, %2" : "=v"(r) : "v"(lo), "v"(hi)); return r; }
__device__ __forceinline__ float bf_lo(unsigned w) { return __uint_as_float(w << 16); }
__device__ __forceinline__ float bf_hi(unsigned w) { return __uint_as_float(w & 0xffff0000u); }
__device__ __forceinline__ float sigmoidf_(float v) { return __builtin_amdgcn_rcpf(1.0f + __builtin_amdgcn_exp2f(-1.4426950408889634f * v)); }


template <class Epi, class Sched, bool ALIGN_EPI = false, bool SP2 = false>
__device__ __forceinline__ void gemm_phase(PG8_LAS unsigned char* lds, const Gemm g, const Sched& S, const Epi& E, const int tid) {
    const int wid = __builtin_amdgcn_readfirstlane(tid >> 6), lane = tid & 63, wr = wid >> 2, wc = wid & 3, fr = lane & 15, fq = lane >> 4;
    const int K = g.K, nt = K / BK;
    unsigned voffA[2], voffB[2];
#pragma unroll
    for (int i = 0; i < 2; ++i) { int R, C; stage_rc(tid * 16 + i * 8192, R, C); const int Rb = Epi::PERM ? ((R & ~31) + perm32(R & 31)) : R;
        voffA[i] = (unsigned)(R * g.lda + C) * 2u; voffB[i] = (unsigned)(Rb * g.ldb + C) * 2u; }
    const size_t kstep = (size_t)(BK * 2);
    const size_t hstepA = (size_t)HALF * g.lda * 2, hstepB = (size_t)HALF * g.ldb * 2;
    const size_t tstepA = 2 * hstepA, tstepB = 2 * hstepB;
    const unsigned ldsw = (unsigned)wid * 1024u;
    const int aoff = lds_byte(wr * 64 + fr, fq * 8), boff = lds_byte(wc * 32 + fr, fq * 8);
#define PG8_SA(b, h) (((b) * 2 + (h)) * HTB)
#define PG8_SB(b, h) ((4 + (b) * 2 + (h)) * HTB)
#define PG8_STAGE(bufoff, gbase, voff) do { _Pragma("unroll") for (int _i = 0; _i < 2; ++_i) \
        __builtin_amdgcn_global_load_lds((const unsigned*)((const char*)(gbase) + (voff)[_i]), (PG8_LAS unsigned*)(lds + (bufoff) + ldsw + _i * 8192), 16, 0, 0); } while (0)
#define PG8_LDA(dst, b, h) do { _Pragma("unroll") for (int m = 0; m < 4; ++m) _Pragma("unroll") for (int k = 0; k < 2; ++k) dst[m][k] = *(const PG8_LAS bf16x8*)(lds + PG8_SA(b, h) + aoff + m * 2048 + k * 1024); } while (0)
#define PG8_LDB(dst, b, h) do { _Pragma("unroll") for (int n = 0; n < 2; ++n) _Pragma("unroll") for (int k = 0; k < 2; ++k) dst[n][k] = *(const PG8_LAS bf16x8*)(lds + PG8_SB(b, h) + boff + n * 2048 + k * 1024); } while (0)
#define PG8_MMA(ai, bj, At, Bt) do { __builtin_amdgcn_s_setprio(1); _Pragma("unroll") for (int m = 0; m < 4; ++m) _Pragma("unroll") for (int n = 0; n < 2; ++n) _Pragma("unroll") for (int k = 0; k < 2; ++k) \
        acc[ai][bj][m][n] = __builtin_amdgcn_mfma_f32_16x16x32_bf16(Bt[n][k], At[m][k], acc[ai][bj][m][n], 0, 0, 0); __builtin_amdgcn_s_setprio(0); } while (0)
#define PG8_WAIT_V(n) asm volatile("s_waitcnt vmcnt(" #n ")" ::: "memory")
#define PG8_WAIT_L(n) asm volatile("s_waitcnt lgkmcnt(" #n ")" ::: "memory")
#define PG8_BAR __builtin_amdgcn_s_barrier()
#define PG8_SCHED __builtin_amdgcn_sched_barrier(0)
    Unit cur, nxt; int ui = 0;
    if (!S.next(0, cur)) return;
    f32x4 acc[2][2][4][2];
#pragma unroll
    for (int a = 0; a < 2; ++a)
#pragma unroll
        for (int b = 0; b < 2; ++b)
#pragma unroll
            for (int m = 0; m < 4; ++m)
#pragma unroll
                for (int n = 0; n < 2; ++n) acc[a][b][m][n] = (f32x4){0.f, 0.f, 0.f, 0.f};
    bf16x8 At[4][2], B0[2][2], B1[2][2];
    const char* cA = (const char*)g.A + (size_t)cur.pm * tstepA + (size_t)cur.pn * g.a_pn_bytes; const char* cB = (const char*)g.Bt + (size_t)cur.pn * tstepB;
    if constexpr (SP2) {
        PG8_STAGE(PG8_SB(0, 0), cB, voffB); PG8_STAGE(PG8_SB(0, 1), cB + hstepB, voffB); PG8_STAGE(PG8_SA(0, 0), cA, voffA); PG8_STAGE(PG8_SA(0, 1), cA + hstepA, voffA);
        if (wr == 1) PG8_BAR;
        PG8_WAIT_V(2); PG8_BAR;
        PG8_STAGE(PG8_SB(1, 0), cB + kstep, voffB); PG8_STAGE(PG8_SA(1, 0), cA + kstep, voffA); PG8_STAGE(PG8_SB(1, 1), cB + hstepB + kstep, voffB);
        PG8_WAIT_V(6); PG8_BAR;
    } else {
        PG8_STAGE(PG8_SB(0, 0), cB, voffB); PG8_STAGE(PG8_SA(0, 0), cA, voffA); PG8_STAGE(PG8_SB(0, 1), cB + hstepB, voffB); PG8_STAGE(PG8_SA(0, 1), cA + hstepA, voffA);
        if (wr == 1) PG8_BAR;
        PG8_WAIT_V(4); PG8_BAR;
        PG8_STAGE(PG8_SB(1, 0), cB + kstep, voffB); PG8_STAGE(PG8_SA(1, 0), cA + kstep, voffA); PG8_STAGE(PG8_SB(1, 1), cB + hstepB + kstep, voffB);
        PG8_WAIT_V(6); PG8_BAR;
    }
    for (;;) {
        const bool has_next = S.next(ui + 1, nxt);
        const char* nA = has_next ? (const char*)g.A + (size_t)nxt.pm * tstepA + (size_t)nxt.pn * g.a_pn_bytes : cA; const char* nB = has_next ? (const char*)g.Bt + (size_t)nxt.pn * tstepB : cB;
        for (int t = 0; t < nt; t += 2) {
            if constexpr (Epi::MID_T > 0) { if (t == Epi::MID_T) {
#pragma unroll
                for (int ai = 0; ai < 2; ++ai)
#pragma unroll
                    for (int bj = 0; bj < 2; ++bj) E.template mid<4>(acc[ai][bj], cur.pm * BM + ai * HALF + wr * 64 + fr, cur.pn * BM + bj * HALF + wc * 32, fq); } }
            const bool last = (t == nt - 2);
            const char* a1 = cA + (size_t)(t + 1) * kstep;
            const char* a2 = last ? nA : cA + (size_t)(t + 2) * kstep; const char* b2 = last ? nB : cB + (size_t)(t + 2) * kstep;
            const char* a3 = a2 + kstep; const char* b3 = b2 + kstep;
            if constexpr (SP2) {
            PG8_LDB(B0, 0, 0); PG8_LDB(B1, 0, 1); PG8_SCHED; PG8_LDA(At, 0, 0); PG8_STAGE(PG8_SA(1, 1), a1 + hstepA, voffA);
            PG8_WAIT_V(8); PG8_WAIT_L(0); PG8_BAR; PG8_MMA(0, 0, At, B0); PG8_MMA(0, 1, At, B1); PG8_BAR; PG8_SCHED;
            PG8_LDA(At, 0, 1); PG8_STAGE(PG8_SB(0, 0), b2, voffB); PG8_STAGE(PG8_SB(0, 1), b2 + hstepB, voffB); PG8_STAGE(PG8_SA(0, 0), a2, voffA);
            PG8_WAIT_V(8); PG8_WAIT_L(0); PG8_BAR; PG8_MMA(1, 0, At, B0); PG8_MMA(1, 1, At, B1); PG8_BAR; PG8_SCHED;
            PG8_LDB(B0, 1, 0); PG8_LDB(B1, 1, 1); PG8_SCHED; PG8_LDA(At, 1, 0); PG8_STAGE(PG8_SA(0, 1), a2 + hstepA, voffA);
            PG8_WAIT_V(8); PG8_WAIT_L(0); PG8_BAR; PG8_MMA(0, 0, At, B0); PG8_MMA(0, 1, At, B1); PG8_BAR; PG8_SCHED;
            PG8_LDA(At, 1, 1); PG8_STAGE(PG8_SB(1, 0), b3, voffB); PG8_STAGE(PG8_SB(1, 1), b3 + hstepB, voffB); PG8_STAGE(PG8_SA(1, 0), a3, voffA);
            PG8_WAIT_V(8); PG8_WAIT_L(0); PG8_BAR; PG8_MMA(1, 0, At, B0); PG8_MMA(1, 1, At, B1); PG8_BAR; PG8_SCHED;
            } else {
            PG8_LDB(B0, 0, 0); PG8_SCHED; PG8_LDA(At, 0, 0); PG8_STAGE(PG8_SA(1, 1), a1 + hstepA, voffA);
            PG8_WAIT_L(8); PG8_BAR; PG8_WAIT_L(0); PG8_MMA(0, 0, At, B0); PG8_BAR; PG8_SCHED;
            PG8_LDB(B1, 0, 1); PG8_STAGE(PG8_SB(0, 0), b2, voffB);
            PG8_BAR; PG8_WAIT_L(0); PG8_MMA(0, 1, At, B1); PG8_BAR;
            PG8_LDA(At, 0, 1); PG8_STAGE(PG8_SA(0, 0), a2, voffA);
            PG8_BAR; PG8_WAIT_L(0); PG8_MMA(1, 0, At, B0); PG8_BAR; PG8_SCHED;
            PG8_STAGE(PG8_SB(0, 1), b2 + hstepB, voffB);
            PG8_WAIT_V(6); PG8_BAR; PG8_MMA(1, 1, At, B1); PG8_BAR;
            PG8_LDB(B0, 1, 0); PG8_SCHED; PG8_LDA(At, 1, 0); PG8_STAGE(PG8_SA(0, 1), a2 + hstepA, voffA);
            PG8_WAIT_L(8); PG8_BAR; PG8_WAIT_L(0); PG8_MMA(0, 0, At, B0); PG8_BAR; PG8_SCHED;
            PG8_LDB(B1, 1, 1); PG8_STAGE(PG8_SB(1, 0), b3, voffB);
            PG8_BAR; PG8_WAIT_L(0); PG8_MMA(0, 1, At, B1); PG8_BAR;
            PG8_LDA(At, 1, 1); PG8_STAGE(PG8_SA(1, 0), a3, voffA);
            PG8_BAR; PG8_WAIT_L(0); PG8_MMA(1, 0, At, B0); PG8_BAR; PG8_SCHED;
            PG8_STAGE(PG8_SB(1, 1), b3 + hstepB, voffB);
            PG8_WAIT_V(6); PG8_BAR; PG8_MMA(1, 1, At, B1); PG8_BAR;
            }
        }
        if constexpr (ALIGN_EPI) { if (wr == 0) PG8_BAR; }
#pragma unroll
        for (int ai = 0; ai < 2; ++ai)
#pragma unroll
            for (int bj = 0; bj < 2; ++bj) E.template core<4>(acc[ai][bj], cur.pm * BM + ai * HALF + wr * 64 + fr, cur.pn * BM + bj * HALF + wc * 32, fq);
        if (!has_next) break;
#pragma unroll
        for (int a = 0; a < 2; ++a)
#pragma unroll
            for (int b = 0; b < 2; ++b)
#pragma unroll
                for (int m = 0; m < 4; ++m)
#pragma unroll
                    for (int n = 0; n < 2; ++n) acc[a][b][m][n] = (f32x4){0.f, 0.f, 0.f, 0.f};
        cur = nxt; cA = nA; cB = nB; ++ui;
        if constexpr (ALIGN_EPI) { if (wr == 1) PG8_BAR; }
    }
    PG8_WAIT_V(0);
    if constexpr (!ALIGN_EPI) { if (wr == 0) PG8_BAR; }
    PG8_BAR;
#undef PG8_SA
#undef PG8_SB
#undef PG8_STAGE
#undef PG8_LDA
#undef PG8_LDB
#undef PG8_MMA
#undef PG8_WAIT_V
#undef PG8_WAIT_L
#undef PG8_BAR
#undef PG8_SCHED
}

template <class Epi>
__device__ __forceinline__ void sgemm_phase(PG8_LAS unsigned char* lds, const Gemm g, const int row_base, const int n_units, const int first, const int stride, const Epi& E, const int tid) {
    const int wid = __builtin_amdgcn_readfirstlane(tid >> 6), lane = tid & 63, wr = wid >> 1, wc = wid & 1, fr = lane & 15, fq = lane >> 4;
    const int nt = g.K / BK;
    unsigned voffA[2], voffB;
#pragma unroll
    for (int i = 0; i < 2; ++i) { int R, C; stage_rc(tid * 16 + i * 8192, R, C); voffA[i] = (unsigned)(R * g.lda + C) * 2u;
        if (i == 0) { const int Rb = Epi::PERM ? ((R & ~31) + perm32(R & 31)) : R; voffB = (unsigned)(Rb * g.ldb + C) * 2u; } }
    const unsigned ldsw = (unsigned)wid * 1024u;
    const int aoff = lds_byte(wr * 32 + fr, fq * 8), boff = 16384 + lds_byte(wc * 32 + fr, fq * 8);
    constexpr int SLOT = 24576;
#define SG_STAGE(slot, pa, pb) do { \
        __builtin_amdgcn_global_load_lds((const unsigned*)((pa) + voffA[0]), (PG8_LAS unsigned*)(lds + (slot) * SLOT + ldsw), 16, 0, 0); \
        __builtin_amdgcn_global_load_lds((const unsigned*)((pa) + voffA[1]), (PG8_LAS unsigned*)(lds + (slot) * SLOT + ldsw + 8192), 16, 0, 0); \
        __builtin_amdgcn_global_load_lds((const unsigned*)((pb) + voffB), (PG8_LAS unsigned*)(lds + (slot) * SLOT + 16384 + ldsw), 16, 0, 0); } while (0)
    const char* cA = (const char*)g.A;
    for (int ui = first; ui < n_units; ui += stride) {
        const char* cB = (const char*)g.Bt + (size_t)ui * 64 * g.ldb * 2;
        f32x4 acc[2][2];
#pragma unroll
        for (int m = 0; m < 2; ++m)
#pragma unroll
            for (int n = 0; n < 2; ++n) acc[m][n] = (f32x4){0.f, 0.f, 0.f, 0.f};
        SG_STAGE(0, cA, cB); SG_STAGE(1, cA + 128, cB + 128); SG_STAGE(2, cA + 256, cB + 256);
        for (int t = 0; t < nt; ++t) {
            if constexpr (Epi::MID_T > 0) { if (t == Epi::MID_T) E.template mid<2>(acc, row_base + wr * 32 + fr, ui * 64 + wc * 32, fq); }
            asm volatile("s_waitcnt vmcnt(6)" ::: "memory"); __builtin_amdgcn_s_barrier();
            { const int tn = (t + 3 < nt) ? t + 3 : nt - 1; const int sl = (t + 3) & 3; SG_STAGE(sl, cA + (size_t)tn * 128, cB + (size_t)tn * 128); }
            const PG8_LAS unsigned char* sp = lds + (t & 3) * SLOT;
            bf16x8 At[2][2], Bt[2][2];
#pragma unroll
            for (int m = 0; m < 2; ++m)
#pragma unroll
                for (int k = 0; k < 2; ++k) At[m][k] = *(const PG8_LAS bf16x8*)(sp + aoff + m * 2048 + k * 1024);
#pragma unroll
            for (int n = 0; n < 2; ++n)
#pragma unroll
                for (int k = 0; k < 2; ++k) Bt[n][k] = *(const PG8_LAS bf16x8*)(sp + boff + n * 2048 + k * 1024);
            asm volatile("s_waitcnt lgkmcnt(0)" ::: "memory");
            __builtin_amdgcn_sched_barrier(0);
#pragma unroll
            for (int m = 0; m < 2; ++m)
#pragma unroll
                for (int n = 0; n < 2; ++n)
#pragma unroll
                    for (int k = 0; k < 2; ++k) acc[m][n] = __builtin_amdgcn_mfma_f32_16x16x32_bf16(Bt[n][k], At[m][k], acc[m][n], 0, 0, 0);
        }
        asm volatile("s_waitcnt vmcnt(0)" ::: "memory"); __builtin_amdgcn_s_barrier();
        E.template core<2>(acc, row_base + wr * 32 + fr, ui * 64 + wc * 32, fq);
    }
#undef SG_STAGE
}
}

constexpr int NWAVES = 8;
constexpr int DM = 2048, MP = 8192, MS = 128, SEQ = 2048, MT = 8448;
constexpr int DPOOL = 1024, NH = 8, DK = 128, DV = 256, DIN = 8192, LDZ = 12288, LDY = 3072;
constexpr int ZC_AX = 0, ZC_AG = 1024, ZC_Q = 2048, ZC_K = 3072, ZC_V = 4096, ZC_BG = 6144, ZC_GA = 8192, ZC_GB = 10240;
constexpr float EPS = 1e-6f;
constexpr int PAST = 16384;
constexpr size_t O_YP = 0, O_YS = 16777216, O_PP = 17039360, O_RP = 17100800, O_PS = 18149376, O_RS = 20115456;

constexpr size_t MiB = 1u << 20;
constexpr size_t WS_CTL = 0, CTL_ZERO_BYTES = 1 * MiB;
constexpr size_t WS_ROPE = 1 * MiB;
constexpr size_t WS_MOD = 3 * MiB;
constexpr size_t WS_SS = 7 * MiB;
constexpr size_t WS_WCAT = 16 * MiB;
constexpr size_t WS_WAB = 64 * MiB;
constexpr size_t WS_WOUT = 76 * MiB;
constexpr size_t WS_POOLW = 84 * MiB;
constexpr size_t WS_H = 96 * MiB;
constexpr size_t WS_Z = 130 * MiB;
constexpr size_t WS_YAB = 328 * MiB;
constexpr size_t WS_POOLED = 378 * MiB;
constexpr size_t WS_SN = 396 * MiB;
constexpr size_t WS_MB = 428 * MiB;
constexpr size_t WS_END = 462 * MiB;
constexpr int CW_BAR = 4096;

constexpr int RING_OFF = 0, RING_BYTES = 131072;
constexpr int LDSCTL_OFF = RING_BYTES, MISC_OFF = LDSCTL_OFF + 320;
constexpr int STAT_OFF = RING_BYTES + 1024;
constexpr int LDS_BYTES = 147456;

#define GAS __attribute__((address_space(1)))
#define LAS __attribute__((address_space(3)))
typedef unsigned short bf16;
typedef unsigned v4u __attribute__((ext_vector_type(4)));
typedef unsigned v2u __attribute__((ext_vector_type(2)));
typedef float f32x4 __attribute__((ext_vector_type(4)));
typedef float f32x16 __attribute__((ext_vector_type(16)));
typedef short bf16x8 __attribute__((ext_vector_type(8)));
typedef short s16x4 __attribute__((ext_vector_type(4)));
typedef GAS unsigned gu32;
#define RLX_AGENT __ATOMIC_RELAXED, __HIP_MEMORY_SCOPE_AGENT
#define LDS_WAIT() asm volatile("s_waitcnt lgkmcnt(0)" ::: "memory")
#define VM_WAIT() asm volatile("s_waitcnt vmcnt(0)" ::: "memory")
__device__ __forceinline__ unsigned f2bf(float f) { unsigned u = __builtin_bit_cast(unsigned, f); return (u + 0x7fffu + ((u >> 16) & 1u)) >> 16; }
__device__ __forceinline__ unsigned pk2(float lo, float hi) { return f2bf(lo) | (f2bf(hi) << 16); }
__device__ __forceinline__ float bflo(unsigned w) { return __uint_as_float(w << 16); }
__device__ __forceinline__ float bfhi(unsigned w) { return __uint_as_float(w & 0xffff0000u); }
__device__ __forceinline__ float bf1(bf16 b) { return __uint_as_float((unsigned)b << 16); }
__device__ __forceinline__ float silu_(float v) { return v * __builtin_amdgcn_rcpf(1.0f + __builtin_amdgcn_exp2f(-1.4426950408889634f * v)); }
__device__ __forceinline__ float wave_sum(float v) {
#pragma unroll
    for (int o = 1; o < 64; o <<= 1) v += __shfl_xor(v, o);
    return v;
}
__device__ __forceinline__ float lg2gamma(int h) {
    const float t[8] = {-0.04580368961312479f, -0.02272007650008353f, -0.011315313227834146f, -0.005646563141142063f, -0.0028205190623786626f, -0.0014095702546713536f, -0.0007046129765893727f, -0.0003522634716290214f};
    float r = t[0];
#pragma unroll
    for (int i = 1; i < 8; ++i) r = (h == i) ? t[i] : r;
    return r;
}

__device__ __forceinline__ int fresh_lane() { unsigned m_ = ~0u; asm volatile("" : "+s"(m_)); return (int)__builtin_amdgcn_mbcnt_hi(m_, __builtin_amdgcn_mbcnt_lo(m_, 0u)); }
#define XB_TMO      128
#define XB_XCNT(j)  (256  + 64 * (j))
#define XB_XSUB(j)  (1280 + 64 * (j))
#define XB_XGEN(j)  (2304 + 64 * (j))
#define XB_TOP      3328
#define XB_TOPGEN   3392
#define XCD_BAR_WORDS 3456
#define XB_SPIN_CAP (1u << 18)
__device__ __forceinline__ unsigned xb_ld(unsigned* p)              { return __hip_atomic_load(p, __ATOMIC_RELAXED, __HIP_MEMORY_SCOPE_AGENT); }
__device__ __forceinline__ unsigned xb_add(unsigned* p, unsigned v) { return __hip_atomic_fetch_add(p, v, __ATOMIC_RELAXED, __HIP_MEMORY_SCOPE_AGENT); }
__device__ __forceinline__ unsigned xb_xcc_id() { return (unsigned)__builtin_amdgcn_s_getreg((3 << 11) | 20) & 0xFu; }
#define XB_SPIN(cond, bar) do { unsigned _sp = 0; while (cond) { __builtin_amdgcn_s_sleep(1); \
    if ((++_sp & 255u) == 0u) { if (xb_ld(&(bar)[XB_TMO])) break; if (_sp > XB_SPIN_CAP) { atomicAdd(&(bar)[XB_TMO], 1u); break; } } } } while (0)
struct XcdBarrier { unsigned* bar; unsigned x; volatile LAS unsigned* st; int wave; };
__device__ __forceinline__ XcdBarrier xcd_barrier_post(unsigned* bar, volatile LAS unsigned* st, int wave) {
    XcdBarrier b; b.bar = bar; b.x = xb_xcc_id(); b.st = st; b.wave = wave;
    if (wave == 0 && fresh_lane() == 0) (void)xb_add(&bar[XB_XCNT(b.x)], 1u);
    return b;
}
__device__ __forceinline__ void xcd_barrier_complete(unsigned* bar, unsigned x, unsigned& nloc, unsigned& nx) {
    const unsigned G = gridDim.x * gridDim.y * gridDim.z;
    unsigned sum, cnt, mine, sp = 0u;
    for (;;) {
        sum = 0u; cnt = 0u; mine = 0u;
#pragma unroll
        for (unsigned j = 0; j < 16; ++j) { const unsigned c = xb_ld(&bar[XB_XCNT(j)]); sum += c; cnt += (c > 0u) ? 1u : 0u; mine = (j == x) ? c : mine; }
        if (sum == G) break;
        __builtin_amdgcn_s_sleep(1);
        if ((++sp & 255u) == 0u) { if (xb_ld(&bar[XB_TMO])) break; if (sp > XB_SPIN_CAP) { atomicAdd(&bar[XB_TMO], 1u); break; } }
    }
    nloc = mine > 0u ? mine : 1u; nx = cnt > 0u ? cnt : 1u;
}
__device__ __forceinline__ void xcd_barrier(const XcdBarrier& b) {
    asm volatile("s_waitcnt vmcnt(0)" ::: "memory");
    __syncthreads();
    if (b.wave == 0 && fresh_lane() == 0) {
        unsigned* bar = b.bar;
        __builtin_amdgcn_s_waitcnt(0);
        unsigned nloc = b.st[0], nx = b.st[1];
        if (nloc == 0u) { xcd_barrier_complete(bar, b.x, nloc, nx); b.st[0] = nloc; b.st[1] = nx; }
        const unsigned old = xb_add(&bar[XB_XSUB(b.x)], 1u);
        const unsigned gen = old / nloc;
        if (old + 1u == (gen + 1u) * nloc) {
            __builtin_amdgcn_fence(__ATOMIC_RELEASE, "agent");
            asm volatile("s_waitcnt vmcnt(0)" ::: "memory");
            const unsigned og = xb_add(&bar[XB_TOP], 1u);
            const unsigned tg = og / nx;
            if (og + 1u == (tg + 1u) * nx) xb_add(&bar[XB_TOPGEN], 1u);
            else XB_SPIN(xb_ld(&bar[XB_TOPGEN]) == tg, bar);
            __builtin_amdgcn_fence(__ATOMIC_ACQUIRE, "agent");
            xb_add(&bar[XB_XGEN(b.x)], 1u);
            asm volatile("s_waitcnt vmcnt(0)" ::: "memory");
        } else {
            XB_SPIN(xb_ld(&bar[XB_XGEN(b.x)]) == gen, bar);
            __builtin_amdgcn_fence(__ATOMIC_ACQUIRE, "agent");
            asm volatile("s_waitcnt vmcnt(0)" ::: "memory");
        }
    }
    __syncthreads();
}

struct Frame {
    LAS unsigned char* lds;
    volatile LAS unsigned* MISC;
    gu32* ctl;
    int tid, lane, wave;
    int vcu, G;
    const float *x_p, *x_s, *st_pool, *st_ret, *c_p, *c_s, *ada_w, *ada_b, *g_pre, *g_post, *w_in, *pool_w, *pool_scale, *gn_g, *w_a, *w_b, *w_merge, *b_merge, *w_out;
    float* out;
    float *ropec, *ropes, *mod, *ss;
    bf16 *Wcat, *Wab, *Wout, *PoolW, *H, *Z, *YAB, *POOLED, *SN, *MB;
};

struct EpiZ {
    static constexpr bool PERM = true; static constexpr int MID_T = 0;
    bf16* Z; const float* bmerge; const float* ropec; const float* ropes; float* out_pp; float* out_ps;
    template <int NM> __device__ __forceinline__ void core(const pg8::f32x4 (&a)[NM][2], int row0, int cs, int fq) const {
        using namespace pg8;
        if (cs >= ZC_Q && cs < ZC_V) {
            const float ksc = (cs >= ZC_K) ? 0.08838834764831845f : 1.0f;
            const int j0 = 16 * ((cs & 127) >> 5) + 4 * fq, hb = cs & ~127;
#pragma unroll
            for (int m = 0; m < NM; ++m) {
                const int row = row0 + m * 16; const int pos = row < MP ? (row & (SEQ - 1)) : SEQ;
                const f32x4 c4 = *(const f32x4*)(ropec + pos * 64 + j0), s4 = *(const f32x4*)(ropes + pos * 64 + j0);
                bf16* rowp = Z + (size_t)row * LDZ + hb + j0;
                const f32x4 v0 = a[m][0], v1 = a[m][1];
                const f32x4 o1 = (v0 * c4 - v1 * s4) * ksc, o2 = (v0 * s4 + v1 * c4) * ksc;
                u32x2 w1, w2; w1.x = cvt_pk_bf16(o1[0], o1[1]); w1.y = cvt_pk_bf16(o1[2], o1[3]); w2.x = cvt_pk_bf16(o2[0], o2[1]); w2.y = cvt_pk_bf16(o2[2], o2[3]);
                *(u32x2*)rowp = w1; *(u32x2*)(rowp + 64) = w2;
            }
            return;
        }
        const int act = (cs >= ZC_GA) ? 2 : (((cs >= ZC_AG && cs < ZC_Q) || (cs >= ZC_BG)) ? 1 : 0);
        const int col = cs + 8 * fq;
        f32x4 bv[2];
#pragma unroll
        for (int n = 0; n < 2; ++n) bv[n] = (act == 2) ? *(const f32x4*)(bmerge + (col - ZC_GA) + 4 * n) : (f32x4){0.f, 0.f, 0.f, 0.f};
#pragma unroll
        for (int m = 0; m < NM; ++m) {
            const int row = row0 + m * 16;
            f32x4 v0 = a[m][0] + bv[0], v1 = a[m][1] + bv[1];
            if (act == 1) {
#pragma unroll
                for (int e = 0; e < 4; ++e) { v0[e] = silu_(v0[e]); v1[e] = silu_(v1[e]); }
            } else if (act == 2) {
#pragma unroll
                for (int e = 0; e < 4; ++e) { v0[e] = sigmoidf_(v0[e]); v1[e] = sigmoidf_(v1[e]); }
            }
            u32x4 w; w.x = cvt_pk_bf16(v0[0], v0[1]); w.y = cvt_pk_bf16(v0[2], v0[3]); w.z = cvt_pk_bf16(v1[0], v1[1]); w.w = cvt_pk_bf16(v1[2], v1[3]);
            *(u32x4*)(Z + (size_t)row * LDZ + col) = w;
            if (cs < ZC_AG) {
                if (row < MP) { const int t = row & (SEQ - 1); if (t >= SEQ - 15) { float* o = out_pp + ((size_t)((row >> 11) * 15 + (t - (SEQ - 15)))) * DPOOL + col; *(f32x4*)o = v0; *(f32x4*)(o + 4) = v1; } }
                else if (row < MP + MS) { float* o = out_ps + ((size_t)((row - MP) * 15 + 14)) * DPOOL + col; *(f32x4*)o = v0; *(f32x4*)(o + 4) = v1; }
            }
        }
    }
    template <int NM> __device__ __forceinline__ void mid(pg8::f32x4 (&)[NM][2], int, int, int) const {}
};
struct EpiPool {
    static constexpr bool PERM = true; static constexpr int MID_T = 0;
    bf16* Y; const bf16* Z; const float* pscale;
    template <int NM> __device__ __forceinline__ void core(const pg8::f32x4 (&a)[NM][2], int row0, int cs, int fq) const {
        using namespace pg8;
        const int col = cs + 8 * fq;
        const f32x4 ps0 = *(const f32x4*)(pscale + col), ps1 = *(const f32x4*)(pscale + col + 4);
#pragma unroll
        for (int m = 0; m < NM; ++m) {
            const int row = row0 + m * 16;
            const u32x4 g = *(const u32x4*)(Z + (size_t)row * LDZ + ZC_AG + col);
            f32x4 v0 = a[m][0] * ps0, v1 = a[m][1] * ps1;
            v0[0] *= bf_lo(g.x); v0[1] *= bf_hi(g.x); v0[2] *= bf_lo(g.y); v0[3] *= bf_hi(g.y);
            v1[0] *= bf_lo(g.z); v1[1] *= bf_hi(g.z); v1[2] *= bf_lo(g.w); v1[3] *= bf_hi(g.w);
            u32x4 w; w.x = cvt_pk_bf16(v0[0], v0[1]); w.y = cvt_pk_bf16(v0[2], v0[3]); w.z = cvt_pk_bf16(v1[0], v1[1]); w.w = cvt_pk_bf16(v1[2], v1[3]);
            *(u32x4*)(Y + (size_t)row * LDY + col) = w;
        }
    }
    template <int NM> __device__ __forceinline__ void mid(pg8::f32x4 (&)[NM][2], int, int, int) const {}
};
struct EpiMerge {
    static constexpr bool PERM = true; static constexpr int MID_T = 16;
    bf16* O; const bf16* Z;
    template <int NM> __device__ __forceinline__ void mid(pg8::f32x4 (&a)[NM][2], int row0, int cs, int fq) const {
        using namespace pg8;
        const bf16* zb = Z + (size_t)row0 * LDZ + ZC_GA + cs + 8 * fq;
        asm volatile("" : "+v"(zb));
#pragma unroll
        for (int m = 0; m < NM; ++m) {
            const bf16* zr = zb + (size_t)(m * 16) * LDZ;
            const u32x4 ga = *(const u32x4*)zr, gb = *(const u32x4*)(zr + (ZC_GB - ZC_GA));
            f32x4& v0 = a[m][0]; f32x4& v1 = a[m][1];
            v0[0] *= bf_lo(ga.x) * __builtin_amdgcn_rcpf(bf_lo(gb.x)); v0[1] *= bf_hi(ga.x) * __builtin_amdgcn_rcpf(bf_hi(gb.x)); v0[2] *= bf_lo(ga.y) * __builtin_amdgcn_rcpf(bf_lo(gb.y)); v0[3] *= bf_hi(ga.y) * __builtin_amdgcn_rcpf(bf_hi(gb.y));
            v1[0] *= bf_lo(ga.z) * __builtin_amdgcn_rcpf(bf_lo(gb.z)); v1[1] *= bf_hi(ga.z) * __builtin_amdgcn_rcpf(bf_hi(gb.z)); v1[2] *= bf_lo(ga.w) * __builtin_amdgcn_rcpf(bf_lo(gb.w)); v1[3] *= bf_hi(ga.w) * __builtin_amdgcn_rcpf(bf_hi(gb.w));
            if (m & 1) asm volatile("" ::: "memory");
        }
    }
    template <int NM> __device__ __forceinline__ void core(const pg8::f32x4 (&a)[NM][2], int row0, int cs, int fq) const {
        using namespace pg8;
        const int col = cs + 8 * fq;
#pragma unroll
        for (int m = 0; m < NM; ++m) {
            const int row = row0 + m * 16;
            const u32x4 g = *(const u32x4*)(Z + (size_t)row * LDZ + ZC_GB + col);
            f32x4 v0 = a[m][0], v1 = a[m][1];
            v0[0] *= bf_lo(g.x); v0[1] *= bf_hi(g.x); v0[2] *= bf_lo(g.y); v0[3] *= bf_hi(g.y);
            v1[0] *= bf_lo(g.z); v1[1] *= bf_hi(g.z); v1[2] *= bf_lo(g.w); v1[3] *= bf_hi(g.w);
            u32x4 w; w.x = cvt_pk_bf16(v0[0], v0[1]); w.y = cvt_pk_bf16(v0[2], v0[3]); w.z = cvt_pk_bf16(v1[0], v1[1]); w.w = cvt_pk_bf16(v1[2], v1[3]);
            *(u32x4*)(O + (size_t)row * DM + col) = w;
        }
    }
};
struct EpiOut {
    static constexpr bool PERM = false; static constexpr int MID_T = 0;
    float* out; float* ss;
    template <int NM> __device__ __forceinline__ void core(const pg8::f32x4 (&a)[NM][2], int row0, int cs, int fq) const {
        using namespace pg8;
#pragma unroll
        for (int m = 0; m < NM; ++m) {
            const int row = row0 + m * 16;
            float s = 0.f;
#pragma unroll
            for (int n = 0; n < 2; ++n) { const f32x4 v = a[m][n]; s += (v[0] * v[0] + v[1] * v[1]) + (v[2] * v[2] + v[3] * v[3]); }
            s += __shfl_xor(s, 16); s += __shfl_xor(s, 32);
            if (fq == 0) ss[(size_t)row * 64 + (cs >> 5)] = s;
            if (row < MP + MS) {
                float* rowp = out + (row < MP ? O_YP + (size_t)row * DM : O_YS + (size_t)(row - MP) * DM) + cs + 4 * fq;
#pragma unroll
                for (int n = 0; n < 2; ++n) *(f32x4*)(rowp + n * 16) = a[m][n];
            }
        }
    }
    template <int NM> __device__ __forceinline__ void mid(pg8::f32x4 (&)[NM][2], int, int, int) const {}
};

__device__ __forceinline__ int rot_row(int n) { const int L = n & 127, hf = L >> 6, j = L & 63; return (n & ~127) + 32 * (j >> 4) + 8 * ((j >> 2) & 3) + 4 * hf + (j & 3); }
__device__ __forceinline__ void p0_transpose_item(const float* W, int N, bf16* WT, int ldw, int row_off, int koff, int rot_lo, int rot_hi, LAS float* scr, int item, int lane) {
    const int nblk = N / 32, kb = item / nblk, nb = item % nblk, k0 = 64 * kb, n0 = 32 * nb;
#pragma unroll 8
    for (int i = 0; i < 32; ++i) { const int kk = 2 * i + (lane >> 5); scr[kk * 33 + (lane & 31)] = __builtin_nontemporal_load(W + (size_t)(k0 + kk) * N + n0 + (lane & 31)); }
    LDS_WAIT(); asm volatile("" ::: "memory");
    const int c = lane & 7;
#pragma unroll
    for (int j = 0; j < 4; ++j) { const int n = (lane >> 3) + 8 * j; const LAS float* s = scr + (8 * c) * 33 + n;
        v4u o; o.x = pk2(s[0 * 33], s[1 * 33]); o.y = pk2(s[2 * 33], s[3 * 33]); o.z = pk2(s[4 * 33], s[5 * 33]); o.w = pk2(s[6 * 33], s[7 * 33]);
        int nn = n0 + n; if (nn >= rot_lo && nn < rot_hi) nn = rot_row(nn);
        *(GAS v4u*)(WT + (size_t)(row_off + nn) * ldw + koff + k0 + 8 * c) = o; }
    LDS_WAIT(); asm volatile("" ::: "memory");
}
__device__ __forceinline__ void p0_mod_item(Frame& F, int strip) {
    const int n0 = strip * 32, lane = F.lane, fr = lane & 15, fq = lane >> 4, wave = F.wave;
    f32x4 acc[9][2];
#pragma unroll
    for (int a = 0; a < 9; ++a) { acc[a][0] = (f32x4){0.f, 0.f, 0.f, 0.f}; acc[a][1] = (f32x4){0.f, 0.f, 0.f, 0.f}; }
    for (int ks = 0; ks < 8; ++ks) {
        const int k0 = wave * 256 + ks * 32 + 8 * fq;
        bf16x8 bfr[2];
#pragma unroll
        for (int nt = 0; nt < 2; ++nt) {
            float w[8];
#pragma unroll
            for (int j = 0; j < 8; ++j) w[j] = __builtin_nontemporal_load(F.ada_w + (size_t)(k0 + j) * 6144 + n0 + 16 * nt + fr);
            v4u p; p.x = pk2(w[0], w[1]); p.y = pk2(w[2], w[3]); p.z = pk2(w[4], w[5]); p.w = pk2(w[6], w[7]);
            bfr[nt] = __builtin_bit_cast(bf16x8, p);
        }
#pragma unroll
        for (int mt = 0; mt < 9; ++mt) {
            const int row = 16 * mt + fr;
            f32x4 a0 = (f32x4){0.f, 0.f, 0.f, 0.f}, a1 = a0;
            if (row < 132) { const float* cp = (row < 4 ? F.c_p + (size_t)row * DM : F.c_s + (size_t)(row - 4) * DM) + k0; a0 = *(const f32x4*)cp; a1 = *(const f32x4*)(cp + 4); }
            v4u p; p.x = pk2(silu_(a0[0]), silu_(a0[1])); p.y = pk2(silu_(a0[2]), silu_(a0[3])); p.z = pk2(silu_(a1[0]), silu_(a1[1])); p.w = pk2(silu_(a1[2]), silu_(a1[3]));
            const bf16x8 afr = __builtin_bit_cast(bf16x8, p);
            acc[mt][0] = __builtin_amdgcn_mfma_f32_16x16x32_bf16(afr, bfr[0], acc[mt][0], 0, 0, 0);
            acc[mt][1] = __builtin_amdgcn_mfma_f32_16x16x32_bf16(afr, bfr[1], acc[mt][1], 0, 0, 0);
        }
    }
    LAS float* red = (LAS float*)F.lds;
    for (int w = 0; w < 8; ++w) {
        if (wave == w) {
#pragma unroll
            for (int mt = 0; mt < 9; ++mt)
#pragma unroll
                for (int nt = 0; nt < 2; ++nt)
#pragma unroll
                    for (int r = 0; r < 4; ++r) { const int idx = (16 * mt + 4 * fq + r) * 32 + 16 * nt + fr; if (w == 0) red[idx] = acc[mt][nt][r]; else red[idx] += acc[mt][nt][r]; }
        }
        __syncthreads();
    }
    for (int i = F.tid; i < 132 * 32; i += NWAVES * 64) { const int r = i >> 5, cc = i & 31; F.mod[(size_t)r * 6144 + n0 + cc] = red[i] + F.ada_b[n0 + cc]; }
    __syncthreads();
}
__device__ __forceinline__ void rope_entry(int prow, int i, float* cosT, float* sinT) {
    double th = 1.0, bs = 0.8659643233600653;
    for (int e = i; e; e >>= 1) { if (e & 1) th *= bs; bs *= bs; }
    const double t2 = th * th; double c = 1.0, s = th, tc = 1.0, ts = th;
#pragma unroll 1
    for (int n = 1; n <= 12; ++n) { tc *= -t2 / (double)((2 * n - 1) * (2 * n)); c += tc; ts *= -t2 / (double)((2 * n) * (2 * n + 1)); s += ts; }
    const int pos = prow < SEQ ? prow : PAST;
    double rc = 1.0, rs = 0.0, bc = c, bn = s;
    for (int e = pos; e; e >>= 1) { if (e & 1) { const double t = rc * bc - rs * bn; rs = rc * bn + rs * bc; rc = t; } const double t = bc * bc - bn * bn; bn = 2.0 * bc * bn; bc = t; }
    cosT[prow * 64 + i] = (float)rc; sinT[prow * 64 + i] = (float)rs;
}
__device__ __forceinline__ void p0_prologue(Frame& F) {
    if (F.vcu < 192) for (int s = F.vcu; s < 192; s += F.G) p0_mod_item(F, s);
    LAS float* scr = (LAS float*)(F.lds + RING_OFF + F.wave * 16384);
    const int gw = F.vcu * NWAVES + F.wave, NGW = F.G * NWAVES;
    constexpr int I_IN = 32 * 256, I_MG = 32 * 128, I_A = 16 * 64, I_B = 32 * 64, I_O = 32 * 64, I_P = 4 * 8;
    constexpr int NITEMS = I_IN + I_MG + I_A + I_B + I_O + 4 * I_P;
    for (int it = gw; it < NITEMS; it += NGW) {
        int r = it;
        if (r < I_IN) { p0_transpose_item(F.w_in, DIN, F.Wcat, DM, 0, 0, ZC_Q, ZC_V, scr, r, F.lane); continue; } r -= I_IN;
        if (r < I_MG) { p0_transpose_item(F.w_merge, 4096, F.Wcat, DM, DIN, 0, 0, 0, scr, r, F.lane); continue; } r -= I_MG;
        if (r < I_A) { p0_transpose_item(F.w_a, DM, F.Wab, LDY, 0, 0, 0, 0, scr, r, F.lane); continue; } r -= I_A;
        if (r < I_B) { p0_transpose_item(F.w_b, DM, F.Wab, LDY, 0, 1024, 0, 0, scr, r, F.lane); continue; } r -= I_B;
        if (r < I_O) { p0_transpose_item(F.w_out, DM, F.Wout, DM, 0, 0, 0, 0, scr, r, F.lane); continue; } r -= I_O;
        { const int g = r / I_P; p0_transpose_item(F.pool_w + (size_t)g * 65536, 256, F.PoolW, 256, g * 256, 0, 0, 0, scr, r % I_P, F.lane); }
    }
    const int gt = F.vcu * (NWAVES * 64) + F.tid, NGT = F.G * NWAVES * 64;
    for (int e = gt; e < 2049 * 64; e += NGT) rope_entry(e >> 6, e & 63, F.ropec, F.ropes);
}

__device__ __forceinline__ void h_row(Frame& F, const float* xrow, const float* modrow, bf16* orow) {
    const GAS f32x4* xr = (const GAS f32x4*)xrow + F.lane;
    f32x4 v[8]; float s = 0.f;
#pragma unroll
    for (int j = 0; j < 8; ++j) { v[j] = xr[64 * j]; s += (v[j].x * v[j].x + v[j].y * v[j].y) + (v[j].z * v[j].z + v[j].w * v[j].w); }
    const float rstd = 1.0f / sqrtf(wave_sum(s) * (1.0f / DM) + EPS);
    GAS v2u* o8 = (GAS v2u*)orow + F.lane;
#pragma unroll
    for (int j = 0; j < 8; ++j) {
        const int col = 4 * F.lane + 256 * j;
        const f32x4 g = *(const f32x4*)(F.g_pre + col), sh = *(const f32x4*)(modrow + col), sc = *(const f32x4*)(modrow + DM + col);
        const f32x4 o = v[j] * rstd * g * (sc + 1.0f) + sh;
        v2u w; w.x = pk2(o.x, o.y); w.y = pk2(o.z, o.w); o8[64 * j] = w;
    }
}

__device__ __forceinline__ unsigned off_a(unsigned row, unsigned ch) { return 2048u * (row >> 3) + 512u * (ch >> 2) + 64u * (row & 7) + 16u * ((ch & 3) ^ ((row >> 2) & 3)); }
struct RowA { unsigned e, d; };
struct TrA { unsigned t0, t1; };
__device__ __forceinline__ RowA row_addr(unsigned lane) { RowA r; r.e = off_a(lane & 31, lane >> 5); r.d = off_a(lane & 31, 2 + (lane >> 5)) - r.e; return r; }
__device__ __forceinline__ TrA tr_addr(unsigned lane) { const unsigned h = lane >> 5, blk = (lane >> 4) & 1, q = (lane & 15) >> 2, p = lane & 3; TrA t;
    t.t0 = off_a(8 * h + q, 2 * blk + (p >> 1)) + 8 * (p & 1); t.t1 = off_a(8 * h + 4 + q, 2 * blk + (p >> 1)) + 8 * (p & 1); return t; }
__device__ __forceinline__ bf16x8 frag_row(const LAS unsigned char* img, const RowA& ra, int s) { return *(const LAS bf16x8*)(img + (ra.e + (unsigned)(s & 1) * ra.d + 512u * (unsigned)(s >> 1))); }
__device__ __forceinline__ bf16x8 frag_tr(const LAS unsigned char* img, const TrA& ta, int c, int ks) {
    const s16x4 lo = __builtin_bit_cast(s16x4, __builtin_amdgcn_ds_read_tr16_b64_v4i16((LAS s16x4*)(img + ta.t0 + 512 * c + 4096 * ks)));
    const s16x4 hi = __builtin_bit_cast(s16x4, __builtin_amdgcn_ds_read_tr16_b64_v4i16((LAS s16x4*)(img + ta.t1 + 512 * c + 4096 * ks)));
    return __builtin_shufflevector(lo, hi, 0, 1, 2, 3, 4, 5, 6, 7);
}
#define MFMA32(a, b, c) __builtin_amdgcn_mfma_f32_32x32x16_bf16((a), (b), (c), 0, 0, 0)
__device__ __forceinline__ int crow(int reg, int h) { return (reg & 3) + 8 * (reg >> 2) + 4 * h; }

__device__ __forceinline__ void ret_ab_unit(Frame& F, int unit) {
    const int bh = unit >> 3, dh = (unit >> 2) & 1, dq = unit & 3, b = bh >> 3, h = bh & 7, lane = fresh_lane(), wave = F.wave, hh = lane >> 5, tid_ = wave * 64 + lane;
    const float lg = lg2gamma(h);
    const float cdec = __builtin_amdgcn_exp2f(128.0f * lg);
    const int di = wave & 1, dj = (wave >> 1) & 1;
    const TrA ta = tr_addr(lane);
    f32x16 acc;
#pragma unroll
    for (int e = 0; e < 16; ++e) acc[e] = 0.f;
    const bf16* Zb = F.Z + (size_t)(b * SEQ) * LDZ;
    v4u r0[4], r1[4];
#define AB_LOAD(c, R) do { _Pragma("unroll") for (int i = 0; i < 2; ++i) { const int n = tid_ + 512 * i, row = n >> 3, ch = n & 7; const bf16* rp = Zb + (size_t)((c) * 128 + row) * LDZ; \
        R[i] = *(const GAS v4u*)(rp + ZC_K + h * DK + dh * 64 + ch * 8); R[2 + i] = *(const GAS v4u*)(rp + ZC_V + h * DV + dq * 64 + ch * 8); } } while (0)
#define AB_STORE(buf, R) do { _Pragma("unroll") for (int i = 0; i < 2; ++i) { const int n = tid_ + 512 * i, row = n >> 3, ch = n & 7; \
        const float d = __builtin_amdgcn_exp2f((float)(127 - row) * lg); v4u kk = R[i]; \
        kk.x = pk2(bflo(kk.x) * d, bfhi(kk.x) * d); kk.y = pk2(bflo(kk.y) * d, bfhi(kk.y) * d); kk.z = pk2(bflo(kk.z) * d, bfhi(kk.z) * d); kk.w = pk2(bflo(kk.w) * d, bfhi(kk.w) * d); \
        const unsigned o = (unsigned)(buf) * 65536u + (unsigned)(row >> 5) * 8192u + off_a(row & 31, ch); \
        *(LAS v4u*)(F.lds + o) = kk; *(LAS v4u*)(F.lds + 32768u + o) = R[2 + i]; } } while (0)
#define AB_STEP(c, RC, RN) do { \
        if ((c) + 2 < 16) AB_LOAD((c) + 2, RC); \
        if (wave < 4) { \
            if ((c) > 0) { v4u w0, w1; w0.x = pk2(acc[0], acc[1]); w0.y = pk2(acc[2], acc[3]); w0.z = pk2(acc[4], acc[5]); w0.w = pk2(acc[6], acc[7]); \
                w1.x = pk2(acc[8], acc[9]); w1.y = pk2(acc[10], acc[11]); w1.z = pk2(acc[12], acc[13]); w1.w = pk2(acc[14], acc[15]); \
                bf16* sn = F.SN + ((((size_t)(bh * 16 + (c)) * 32 + (2 * dh + di) * 8 + (2 * dq + dj)) * 64 + lane) * 16); \
                *(GAS v4u*)sn = w0; *(GAS v4u*)(sn + 8) = w1; } \
            _Pragma("unroll") for (int e = 0; e < 16; ++e) acc[e] *= cdec; \
            const LAS unsigned char* kb = F.lds + ((c) & 1) * 65536; const LAS unsigned char* vb = kb + 32768; \
            _Pragma("unroll") for (int kk = 0; kk < 8; ++kk) acc = MFMA32(frag_tr(kb + (kk >> 1) * 8192, ta, di, kk & 1), frag_tr(vb + (kk >> 1) * 8192, ta, dj, kk & 1), acc); \
        } \
        if ((c) + 1 < 16) AB_STORE(((c) + 1) & 1, RN); \
        __syncthreads(); } while (0)
    AB_LOAD(0, r0); AB_LOAD(1, r1); AB_STORE(0, r0); __syncthreads();
#pragma unroll 1
    for (int c = 0; c < 16; c += 2) { AB_STEP(c, r0, r1); AB_STEP(c + 1, r1, r0); }
#undef AB_LOAD
#undef AB_STORE
#undef AB_STEP
    if (wave < 4) {
        float* so = F.out + O_RP + (size_t)bh * (DK * DV);
        const int dv = 64 * dq + 32 * dj + (lane & 31);
#pragma unroll
        for (int e = 0; e < 16; ++e) so[(size_t)(64 * dh + 32 * di + crow(e, hh)) * DV + dv] = acc[e];
    }
}

__device__ __forceinline__ void pooled_prompt(Frame& F, int it0, int it1) {
    for (int it = it0 + F.tid; it < it1; it += NWAVES * 64) {
        const int row = it >> 7, q = it & 127, t = row & (SEQ - 1), w = 2 << (q >> 5), cnt = (t + 1 < w) ? t + 1 : w;
        const bf16* p = F.Z + (size_t)row * LDZ + ZC_AX + q * 8;
        v4u x[16];
#pragma unroll
        for (int j = 0; j < 16; ++j) x[j] = (j < cnt) ? *(const GAS v4u*)(p - (size_t)j * LDZ) : (v4u){0u, 0u, 0u, 0u};
        float s[8] = {0.f, 0.f, 0.f, 0.f, 0.f, 0.f, 0.f, 0.f};
#pragma unroll
        for (int j = 0; j < 16; ++j) { s[0] += bflo(x[j].x); s[1] += bfhi(x[j].x); s[2] += bflo(x[j].y); s[3] += bfhi(x[j].y); s[4] += bflo(x[j].z); s[5] += bfhi(x[j].z); s[6] += bflo(x[j].w); s[7] += bfhi(x[j].w); }
        const float inv = 1.0f / (float)cnt;
        const float a[8] = {bflo(x[0].x), bfhi(x[0].x), bflo(x[0].y), bfhi(x[0].y), bflo(x[0].z), bfhi(x[0].z), bflo(x[0].w), bfhi(x[0].w)};
        v4u o; o.x = pk2(s[0] * inv - a[0], s[1] * inv - a[1]); o.y = pk2(s[2] * inv - a[2], s[3] * inv - a[3]); o.z = pk2(s[4] * inv - a[4], s[5] * inv - a[5]); o.w = pk2(s[6] * inv - a[6], s[7] * inv - a[7]);
        *(GAS v4u*)(F.POOLED + (size_t)row * DPOOL + q * 8) = o;
    }
}
__device__ __forceinline__ void pooled_sample(Frame& F, int it0, int it1) {
    for (int it = it0 + F.tid; it < it1; it += NWAVES * 64) {
        const int bs = it >> 7, q = it & 127, w = 2 << (q >> 5);
        const v4u x = *(const GAS v4u*)(F.Z + (size_t)(MP + bs) * LDZ + ZC_AX + q * 8);
        float a[8] = {bflo(x.x), bfhi(x.x), bflo(x.y), bfhi(x.y), bflo(x.z), bfhi(x.z), bflo(x.w), bfhi(x.w)}, s[8];
#pragma unroll
        for (int e = 0; e < 8; ++e) s[e] = a[e];
        const float* sp = F.st_pool + (size_t)bs * 15 * DPOOL + q * 8;
        float* op = F.out + O_PS + (size_t)bs * 15 * DPOOL + q * 8;
#pragma unroll
        for (int i = 14; i >= 0; --i) {
            const f32x4 b0 = *(const f32x4*)(sp + (size_t)i * DPOOL), b1 = *(const f32x4*)(sp + (size_t)i * DPOOL + 4);
            if (i >= 1) { *(f32x4*)(op + (size_t)(i - 1) * DPOOL) = b0; *(f32x4*)(op + (size_t)(i - 1) * DPOOL + 4) = b1; }
            if (15 - i < w) { s[0] += b0.x; s[1] += b0.y; s[2] += b0.z; s[3] += b0.w; s[4] += b1.x; s[5] += b1.y; s[6] += b1.z; s[7] += b1.w; }
        }
        const float inv = 1.0f / (float)w;
        v4u o; o.x = pk2(s[0] * inv - a[0], s[1] * inv - a[1]); o.y = pk2(s[2] * inv - a[2], s[3] * inv - a[3]); o.z = pk2(s[4] * inv - a[4], s[5] * inv - a[5]); o.w = pk2(s[6] * inv - a[6], s[7] * inv - a[7]);
        *(GAS v4u*)(F.POOLED + (size_t)(MP + bs) * DPOOL + q * 8) = o;
    }
}
__device__ __forceinline__ void ret_sample_item(Frame& F, int item) {
    const int bs = item >> 3, h = item & 7, lane = F.lane, wave = F.wave, row = MP + bs;
    const float gam = 1.0f - __builtin_amdgcn_exp2f((float)(-5 - h));
    const bf16* zr = F.Z + (size_t)row * LDZ;
    f32x4 v4; { const v2u x = *(const GAS v2u*)(zr + ZC_V + h * DV + 4 * lane); v4 = (f32x4){bflo(x.x), bfhi(x.x), bflo(x.y), bfhi(x.y)}; }
    const float* s0 = F.st_ret + ((size_t)(bs * NH + h) * DK) * DV + 4 * lane;
    float* s1 = F.out + O_RS + ((size_t)(bs * NH + h) * DK) * DV + 4 * lane;
    f32x4 o4 = (f32x4){0.f, 0.f, 0.f, 0.f};
    f32x4 sv[16];
#pragma unroll
    for (int r = 0; r < 16; ++r) sv[r] = __builtin_nontemporal_load((const f32x4*)(s0 + (size_t)(16 * wave + r) * DV));
#pragma unroll
    for (int r = 0; r < 16; ++r) {
        const int dk = 16 * wave + r;
        const float qd = bf1(zr[ZC_Q + h * DK + dk]), kd = bf1(zr[ZC_K + h * DK + dk]);
        const f32x4 sn = sv[r] * gam + v4 * kd;
        __builtin_nontemporal_store(sn, (f32x4*)(s1 + (size_t)dk * DV));
        o4 += sn * qd;
    }
    LAS float* part = (LAS float*)(F.lds);
    *(LAS f32x4*)(part + wave * 256 + 4 * lane) = o4;
    __syncthreads();
    if (wave == 0) {
        f32x4 o = *(LAS f32x4*)(part + 4 * lane);
#pragma unroll
        for (int w = 1; w < 8; ++w) o += *(LAS f32x4*)(part + w * 256 + 4 * lane);
        const float mu = wave_sum((o.x + o.y) + (o.z + o.w)) * (1.0f / DV);
        o = o - mu;
        const float var = wave_sum((o.x * o.x + o.y * o.y) + (o.z * o.z + o.w * o.w)) * (1.0f / DV);
        const float rstd = 1.0f / sqrtf(var + EPS);
        const f32x4 g = *(const f32x4*)(F.gn_g + h * DV + 4 * lane);
        const v2u x = *(const GAS v2u*)(zr + ZC_BG + h * DV + 4 * lane);
        o = o * rstd * g; o.x *= bflo(x.x); o.y *= bfhi(x.x); o.z *= bflo(x.y); o.w *= bfhi(x.y);
        v2u wv; wv.x = pk2(o.x, o.y); wv.y = pk2(o.z, o.w);
        *(GAS v2u*)(F.YAB + (size_t)row * LDY + 1024 + h * DV + 4 * lane) = wv;
    }
    __syncthreads();
}

__device__ __forceinline__ void ret_c_unit(Frame& F, int unit) {
    const int bh = unit >> 4, c = unit & 15, b = bh >> 3, h = bh & 7, lane = fresh_lane(), wave = F.wave, hh = lane >> 5, l31 = lane & 31, tid_ = wave * 64 + lane;
    const float lg = lg2gamma(h);
    const int ti = wave & 3, wh = wave >> 2;
    const RowA ra = row_addr(lane); const TrA ta = tr_addr(lane);
    const int rowbase = b * SEQ + c * 128;
    const bf16* Zb = F.Z + (size_t)rowbase * LDZ;
    LAS unsigned char* Qi = F.lds; LAS unsigned char* Ki = F.lds + 32768; LAS unsigned char* Vi = F.lds + 65536;
    {
        v4u rq[4], rk[4], rv[8];
#pragma unroll
        for (int i = 0; i < 4; ++i) { const int n = tid_ + 512 * i, row = n >> 4, ch = n & 15; const bf16* rp = Zb + (size_t)row * LDZ;
            rq[i] = *(const GAS v4u*)(rp + ZC_Q + h * DK + ch * 8); rk[i] = *(const GAS v4u*)(rp + ZC_K + h * DK + ch * 8); }
#pragma unroll
        for (int i = 0; i < 8; ++i) { const int n = tid_ + 512 * i, row = n >> 5, ch = n & 31; rv[i] = *(const GAS v4u*)(Zb + (size_t)row * LDZ + ZC_V + h * DV + ch * 8); }
#pragma unroll
        for (int i = 0; i < 4; ++i) { const int n = tid_ + 512 * i, row = n >> 4, ch = n & 15; const unsigned o = (unsigned)(row >> 5) * 8192u + off_a(row & 31, ch);
            *(LAS v4u*)(Qi + o) = rq[i]; *(LAS v4u*)(Ki + o) = rk[i]; }
#pragma unroll
        for (int i = 0; i < 8; ++i) { const int n = tid_ + 512 * i, row = n >> 5, ch = n & 31;
            *(LAS v4u*)(Vi + (unsigned)((row >> 5) * 2 + (ch >> 4)) * 8192u + off_a(row & 31, ch & 15)) = rv[i]; }
    }
    const bf16* snb = F.SN + (((size_t)(bh * 16 + c) * 32) * 64 + lane) * 16;
    v4u sf[2][2][4];
    if (c > 0) {
#pragma unroll
        for (int i = 0; i < 2; ++i)
#pragma unroll
            for (int s2 = 0; s2 < 2; ++s2)
#pragma unroll
                for (int j = 0; j < 4; ++j) sf[i][s2][j] = *(const GAS v4u*)(snb + (size_t)(i * 8 + 4 * wh + j) * 1024 + 8 * s2);
    }
    __syncthreads();
    f32x16 X[2];
#pragma unroll
    for (int t = 0; t < 2; ++t) {
        const int sj = 2 * wh + t;
#pragma unroll
        for (int e = 0; e < 16; ++e) X[t][e] = 0.f;
        if (sj <= ti) {
#pragma unroll
            for (int ks = 0; ks < 8; ++ks) X[t] = MFMA32(frag_row(Ki + sj * 8192, ra, ks), frag_row(Qi + ti * 8192, ra, ks), X[t]);
        }
    }
    __syncthreads();
#pragma unroll
    for (int t = 0; t < 2; ++t) {
        const int sj = 2 * wh + t;
        if (sj <= ti) {
            const int tt = 32 * ti + l31;
#pragma unroll
            for (int g = 0; g < 4; ++g) {
                float p[4];
#pragma unroll
                for (int e = 0; e < 4; ++e) { const int s = 32 * sj + 8 * g + 4 * hh + e; const float f = __builtin_amdgcn_exp2f(-(float)(s + 1) * lg); p[e] = (s <= tt) ? X[t][4 * g + e] * f : 0.f; }
                v2u w; w.x = pk2(p[0], p[1]); w.y = pk2(p[2], p[3]);
                *(LAS v2u*)(Ki + ti * 8192 + off_a(l31, 4 * sj + g) + 8 * hh) = w;
            }
        }
    }
    f32x16 O[4];
#pragma unroll
    for (int j = 0; j < 4; ++j)
#pragma unroll
        for (int e = 0; e < 16; ++e) O[j][e] = 0.f;
    const unsigned qb = 2048u * (l31 >> 3) + 64u * (l31 & 7) + 8u * hh, qm = (l31 >> 2) & 3;
    const LAS unsigned char* Qt = Qi + ti * 8192 + qb;
#define QFRAG(i, s2) __builtin_shufflevector(*(const LAS s16x4*)(Qt + 512 * (i) + 16 * ((2 * (s2)) ^ qm)), *(const LAS s16x4*)(Qt + 512 * (i) + 16 * ((2 * (s2) + 1) ^ qm)), 0, 1, 2, 3, 4, 5, 6, 7)
    if (c > 0) {
#pragma unroll
        for (int i = 0; i < 2; ++i)
#pragma unroll
            for (int s2 = 0; s2 < 2; ++s2) { const bf16x8 a = QFRAG(i, s2);
#pragma unroll
                for (int j = 0; j < 4; ++j) O[j] = MFMA32(a, __builtin_bit_cast(bf16x8, sf[i][s2][j]), O[j]); }
#pragma unroll
        for (int i = 0; i < 2; ++i)
#pragma unroll
            for (int s2 = 0; s2 < 2; ++s2)
#pragma unroll
                for (int j = 0; j < 4; ++j) sf[i][s2][j] = *(const GAS v4u*)(snb + (size_t)((i + 2) * 8 + 4 * wh + j) * 1024 + 8 * s2);
    }
    __syncthreads();
    for (int kk = 0; kk < 2 * (ti + 1); ++kk) {
        const bf16x8 a = frag_row(Ki + ti * 8192, ra, kk);
        const LAS unsigned char* vimg = Vi + ((kk >> 1) * 2 + wh) * 8192;
#pragma unroll
        for (int j = 0; j < 4; ++j) O[j] = MFMA32(a, frag_tr(vimg, ta, j, kk & 1), O[j]);
    }
    if (c > 0) {
#pragma unroll
        for (int i = 0; i < 2; ++i)
#pragma unroll
            for (int s2 = 0; s2 < 2; ++s2) { const bf16x8 a = QFRAG(i + 2, s2);
#pragma unroll
                for (int j = 0; j < 4; ++j) O[j] = MFMA32(a, __builtin_bit_cast(bf16x8, sf[i][s2][j]), O[j]); }
    }
#undef QFRAG
    LAS float* st = (LAS float*)(F.lds + STAT_OFF);
    float mu[16], rs[16];
#pragma unroll
    for (int e = 0; e < 16; ++e) {
        const float f = __builtin_amdgcn_exp2f((float)(crow(e, hh) + 32 * ti + 1) * lg);
        float s = 0.f;
#pragma unroll
        for (int j = 0; j < 4; ++j) { O[j][e] *= f; s += O[j][e]; }
        s += __shfl_xor(s, 1); s += __shfl_xor(s, 2); s += __shfl_xor(s, 4); s += __shfl_xor(s, 8); s += __shfl_xor(s, 16);
        if (l31 == 0) st[(32 * ti + crow(e, hh)) * 2 + wh] = s;
    }
    __syncthreads();
#pragma unroll
    for (int e = 0; e < 16; ++e) { const int r = 32 * ti + crow(e, hh); mu[e] = (st[r * 2] + st[r * 2 + 1]) * (1.0f / DV); }
#pragma unroll
    for (int e = 0; e < 16; ++e) {
        float s = 0.f;
#pragma unroll
        for (int j = 0; j < 4; ++j) { O[j][e] -= mu[e]; s += O[j][e] * O[j][e]; }
        s += __shfl_xor(s, 1); s += __shfl_xor(s, 2); s += __shfl_xor(s, 4); s += __shfl_xor(s, 8); s += __shfl_xor(s, 16);
        if (l31 == 0) st[256 + (32 * ti + crow(e, hh)) * 2 + wh] = s;
    }
    __syncthreads();
#pragma unroll
    for (int e = 0; e < 16; ++e) { const int r = 32 * ti + crow(e, hh); rs[e] = 1.0f / sqrtf((st[256 + r * 2] + st[256 + r * 2 + 1]) * (1.0f / DV) + EPS); }
    LAS float* T = (LAS float*)F.lds;
#pragma unroll
    for (int j = 0; j < 4; ++j) {
        const float g = F.gn_g[h * DV + 128 * wh + 32 * j + l31];
#pragma unroll
        for (int e = 0; e < 16; ++e) T[(32 * ti + crow(e, hh)) * 256 + 128 * wh + 32 * j + l31] = O[j][e] * rs[e] * g;
    }
    __syncthreads();
    {
        v4u bg[8];
#pragma unroll
        for (int i = 0; i < 8; ++i) { const int n = tid_ + 512 * i, row = n >> 5, ch = n & 31; bg[i] = *(const GAS v4u*)(Zb + (size_t)row * LDZ + ZC_BG + h * DV + ch * 8); }
#pragma unroll
        for (int i = 0; i < 8; ++i) { const int n = tid_ + 512 * i, row = n >> 5, ch = n & 31;
            const f32x4 t0 = *(const LAS f32x4*)(T + row * 256 + ch * 8), t1 = *(const LAS f32x4*)(T + row * 256 + ch * 8 + 4);
            v4u o; o.x = pk2(t0.x * bflo(bg[i].x), t0.y * bfhi(bg[i].x)); o.y = pk2(t0.z * bflo(bg[i].y), t0.w * bfhi(bg[i].y));
            o.z = pk2(t1.x * bflo(bg[i].z), t1.y * bfhi(bg[i].z)); o.w = pk2(t1.z * bflo(bg[i].w), t1.w * bfhi(bg[i].w));
            *(GAS v4u*)(F.YAB + (size_t)(rowbase + row) * LDY + 1024 + h * DV + ch * 8) = o; }
    }
    __syncthreads();
}


constexpr int CW_Q = 8192;
__device__ __forceinline__ int wg_ticket(Frame& F, int q, int n) {
    __syncthreads();
    if (F.tid == 0) F.MISC[16] = __hip_atomic_fetch_add((unsigned*)(F.ctl + CW_Q + 64 * q), (unsigned)n, __ATOMIC_RELAXED, __HIP_MEMORY_SCOPE_AGENT);
    __syncthreads();
    return (int)F.MISC[16];
}

__device__ __forceinline__ void final_row(Frame& F, const float* xrow, float* yrow, const float* ssrow, const float* gaterow) {
    const float s = ssrow[F.lane];
    const float rstd = 1.0f / sqrtf(wave_sum(s) * (1.0f / DM) + EPS);
#pragma unroll
    for (int j = 0; j < 8; ++j) {
        const int col = 4 * F.lane + 256 * j;
        const f32x4 x = __builtin_nontemporal_load((const f32x4*)(xrow + col)), o = __builtin_nontemporal_load((const f32x4*)(yrow + col)), g = *(const f32x4*)(F.g_post + col), gt = *(const f32x4*)(gaterow + col);
        __builtin_nontemporal_store(x + gt * (o * rstd * g), (f32x4*)(yrow + col));
    }
}

struct Args { const float* in[19]; float* out; unsigned char* ws; int ph_lo, ph_hi; };
constexpr int N_PHASES = 8;
__global__ void __launch_bounds__(NWAVES * 64, 2) hybrid_fwd(Args args) {
    extern __shared__ __attribute__((aligned(16))) unsigned char lds[];
    Frame F;
    F.lds = (LAS unsigned char*)lds;
    F.MISC = (volatile LAS unsigned*)(F.lds + MISC_OFF);
    F.wave = __builtin_amdgcn_readfirstlane((int)threadIdx.x >> 6); F.lane = fresh_lane(); F.tid = F.wave * 64 + F.lane;
    F.G = gridDim.x; { const int bx = blockIdx.x; F.vcu = (F.G % 8 == 0) ? (bx % 8) * (F.G / 8) + bx / 8 : bx; }
    unsigned char* ws = args.ws;
    F.ctl = (gu32*)(ws + WS_CTL);
    F.x_p = args.in[0]; F.x_s = args.in[1]; F.st_pool = args.in[2]; F.st_ret = args.in[3]; F.c_p = args.in[4]; F.c_s = args.in[5]; F.ada_w = args.in[6]; F.ada_b = args.in[7];
    F.g_pre = args.in[8]; F.g_post = args.in[9]; F.w_in = args.in[10]; F.pool_w = args.in[11]; F.pool_scale = args.in[12]; F.gn_g = args.in[13]; F.w_a = args.in[14]; F.w_b = args.in[15];
    F.w_merge = args.in[16]; F.b_merge = args.in[17]; F.w_out = args.in[18]; F.out = args.out;
    F.ropec = (float*)(ws + WS_ROPE); F.ropes = F.ropec + 2049 * 64; F.mod = (float*)(ws + WS_MOD); F.ss = (float*)(ws + WS_SS);
    F.Wcat = (bf16*)(ws + WS_WCAT); F.Wab = (bf16*)(ws + WS_WAB); F.Wout = (bf16*)(ws + WS_WOUT); F.PoolW = (bf16*)(ws + WS_POOLW);
    F.H = (bf16*)(ws + WS_H); F.Z = (bf16*)(ws + WS_Z); F.YAB = (bf16*)(ws + WS_YAB); F.POOLED = (bf16*)(ws + WS_POOLED); F.SN = (bf16*)(ws + WS_SN); F.MB = (bf16*)(ws + WS_MB);
    for (int u = F.tid; u < (LDS_BYTES - LDSCTL_OFF) / 4; u += NWAVES * 64) ((LAS unsigned*)(F.lds + LDSCTL_OFF))[u] = 0u;
    __syncthreads();
    const int lo = args.ph_lo, hi = args.ph_hi;
    XcdBarrier bar; bar.bar = (unsigned*)(F.ctl + CW_BAR); bar.x = 0; bar.st = nullptr; bar.wave = F.wave;
    if (hi - lo > 1) bar = xcd_barrier_post((unsigned*)(F.ctl + CW_BAR), F.MISC + 8, F.wave);
#define IN(k) (lo <= (k) && (k) < hi)
#define PHASE_BEGIN() do { F.lane = fresh_lane(); F.tid = F.wave * 64 + F.lane; } while (0)
#define SEAM(k) do { if (IN(k) && IN((k) + 1)) xcd_barrier(bar); } while (0)
    const int gw = F.vcu * NWAVES + F.wave, NGW = F.G * NWAVES;

    if (((PH_MASK >> 0) & 1) && IN(0)) for (int rep_ = 0; rep_ < (REP_PHASE == 0 ? REP_N : 1); ++rep_) { PHASE_BEGIN(); p0_prologue(F); } SEAM(0);

    if (((PH_MASK >> 1) & 1) && IN(1)) for (int rep_ = 0; rep_ < (REP_PHASE == 1 ? REP_N : 1); ++rep_) { PHASE_BEGIN();
        for (int m = gw; m < MP + MS; m += NGW) {
            const float* xr = m < MP ? F.x_p + (size_t)m * DM : F.x_s + (size_t)(m - MP) * DM;
            const float* mr = F.mod + (size_t)(m < MP ? (m >> 11) : 4 + (m - MP)) * 6144;
            h_row(F, xr, mr, F.H + (size_t)m * DM);
        }
    } SEAM(1);

    if (((PH_MASK >> 2) & 1) && IN(2)) for (int rep_ = 0; rep_ < (REP_PHASE == 2 ? REP_N : 1); ++rep_) { PHASE_BEGIN();
        pg8::Gemm g{F.H, F.Wcat, DM, DM, DM, 0}; pg8::StaticOrder S; S.init(MP, LDZ, F.G, (int)blockIdx.x);
        EpiZ E{F.Z, F.b_merge, F.ropec, F.ropes, F.out + O_PP, F.out + O_PS};
        pg8::gemm_phase<EpiZ, pg8::StaticOrder, true, true>(F.lds + RING_OFF, g, S, E, F.tid);
        PHASE_BEGIN();
        { pg8::Gemm gs{F.H + (size_t)MP * DM, F.Wcat, DM, DM, DM, 0}; pg8::sgemm_phase<EpiZ>(F.lds + RING_OFF, gs, MP, LDZ / 64, F.vcu, F.G, E, F.tid); }
    } SEAM(2);

    if (((PH_MASK >> 3) & 1) && IN(3)) for (int rep_ = 0; rep_ < (REP_PHASE == 3 ? REP_N : 1); ++rep_) { PHASE_BEGIN();
        for (int u = F.vcu; u < 256; u += F.G) ret_ab_unit(F, u);
        PHASE_BEGIN();
        { const int gw512 = F.vcu; for (int k = gw512; k < 2048 + 32; k += F.G) { if (k < 2048) pooled_prompt(F, k * 512, k * 512 + 512); else pooled_sample(F, (k - 2048) * 512, (k - 2048) * 512 + 512); } }
        PHASE_BEGIN();
        for (int it = F.vcu; it < MS * NH; it += F.G) ret_sample_item(F, it);
    } SEAM(3);

    if (((PH_MASK >> 4) & 1) && IN(4)) for (int rep_ = 0; rep_ < (REP_PHASE == 4 ? REP_N : 1); ++rep_) { PHASE_BEGIN();
        { pg8::Gemm g{F.POOLED, F.PoolW, 256, DPOOL, 256, 512}; pg8::StaticOrder S; S.init(MT, DPOOL, F.G, (int)blockIdx.x);
          EpiPool E{F.YAB, F.Z, F.pool_scale};
          pg8::gemm_phase<EpiPool, pg8::StaticOrder, true, true>(F.lds + RING_OFF, g, S, E, F.tid); }
        PHASE_BEGIN();
        for (;;) { const int t = wg_ticket(F, 4 * rep_ + 3, 1); if (t >= 512) break; ret_c_unit(F, t); }
    } SEAM(4);

    if (((PH_MASK >> 5) & 1) && IN(5)) for (int rep_ = 0; rep_ < (REP_PHASE == 5 ? REP_N : 1); ++rep_) { PHASE_BEGIN();
        pg8::Gemm g{F.YAB, F.Wab, LDY, LDY, LDY, 0}; pg8::StaticOrder S; S.init(MP, DM, F.G, (int)blockIdx.x);
        EpiMerge E{F.MB, F.Z};
        pg8::gemm_phase<EpiMerge, pg8::StaticOrder, true, true>(F.lds + RING_OFF, g, S, E, F.tid);
        PHASE_BEGIN();
        { pg8::Gemm gs{F.YAB + (size_t)MP * LDY, F.Wab, LDY, LDY, LDY, 0}; pg8::sgemm_phase<EpiMerge>(F.lds + RING_OFF, gs, MP, DM / 64, F.vcu, F.G, E, F.tid); }
    } SEAM(5);

    if (((PH_MASK >> 6) & 1) && IN(6)) for (int rep_ = 0; rep_ < (REP_PHASE == 6 ? REP_N : 1); ++rep_) { PHASE_BEGIN();
        pg8::Gemm g{F.MB, F.Wout, DM, DM, DM, 0}; pg8::StaticOrder S; S.init(MP, DM, F.G, (int)blockIdx.x);
        EpiOut E{F.out, F.ss};
        pg8::gemm_phase<EpiOut, pg8::StaticOrder, true, true>(F.lds + RING_OFF, g, S, E, F.tid);
        PHASE_BEGIN();
        { pg8::Gemm gs{F.MB + (size_t)MP * DM, F.Wout, DM, DM, DM, 0}; pg8::sgemm_phase<EpiOut>(F.lds + RING_OFF, gs, MP, DM / 64, F.vcu, F.G, E, F.tid); }
    } SEAM(6);

    if (((PH_MASK >> 7) & 1) && IN(7)) for (int rep_ = 0; rep_ < (REP_PHASE == 7 ? REP_N : 1); ++rep_) { PHASE_BEGIN();
        for (int m = gw; m < MP + MS; m += NGW) {
            const float* xr = m < MP ? F.x_p + (size_t)m * DM : F.x_s + (size_t)(m - MP) * DM;
            float* yr = F.out + (m < MP ? O_YP + (size_t)m * DM : O_YS + (size_t)(m - MP) * DM);
            const float* gr = F.mod + (size_t)(m < MP ? (m >> 11) : 4 + (m - MP)) * 6144 + 2 * DM;
            final_row(F, xr, yr, F.ss + (size_t)m * 64, gr);
        }
    }
#undef IN
#undef SEAM
}

extern "C" void kernel_launch(void* const* d_in, const int* in_sizes, int n_in, void* d_out, int out_size, void* d_ws, size_t ws_size, hipStream_t stream) {
    static int grid = 0;
    if (grid == 0) {
        if (n_in != 19 || ws_size < WS_END) { fprintf(stderr, "kernel_launch: unexpected inputs (n_in %d, ws %zu)\n", n_in, ws_size); grid = -1; return; }
        int dev = 0, cus = 0, per_cu = 0;
        if (hipGetDevice(&dev) != hipSuccess || hipDeviceGetAttribute(&cus, hipDeviceAttributeMultiprocessorCount, dev) != hipSuccess) { grid = -1; return; }
        if (hipFuncSetAttribute((const void*)hybrid_fwd, hipFuncAttributeMaxDynamicSharedMemorySize, LDS_BYTES) != hipSuccess) { fprintf(stderr, "kernel_launch: hipFuncSetAttribute failed\n"); grid = -1; return; }
        if (hipOccupancyMaxActiveBlocksPerMultiprocessor(&per_cu, (const void*)hybrid_fwd, NWAVES * 64, LDS_BYTES) != hipSuccess || per_cu < 1) { fprintf(stderr, "kernel_launch: occupancy query says %d\n", per_cu); per_cu = 1; }
        (void)hipGetLastError();
        grid = cus;
    }
    if (grid < 0) return;
    (void)hipMemsetAsync((char*)d_ws + WS_CTL, 0, CTL_ZERO_BYTES, stream);
    Args a{};
    for (int i = 0; i < 19; ++i) a.in[i] = (const float*)d_in[i];
    a.out = (float*)d_out; a.ws = (unsigned char*)d_ws;
    if (MK_N_LAUNCHES == 1) { a.ph_lo = 0; a.ph_hi = N_PHASES; hipLaunchKernelGGL(hybrid_fwd, dim3(grid), dim3(NWAVES * 64), LDS_BYTES, stream, a); }
    else for (int p = 0; p < N_PHASES; ++p) { a.ph_lo = p; a.ph_hi = p + 1; hipLaunchKernelGGL(hybrid_fwd, dim3(grid), dim3(NWAVES * 64), LDS_BYTES, stream, a); }
}
```

```cpp
#include <hip/hip_runtime.h>
#include <cstdio>
#include <cstdint>

#ifndef PH_MASK
#define PH_MASK 255
#endif
#ifndef REP_PHASE
#define REP_PHASE -1
#define REP_N 1
#endif
#ifndef MK_N_LAUNCHES
#define MK_N_LAUNCHES 1
#endif

namespace pg8 {
#define PG8_LAS __attribute__((address_space(3)))
typedef unsigned short bf16_t;
typedef short bf16x8 __attribute__((ext_vector_type(8)));
typedef float f32x4 __attribute__((ext_vector_type(4)));
typedef unsigned u32x4 __attribute__((ext_vector_type(4)));
typedef unsigned u32x2 __attribute__((ext_vector_type(2)));
constexpr int BM = 256, BK = 64, HALF = 128, HTB = HALF * BK * 2  , STAGE_BYTES = 8 * HTB, NXCD = 8, WGM = 8;

__host__ __device__ __forceinline__ int lds_byte(int r, int c) { const int st = (r >> 4) * 2 + (c >> 5), rr = r & 15, cc = c & 31, ob = rr * 64 + cc * 2; return st * 1024 + (ob ^ (((ob >> 9) & 1) << 5)); }
__host__ __device__ __forceinline__ void stage_rc(int b, int& R, int& C) { const int st = b / 1024, sb = b % 1024, swz = sb ^ (((sb >> 9) & 1) << 5); R = (st >> 1) * 16 + swz / 64; C = (st & 1) * 32 + (swz % 64) / 2; }
__host__ __device__ __forceinline__ int perm32(int rho) { const int n = rho >> 4, i = rho & 15; return 8 * (i >> 2) + 4 * n + (i & 3); }

struct Unit { int pm, pn; };
struct Gemm { const bf16_t* A; const bf16_t* Bt; int K, lda, ldb, a_pn_bytes; };

struct StaticOrder {
    int nM, nN, nwg, G, c;
    __host__ __device__ void init(int M, int N, int G_, int c_) { nM = M / BM; nN = N / BM; nwg = nM * nN; G = G_; c = c_; }
    __host__ __device__ bool next(int i, Unit& u) const {
        const long L = (long)i * G + c; if (L >= nwg) return false;
        int wgid = (int)L; { const int q = nwg / NXCD, r = nwg % NXCD, xcd = wgid % NXCD, off = wgid / NXCD; wgid = (xcd < r ? xcd * (q + 1) : r * (q + 1) + (xcd - r) * q) + off; }
        const int nig = WGM * nN, gid = wgid / nig, fm = gid * WGM, gsz = (nM - fm) < WGM ? (nM - fm) : WGM;
        u.pm = fm + ((wgid % nig) % gsz); u.pn = (wgid % nig) / gsz; return true;
    }
};

__device__ __forceinline__ unsigned cvt_pk_bf16(float lo, float hi) { unsigned r; asm volatile("v_cvt_pk_bf16_f32 %0, %1, %2" : "=v"(r) : "v"(lo), "v"(hi)); return r; }
__device__ __forceinline__ float bf_lo(unsigned w) { return __uint_as_float(w << 16); }
__device__ __forceinline__ float bf_hi(unsigned w) { return __uint_as_float(w & 0xffff0000u); }
__device__ __forceinline__ float sigmoidf_(float v) { return __builtin_amdgcn_rcpf(1.0f + __builtin_amdgcn_exp2f(-1.4426950408889634f * v)); }


template <class Epi, class Sched, bool ALIGN_EPI = false, bool SP2 = false>
__device__ __forceinline__ void gemm_phase(PG8_LAS unsigned char* lds, const Gemm g, const Sched& S, const Epi& E, const int tid) {
    const int wid = __builtin_amdgcn_readfirstlane(tid >> 6), lane = tid & 63, wr = wid >> 2, wc = wid & 3, fr = lane & 15, fq = lane >> 4;
    const int K = g.K, nt = K / BK;
    unsigned voffA[2], voffB[2];
#pragma unroll
    for (int i = 0; i < 2; ++i) { int R, C; stage_rc(tid * 16 + i * 8192, R, C); const int Rb = Epi::PERM ? ((R & ~31) + perm32(R & 31)) : R;
        voffA[i] = (unsigned)(R * g.lda + C) * 2u; voffB[i] = (unsigned)(Rb * g.ldb + C) * 2u; }
    const size_t kstep = (size_t)(BK * 2);
    const size_t hstepA = (size_t)HALF * g.lda * 2, hstepB = (size_t)HALF * g.ldb * 2;
    const size_t tstepA = 2 * hstepA, tstepB = 2 * hstepB;
    const unsigned ldsw = (unsigned)wid * 1024u;
    const int aoff = lds_byte(wr * 64 + fr, fq * 8), boff = lds_byte(wc * 32 + fr, fq * 8);
#define PG8_SA(b, h) (((b) * 2 + (h)) * HTB)
#define PG8_SB(b, h) ((4 + (b) * 2 + (h)) * HTB)
#define PG8_STAGE(bufoff, gbase, voff) do { _Pragma("unroll") for (int _i = 0; _i < 2; ++_i) \
        __builtin_amdgcn_global_load_lds((const unsigned*)((const char*)(gbase) + (voff)[_i]), (PG8_LAS unsigned*)(lds + (bufoff) + ldsw + _i * 8192), 16, 0, 0); } while (0)
#define PG8_LDA(dst, b, h) do { _Pragma("unroll") for (int m = 0; m < 4; ++m) _Pragma("unroll") for (int k = 0; k < 2; ++k) dst[m][k] = *(const PG8_LAS bf16x8*)(lds + PG8_SA(b, h) + aoff + m * 2048 + k * 1024); } while (0)
#define PG8_LDB(dst, b, h) do { _Pragma("unroll") for (int n = 0; n < 2; ++n) _Pragma("unroll") for (int k = 0; k < 2; ++k) dst[n][k] = *(const PG8_LAS bf16x8*)(lds + PG8_SB(b, h) + boff + n * 2048 + k * 1024); } while (0)
#define PG8_MMA(ai, bj, At, Bt) do { __builtin_amdgcn_s_setprio(1); _Pragma("unroll") for (int m = 0; m < 4; ++m) _Pragma("unroll") for (int n = 0; n < 2; ++n) _Pragma("unroll") for (int k = 0; k < 2; ++k) \
        acc[ai][bj][m][n] = __builtin_amdgcn_mfma_f32_16x16x32_bf16(Bt[n][k], At[m][k], acc[ai][bj][m][n], 0, 0, 0); __builtin_amdgcn_s_setprio(0); } while (0)
#define PG8_WAIT_V(n) asm volatile("s_waitcnt vmcnt(" #n ")" ::: "memory")
#define PG8_WAIT_L(n) asm volatile("s_waitcnt lgkmcnt(" #n ")" ::: "memory")
#define PG8_BAR __builtin_amdgcn_s_barrier()
#define PG8_SCHED __builtin_amdgcn_sched_barrier(0)
    Unit cur, nxt; int ui = 0;
    if (!S.next(0, cur)) return;
    f32x4 acc[2][2][4][2];
#pragma unroll
    for (int a = 0; a < 2; ++a)
#pragma unroll
        for (int b = 0; b < 2; ++b)
#pragma unroll
            for (int m = 0; m < 4; ++m)
#pragma unroll
                for (int n = 0; n < 2; ++n) acc[a][b][m][n] = (f32x4){0.f, 0.f, 0.f, 0.f};
    bf16x8 At[4][2], B0[2][2], B1[2][2];
    const char* cA = (const char*)g.A + (size_t)cur.pm * tstepA + (size_t)cur.pn * g.a_pn_bytes; const char* cB = (const char*)g.Bt + (size_t)cur.pn * tstepB;
    if constexpr (SP2) {
        PG8_STAGE(PG8_SB(0, 0), cB, voffB); PG8_STAGE(PG8_SB(0, 1), cB + hstepB, voffB); PG8_STAGE(PG8_SA(0, 0), cA, voffA); PG8_STAGE(PG8_SA(0, 1), cA + hstepA, voffA);
        if (wr == 1) PG8_BAR;
        PG8_WAIT_V(2); PG8_BAR;
        PG8_STAGE(PG8_SB(1, 0), cB + kstep, voffB); PG8_STAGE(PG8_SA(1, 0), cA + kstep, voffA); PG8_STAGE(PG8_SB(1, 1), cB + hstepB + kstep, voffB);
        PG8_WAIT_V(6); PG8_BAR;
    } else {
        PG8_STAGE(PG8_SB(0, 0), cB, voffB); PG8_STAGE(PG8_SA(0, 0), cA, voffA); PG8_STAGE(PG8_SB(0, 1), cB + hstepB, voffB); PG8_STAGE(PG8_SA(0, 1), cA + hstepA, voffA);
        if (wr == 1) PG8_BAR;
        PG8_WAIT_V(4); PG8_BAR;
        PG8_STAGE(PG8_SB(1, 0), cB + kstep, voffB); PG8_STAGE(PG8_SA(1, 0), cA + kstep, voffA); PG8_STAGE(PG8_SB(1, 1), cB + hstepB + kstep, voffB);
        PG8_WAIT_V(6); PG8_BAR;
    }
    for (;;) {
        const bool has_next = S.next(ui + 1, nxt);
        const char* nA = has_next ? (const char*)g.A + (size_t)nxt.pm * tstepA + (size_t)nxt.pn * g.a_pn_bytes : cA; const char* nB = has_next ? (const char*)g.Bt + (size_t)nxt.pn * tstepB : cB;
        for (int t = 0; t < nt; t += 2) {
            if constexpr (Epi::MID_T > 0) { if (t == Epi::MID_T) {
#pragma unroll
                for (int ai = 0; ai < 2; ++ai)
#pragma unroll
                    for (int bj = 0; bj < 2; ++bj) E.template mid<4>(acc[ai][bj], cur.pm * BM + ai * HALF + wr * 64 + fr, cur.pn * BM + bj * HALF + wc * 32, fq); } }
            const bool last = (t == nt - 2);
            const char* a1 = cA + (size_t)(t + 1) * kstep;
            const char* a2 = last ? nA : cA + (size_t)(t + 2) * kstep; const char* b2 = last ? nB : cB + (size_t)(t + 2) * kstep;
            const char* a3 = a2 + kstep; const char* b3 = b2 + kstep;
            if constexpr (SP2) {
            PG8_LDB(B0, 0, 0); PG8_LDB(B1, 0, 1); PG8_SCHED; PG8_LDA(At, 0, 0); PG8_STAGE(PG8_SA(1, 1), a1 + hstepA, voffA);
            PG8_WAIT_V(8); PG8_WAIT_L(0); PG8_BAR; PG8_MMA(0, 0, At, B0); PG8_MMA(0, 1, At, B1); PG8_BAR; PG8_SCHED;
            PG8_LDA(At, 0, 1); PG8_STAGE(PG8_SB(0, 0), b2, voffB); PG8_STAGE(PG8_SB(0, 1), b2 + hstepB, voffB); PG8_STAGE(PG8_SA(0, 0), a2, voffA);
            PG8_WAIT_V(8); PG8_WAIT_L(0); PG8_BAR; PG8_MMA(1, 0, At, B0); PG8_MMA(1, 1, At, B1); PG8_BAR; PG8_SCHED;
            PG8_LDB(B0, 1, 0); PG8_LDB(B1, 1, 1); PG8_SCHED; PG8_LDA(At, 1, 0); PG8_STAGE(PG8_SA(0, 1), a2 + hstepA, voffA);
            PG8_WAIT_V(8); PG8_WAIT_L(0); PG8_BAR; PG8_MMA(0, 0, At, B0); PG8_MMA(0, 1, At, B1); PG8_BAR; PG8_SCHED;
            PG8_LDA(At, 1, 1); PG8_STAGE(PG8_SB(1, 0), b3, voffB); PG8_STAGE(PG8_SB(1, 1), b3 + hstepB, voffB); PG8_STAGE(PG8_SA(1, 0), a3, voffA);
            PG8_WAIT_V(8); PG8_WAIT_L(0); PG8_BAR; PG8_MMA(1, 0, At, B0); PG8_MMA(1, 1, At, B1); PG8_BAR; PG8_SCHED;
            } else {
            PG8_LDB(B0, 0, 0); PG8_SCHED; PG8_LDA(At, 0, 0); PG8_STAGE(PG8_SA(1, 1), a1 + hstepA, voffA);
            PG8_WAIT_L(8); PG8_BAR; PG8_WAIT_L(0); PG8_MMA(0, 0, At, B0); PG8_BAR; PG8_SCHED;
            PG8_LDB(B1, 0, 1); PG8_STAGE(PG8_SB(0, 0), b2, voffB);
            PG8_BAR; PG8_WAIT_L(0); PG8_MMA(0, 1, At, B1); PG8_BAR;
            PG8_LDA(At, 0, 1); PG8_STAGE(PG8_SA(0, 0), a2, voffA);
            PG8_BAR; PG8_WAIT_L(0); PG8_MMA(1, 0, At, B0); PG8_BAR; PG8_SCHED;
            PG8_STAGE(PG8_SB(0, 1), b2 + hstepB, voffB);
            PG8_WAIT_V(6); PG8_BAR; PG8_MMA(1, 1, At, B1); PG8_BAR;
            PG8_LDB(B0, 1, 0); PG8_SCHED; PG8_LDA(At, 1, 0); PG8_STAGE(PG8_SA(0, 1), a2 + hstepA, voffA);
            PG8_WAIT_L(8); PG8_BAR; PG8_WAIT_L(0); PG8_MMA(0, 0, At, B0); PG8_BAR; PG8_SCHED;
            PG8_LDB(B1, 1, 1); PG8_STAGE(PG8_SB(1, 0), b3, voffB);
            PG8_BAR; PG8_WAIT_L(0); PG8_MMA(0, 1, At, B1); PG8_BAR;
            PG8_LDA(At, 1, 1); PG8_STAGE(PG8_SA(1, 0), a3, voffA);
            PG8_BAR; PG8_WAIT_L(0); PG8_MMA(1, 0, At, B0); PG8_BAR; PG8_SCHED;
            PG8_STAGE(PG8_SB(1, 1), b3 + hstepB, voffB);
            PG8_WAIT_V(6); PG8_BAR; PG8_MMA(1, 1, At, B1); PG8_BAR;
            }
        }
        if constexpr (ALIGN_EPI) { if (wr == 0) PG8_BAR; }
#pragma unroll
        for (int ai = 0; ai < 2; ++ai)
#pragma unroll
            for (int bj = 0; bj < 2; ++bj) E.template core<4>(acc[ai][bj], cur.pm * BM + ai * HALF + wr * 64 + fr, cur.pn * BM + bj * HALF + wc * 32, fq);
        if (!has_next) break;
#pragma unroll
        for (int a = 0; a < 2; ++a)
#pragma unroll
            for (int b = 0; b < 2; ++b)
#pragma unroll
                for (int m = 0; m < 4; ++m)
#pragma unroll
                    for (int n = 0; n < 2; ++n) acc[a][b][m][n] = (f32x4){0.f, 0.f, 0.f, 0.f};
        cur = nxt; cA = nA; cB = nB; ++ui;
        if constexpr (ALIGN_EPI) { if (wr == 1) PG8_BAR; }
    }
    PG8_WAIT_V(0);
    if constexpr (!ALIGN_EPI) { if (wr == 0) PG8_BAR; }
    PG8_BAR;
#undef PG8_SA
#undef PG8_SB
#undef PG8_STAGE
#undef PG8_LDA
#undef PG8_LDB
#undef PG8_MMA
#undef PG8_WAIT_V
#undef PG8_WAIT_L
#undef PG8_BAR
#undef PG8_SCHED
}

template <class Epi>
__device__ __forceinline__ void sgemm_phase(PG8_LAS unsigned char* lds, const Gemm g, const int row_base, const int n_units, const int first, const int stride, const Epi& E, const int tid) {
    const int wid = __builtin_amdgcn_readfirstlane(tid >> 6), lane = tid & 63, wr = wid >> 1, wc = wid & 1, fr = lane & 15, fq = lane >> 4;
    const int nt = g.K / BK;
    unsigned voffA[2], voffB;
#pragma unroll
    for (int i = 0; i < 2; ++i) { int R, C; stage_rc(tid * 16 + i * 8192, R, C); voffA[i] = (unsigned)(R * g.lda + C) * 2u;
        if (i == 0) { const int Rb = Epi::PERM ? ((R & ~31) + perm32(R & 31)) : R; voffB = (unsigned)(Rb * g.ldb + C) * 2u; } }
    const unsigned ldsw = (unsigned)wid * 1024u;
    const int aoff = lds_byte(wr * 32 + fr, fq * 8), boff = 16384 + lds_byte(wc * 32 + fr, fq * 8);
    constexpr int SLOT = 24576;
#define SG_STAGE(slot, pa, pb) do { \
        __builtin_amdgcn_global_load_lds((const unsigned*)((pa) + voffA[0]), (PG8_LAS unsigned*)(lds + (slot) * SLOT + ldsw), 16, 0, 0); \
        __builtin_amdgcn_global_load_lds((const unsigned*)((pa) + voffA[1]), (PG8_LAS unsigned*)(lds + (slot) * SLOT + ldsw + 8192), 16, 0, 0); \
        __builtin_amdgcn_global_load_lds((const unsigned*)((pb) + voffB), (PG8_LAS unsigned*)(lds + (slot) * SLOT + 16384 + ldsw), 16, 0, 0); } while (0)
    const char* cA = (const char*)g.A;
    for (int ui = first; ui < n_units; ui += stride) {
        const char* cB = (const char*)g.Bt + (size_t)ui * 64 * g.ldb * 2;
        f32x4 acc[2][2];
#pragma unroll
        for (int m = 0; m < 2; ++m)
#pragma unroll
            for (int n = 0; n < 2; ++n) acc[m][n] = (f32x4){0.f, 0.f, 0.f, 0.f};
        SG_STAGE(0, cA, cB); SG_STAGE(1, cA + 128, cB + 128); SG_STAGE(2, cA + 256, cB + 256);
        for (int t = 0; t < nt; ++t) {
            if constexpr (Epi::MID_T > 0) { if (t == Epi::MID_T) E.template mid<2>(acc, row_base + wr * 32 + fr, ui * 64 + wc * 32, fq); }
            asm volatile("s_waitcnt vmcnt(6)" ::: "memory"); __builtin_amdgcn_s_barrier();
            { const int tn = (t + 3 < nt) ? t + 3 : nt - 1; const int sl = (t + 3) & 3; SG_STAGE(sl, cA + (size_t)tn * 128, cB + (size_t)tn * 128); }
            const PG8_LAS unsigned char* sp = lds + (t & 3) * SLOT;
            bf16x8 At[2][2], Bt[2][2];
#pragma unroll
            for (int m = 0; m < 2; ++m)
#pragma unroll
                for (int k = 0; k < 2; ++k) At[m][k] = *(const PG8_LAS bf16x8*)(sp + aoff + m * 2048 + k * 1024);
#pragma unroll
            for (int n = 0; n < 2; ++n)
#pragma unroll
                for (int k = 0; k < 2; ++k) Bt[n][k] = *(const PG8_LAS bf16x8*)(sp + boff + n * 2048 + k * 1024);
            asm volatile("s_waitcnt lgkmcnt(0)" ::: "memory");
            __builtin_amdgcn_sched_barrier(0);
#pragma unroll
            for (int m = 0; m < 2; ++m)
#pragma unroll
                for (int n = 0; n < 2; ++n)
#pragma unroll
                    for (int k = 0; k < 2; ++k) acc[m][n] = __builtin_amdgcn_mfma_f32_16x16x32_bf16(Bt[n][k], At[m][k], acc[m][n], 0, 0, 0);
        }
        asm volatile("s_waitcnt vmcnt(0)" ::: "memory"); __builtin_amdgcn_s_barrier();
        E.template core<2>(acc, row_base + wr * 32 + fr, ui * 64 + wc * 32, fq);
    }
#undef SG_STAGE
}
}

constexpr int NWAVES = 8;
constexpr int DM = 2048, MP = 8192, MS = 128, SEQ = 2048, MT = 8448;
constexpr int DPOOL = 1024, NH = 8, DK = 128, DV = 256, DIN = 8192, LDZ = 12288, LDY = 3072;
constexpr int ZC_AX = 0, ZC_AG = 1024, ZC_Q = 2048, ZC_K = 3072, ZC_V = 4096, ZC_BG = 6144, ZC_GA = 8192, ZC_GB = 10240;
constexpr float EPS = 1e-6f;
__host__ __device__ __forceinline__ int hm_row(int r, int h) { return r < MP ? (((r >> 11) * NH + h) * SEQ + (r & (SEQ - 1))) : (MP * NH + (r - MP) * NH + h); }
constexpr int PAST = 16384;
constexpr size_t O_YP = 0, O_YS = 16777216, O_PP = 17039360, O_RP = 17100800, O_PS = 18149376, O_RS = 20115456;

constexpr size_t MiB = 1u << 20;
constexpr size_t WS_CTL = 0, CTL_ZERO_BYTES = 1 * MiB;
constexpr size_t WS_ROPE = 1 * MiB;
constexpr size_t WS_MOD = 3 * MiB;
constexpr size_t WS_SS = 7 * MiB;
constexpr size_t WS_WCAT = 16 * MiB;
constexpr size_t WS_WAB = 64 * MiB;
constexpr size_t WS_WOUT = 76 * MiB;
constexpr size_t WS_POOLW = 84 * MiB;
constexpr size_t WS_H = 96 * MiB;
constexpr size_t WS_AX = 130 * MiB, WS_AG = 147 * MiB, WS_Q = 164 * MiB, WS_K = 181 * MiB, WS_V = 198 * MiB, WS_BG = 231 * MiB, WS_GA = 264 * MiB, WS_GB = 297 * MiB;
constexpr size_t WS_Z = WS_AX;
constexpr size_t WS_YAB = 330 * MiB;
constexpr size_t WS_POOLED = 380 * MiB;
constexpr size_t WS_SN = 397 * MiB;
constexpr size_t WS_MB = 430 * MiB;
constexpr size_t WS_END = 464 * MiB;
constexpr int CW_BAR = 4096;

constexpr int RING_OFF = 0, RING_BYTES = 131072;
constexpr int LDSCTL_OFF = RING_BYTES, MISC_OFF = LDSCTL_OFF + 320;
constexpr int STAT_OFF = RING_BYTES + 1024;
constexpr int LDS_BYTES = 147456;

#define GAS __attribute__((address_space(1)))
#define LAS __attribute__((address_space(3)))
typedef unsigned short bf16;
typedef unsigned v4u __attribute__((ext_vector_type(4)));
typedef unsigned v2u __attribute__((ext_vector_type(2)));
typedef float f32x4 __attribute__((ext_vector_type(4)));
typedef float f32x16 __attribute__((ext_vector_type(16)));
typedef short bf16x8 __attribute__((ext_vector_type(8)));
typedef short s16x4 __attribute__((ext_vector_type(4)));
typedef GAS unsigned gu32;
#define RLX_AGENT __ATOMIC_RELAXED, __HIP_MEMORY_SCOPE_AGENT
#define LDS_WAIT() asm volatile("s_waitcnt lgkmcnt(0)" ::: "memory")
#define VM_WAIT() asm volatile("s_waitcnt vmcnt(0)" ::: "memory")
__device__ __forceinline__ unsigned f2bf(float f) { unsigned u = __builtin_bit_cast(unsigned, f); return (u + 0x7fffu + ((u >> 16) & 1u)) >> 16; }
__device__ __forceinline__ unsigned pk2(float lo, float hi) { return f2bf(lo) | (f2bf(hi) << 16); }
__device__ __forceinline__ float bflo(unsigned w) { return __uint_as_float(w << 16); }
__device__ __forceinline__ float bfhi(unsigned w) { return __uint_as_float(w & 0xffff0000u); }
__device__ __forceinline__ float bf1(bf16 b) { return __uint_as_float((unsigned)b << 16); }
__device__ __forceinline__ float silu_(float v) { return v * __builtin_amdgcn_rcpf(1.0f + __builtin_amdgcn_exp2f(-1.4426950408889634f * v)); }
__device__ __forceinline__ float wave_sum(float v) {
#pragma unroll
    for (int o = 1; o < 64; o <<= 1) v += __shfl_xor(v, o);
    return v;
}
__device__ __forceinline__ float lg2gamma(int h) {
    const float t[8] = {-0.04580368961312479f, -0.02272007650008353f, -0.011315313227834146f, -0.005646563141142063f, -0.0028205190623786626f, -0.0014095702546713536f, -0.0007046129765893727f, -0.0003522634716290214f};
    float r = t[0];
#pragma unroll
    for (int i = 1; i < 8; ++i) r = (h == i) ? t[i] : r;
    return r;
}

__device__ __forceinline__ int fresh_lane() { unsigned m_ = ~0u; asm volatile("" : "+s"(m_)); return (int)__builtin_amdgcn_mbcnt_hi(m_, __builtin_amdgcn_mbcnt_lo(m_, 0u)); }
#define XB_TMO      128
#define XB_XCNT(j)  (256  + 64 * (j))
#define XB_XSUB(j)  (1280 + 64 * (j))
#define XB_XGEN(j)  (2304 + 64 * (j))
#define XB_TOP      3328
#define XB_TOPGEN   3392
#define XCD_BAR_WORDS 3456
#define XB_SPIN_CAP (1u << 18)
__device__ __forceinline__ unsigned xb_ld(unsigned* p)              { return __hip_atomic_load(p, __ATOMIC_RELAXED, __HIP_MEMORY_SCOPE_AGENT); }
__device__ __forceinline__ unsigned xb_add(unsigned* p, unsigned v) { return __hip_atomic_fetch_add(p, v, __ATOMIC_RELAXED, __HIP_MEMORY_SCOPE_AGENT); }
__device__ __forceinline__ unsigned xb_xcc_id() { return (unsigned)__builtin_amdgcn_s_getreg((3 << 11) | 20) & 0xFu; }
#define XB_SPIN(cond, bar) do { unsigned _sp = 0; while (cond) { __builtin_amdgcn_s_sleep(1); \
    if ((++_sp & 255u) == 0u) { if (xb_ld(&(bar)[XB_TMO])) break; if (_sp > XB_SPIN_CAP) { atomicAdd(&(bar)[XB_TMO], 1u); break; } } } } while (0)
struct XcdBarrier { unsigned* bar; unsigned x; volatile LAS unsigned* st; int wave; };
__device__ __forceinline__ XcdBarrier xcd_barrier_post(unsigned* bar, volatile LAS unsigned* st, int wave) {
    XcdBarrier b; b.bar = bar; b.x = xb_xcc_id(); b.st = st; b.wave = wave;
    if (wave == 0 && fresh_lane() == 0) (void)xb_add(&bar[XB_XCNT(b.x)], 1u);
    return b;
}
__device__ __forceinline__ void xcd_barrier_complete(unsigned* bar, unsigned x, unsigned& nloc, unsigned& nx) {
    const unsigned G = gridDim.x * gridDim.y * gridDim.z;
    unsigned sum, cnt, mine, sp = 0u;
    for (;;) {
        sum = 0u; cnt = 0u; mine = 0u;
#pragma unroll
        for (unsigned j = 0; j < 16; ++j) { const unsigned c = xb_ld(&bar[XB_XCNT(j)]); sum += c; cnt += (c > 0u) ? 1u : 0u; mine = (j == x) ? c : mine; }
        if (sum == G) break;
        __builtin_amdgcn_s_sleep(1);
        if ((++sp & 255u) == 0u) { if (xb_ld(&bar[XB_TMO])) break; if (sp > XB_SPIN_CAP) { atomicAdd(&bar[XB_TMO], 1u); break; } }
    }
    nloc = mine > 0u ? mine : 1u; nx = cnt > 0u ? cnt : 1u;
}
__device__ __forceinline__ void xcd_barrier(const XcdBarrier& b) {
    asm volatile("s_waitcnt vmcnt(0)" ::: "memory");
    __syncthreads();
    if (b.wave == 0 && fresh_lane() == 0) {
        unsigned* bar = b.bar;
        __builtin_amdgcn_s_waitcnt(0);
        unsigned nloc = b.st[0], nx = b.st[1];
        if (nloc == 0u) { xcd_barrier_complete(bar, b.x, nloc, nx); b.st[0] = nloc; b.st[1] = nx; }
        const unsigned old = xb_add(&bar[XB_XSUB(b.x)], 1u);
        const unsigned gen = old / nloc;
        if (old + 1u == (gen + 1u) * nloc) {
            __builtin_amdgcn_fence(__ATOMIC_RELEASE, "agent");
            asm volatile("s_waitcnt vmcnt(0)" ::: "memory");
            const unsigned og = xb_add(&bar[XB_TOP], 1u);
            const unsigned tg = og / nx;
            if (og + 1u == (tg + 1u) * nx) xb_add(&bar[XB_TOPGEN], 1u);
            else XB_SPIN(xb_ld(&bar[XB_TOPGEN]) == tg, bar);
            __builtin_amdgcn_fence(__ATOMIC_ACQUIRE, "agent");
            xb_add(&bar[XB_XGEN(b.x)], 1u);
            asm volatile("s_waitcnt vmcnt(0)" ::: "memory");
        } else {
            XB_SPIN(xb_ld(&bar[XB_XGEN(b.x)]) == gen, bar);
            __builtin_amdgcn_fence(__ATOMIC_ACQUIRE, "agent");
            asm volatile("s_waitcnt vmcnt(0)" ::: "memory");
        }
    }
    __syncthreads();
}

struct Frame {
    LAS unsigned char* lds;
    volatile LAS unsigned* MISC;
    gu32* ctl;
    int tid, lane, wave;
    int vcu, G;
    const float *x_p, *x_s, *st_pool, *st_ret, *c_p, *c_s, *ada_w, *ada_b, *g_pre, *g_post, *w_in, *pool_w, *pool_scale, *gn_g, *w_a, *w_b, *w_merge, *b_merge, *w_out;
    float* out;
    float *ropec, *ropes, *mod, *ss;
    bf16 *Wcat, *Wab, *Wout, *PoolW, *H, *AX, *AG, *Qb, *Kb, *Vb, *BG, *GA, *GB, *YAB, *POOLED, *SN, *MB;
};

struct EpiZ {
    static constexpr bool PERM = true; static constexpr int MID_T = 0;
    bf16 *AX, *AG, *Qb, *Kb, *Vb, *BG, *GA, *GB; const float* bmerge; const float* ropec; const float* ropes; float* out_pp; float* out_ps;
    template <int NM> __device__ __forceinline__ void core(const pg8::f32x4 (&a)[NM][2], int row0, int cs, int fq) const {
        using namespace pg8;
        if (cs >= ZC_Q && cs < ZC_V) {
            const float ksc = (cs >= ZC_K) ? 0.08838834764831845f : 1.0f;
            const int j0 = 16 * ((cs & 127) >> 5) + 4 * fq, hd = (cs >> 7) & 7; bf16* qk = (cs >= ZC_K) ? Kb : Qb;
#pragma unroll
            for (int m = 0; m < NM; ++m) {
                const int row = row0 + m * 16; const int pos = row < MP ? (row & (SEQ - 1)) : SEQ;
                const f32x4 c4 = *(const f32x4*)(ropec + pos * 64 + j0), s4 = *(const f32x4*)(ropes + pos * 64 + j0);
                bf16* rowp = qk + (size_t)hm_row(row, hd) * DK + j0;
                const f32x4 v0 = a[m][0], v1 = a[m][1];
                const f32x4 o1 = (v0 * c4 - v1 * s4) * ksc, o2 = (v0 * s4 + v1 * c4) * ksc;
                u32x2 w1, w2; w1.x = cvt_pk_bf16(o1[0], o1[1]); w1.y = cvt_pk_bf16(o1[2], o1[3]); w2.x = cvt_pk_bf16(o2[0], o2[1]); w2.y = cvt_pk_bf16(o2[2], o2[3]);
                *(u32x2*)rowp = w1; *(u32x2*)(rowp + 64) = w2;
            }
            return;
        }
        const int act = (cs >= ZC_GA) ? 2 : (((cs >= ZC_AG && cs < ZC_Q) || (cs >= ZC_BG)) ? 1 : 0);
        const int col = cs + 8 * fq;
        f32x4 bv[2];
#pragma unroll
        for (int n = 0; n < 2; ++n) bv[n] = (act == 2) ? *(const f32x4*)(bmerge + (col - ZC_GA) + 4 * n) : (f32x4){0.f, 0.f, 0.f, 0.f};
#pragma unroll
        for (int m = 0; m < NM; ++m) {
            const int row = row0 + m * 16;
            f32x4 v0 = a[m][0] + bv[0], v1 = a[m][1] + bv[1];
            if (act == 1) {
#pragma unroll
                for (int e = 0; e < 4; ++e) { v0[e] = silu_(v0[e]); v1[e] = silu_(v1[e]); }
            } else if (act == 2) {
#pragma unroll
                for (int e = 0; e < 4; ++e) { v0[e] = sigmoidf_(v0[e]); v1[e] = sigmoidf_(v1[e]); }
            }
            u32x4 w; w.x = cvt_pk_bf16(v0[0], v0[1]); w.y = cvt_pk_bf16(v0[2], v0[3]); w.z = cvt_pk_bf16(v1[0], v1[1]); w.w = cvt_pk_bf16(v1[2], v1[3]);
            bf16* dst = (cs < ZC_AG) ? AX + (size_t)row * DPOOL + col : (cs < ZC_Q) ? AG + (size_t)row * DPOOL + (col - ZC_AG) : (cs < ZC_BG) ? Vb + (size_t)hm_row(row, (cs - ZC_V) >> 8) * DV + (col & 255)
                      : (cs < ZC_GA) ? BG + (size_t)hm_row(row, (cs - ZC_BG) >> 8) * DV + (col & 255) : (cs < ZC_GB) ? GA + (size_t)row * DM + (col - ZC_GA) : GB + (size_t)row * DM + (col - ZC_GB);
            *(u32x4*)dst = w;
            if (cs < ZC_AG) {
                if (row < MP) { const int t = row & (SEQ - 1); if (t >= SEQ - 15) { float* o = out_pp + ((size_t)((row >> 11) * 15 + (t - (SEQ - 15)))) * DPOOL + col; *(f32x4*)o = v0; *(f32x4*)(o + 4) = v1; } }
                else if (row < MP + MS) { float* o = out_ps + ((size_t)((row - MP) * 15 + 14)) * DPOOL + col; *(f32x4*)o = v0; *(f32x4*)(o + 4) = v1; }
            }
        }
    }
    template <int NM> __device__ __forceinline__ void mid(pg8::f32x4 (&)[NM][2], int, int, int) const {}
};
struct EpiPool {
    static constexpr bool PERM = true; static constexpr int MID_T = 0;
    bf16* Y; const bf16* AG; const float* pscale;
    template <int NM> __device__ __forceinline__ void core(const pg8::f32x4 (&a)[NM][2], int row0, int cs, int fq) const {
        using namespace pg8;
        const int col = cs + 8 * fq;
        const f32x4 ps0 = *(const f32x4*)(pscale + col), ps1 = *(const f32x4*)(pscale + col + 4);
#pragma unroll
        for (int m = 0; m < NM; ++m) {
            const int row = row0 + m * 16;
            const u32x4 g = *(const u32x4*)(AG + (size_t)row * DPOOL + col);
            f32x4 v0 = a[m][0] * ps0, v1 = a[m][1] * ps1;
            v0[0] *= bf_lo(g.x); v0[1] *= bf_hi(g.x); v0[2] *= bf_lo(g.y); v0[3] *= bf_hi(g.y);
            v1[0] *= bf_lo(g.z); v1[1] *= bf_hi(g.z); v1[2] *= bf_lo(g.w); v1[3] *= bf_hi(g.w);
            u32x4 w; w.x = cvt_pk_bf16(v0[0], v0[1]); w.y = cvt_pk_bf16(v0[2], v0[3]); w.z = cvt_pk_bf16(v1[0], v1[1]); w.w = cvt_pk_bf16(v1[2], v1[3]);
            *(u32x4*)(Y + (size_t)row * LDY + col) = w;
        }
    }
    template <int NM> __device__ __forceinline__ void mid(pg8::f32x4 (&)[NM][2], int, int, int) const {}
};
struct EpiMerge {
    static constexpr bool PERM = true; static constexpr int MID_T = 16;
    bf16* O; const bf16* GA; const bf16* GB;
    template <int NM> __device__ __forceinline__ void mid(pg8::f32x4 (&a)[NM][2], int row0, int cs, int fq) const {
        using namespace pg8;
        const size_t zoff = (size_t)row0 * DM + cs + 8 * fq; const bf16* za = GA + zoff; const bf16* zb = GB + zoff;
        asm volatile("" : "+v"(za), "+v"(zb));
#pragma unroll
        for (int m = 0; m < NM; ++m) {
            const u32x4 ga = *(const u32x4*)(za + (size_t)(m * 16) * DM), gb = *(const u32x4*)(zb + (size_t)(m * 16) * DM);
            f32x4& v0 = a[m][0]; f32x4& v1 = a[m][1];
            v0[0] *= bf_lo(ga.x) * __builtin_amdgcn_rcpf(bf_lo(gb.x)); v0[1] *= bf_hi(ga.x) * __builtin_amdgcn_rcpf(bf_hi(gb.x)); v0[2] *= bf_lo(ga.y) * __builtin_amdgcn_rcpf(bf_lo(gb.y)); v0[3] *= bf_hi(ga.y) * __builtin_amdgcn_rcpf(bf_hi(gb.y));
            v1[0] *= bf_lo(ga.z) * __builtin_amdgcn_rcpf(bf_lo(gb.z)); v1[1] *= bf_hi(ga.z) * __builtin_amdgcn_rcpf(bf_hi(gb.z)); v1[2] *= bf_lo(ga.w) * __builtin_amdgcn_rcpf(bf_lo(gb.w)); v1[3] *= bf_hi(ga.w) * __builtin_amdgcn_rcpf(bf_hi(gb.w));
            if (m & 1) asm volatile("" ::: "memory");
        }
    }
    template <int NM> __device__ __forceinline__ void core(const pg8::f32x4 (&a)[NM][2], int row0, int cs, int fq) const {
        using namespace pg8;
        const int col = cs + 8 * fq;
#pragma unroll
        for (int m = 0; m < NM; ++m) {
            const int row = row0 + m * 16;
            const u32x4 g = *(const u32x4*)(GB + (size_t)row * DM + col);
            f32x4 v0 = a[m][0], v1 = a[m][1];
            v0[0] *= bf_lo(g.x); v0[1] *= bf_hi(g.x); v0[2] *= bf_lo(g.y); v0[3] *= bf_hi(g.y);
            v1[0] *= bf_lo(g.z); v1[1] *= bf_hi(g.z); v1[2] *= bf_lo(g.w); v1[3] *= bf_hi(g.w);
            u32x4 w; w.x = cvt_pk_bf16(v0[0], v0[1]); w.y = cvt_pk_bf16(v0[2], v0[3]); w.z = cvt_pk_bf16(v1[0], v1[1]); w.w = cvt_pk_bf16(v1[2], v1[3]);
            *(u32x4*)(O + (size_t)row * DM + col) = w;
        }
    }
};
struct EpiOut {
    static constexpr bool PERM = false; static constexpr int MID_T = 0;
    float* out; float* ss;
    template <int NM> __device__ __forceinline__ void core(const pg8::f32x4 (&a)[NM][2], int row0, int cs, int fq) const {
        using namespace pg8;
#pragma unroll
        for (int m = 0; m < NM; ++m) {
            const int row = row0 + m * 16;
            float s = 0.f;
#pragma unroll
            for (int n = 0; n < 2; ++n) { const f32x4 v = a[m][n]; s += (v[0] * v[0] + v[1] * v[1]) + (v[2] * v[2] + v[3] * v[3]); }
            s += __shfl_xor(s, 16); s += __shfl_xor(s, 32);
            if (fq == 0) ss[(size_t)row * 64 + (cs >> 5)] = s;
            if (row < MP + MS) {
                float* rowp = out + (row < MP ? O_YP + (size_t)row * DM : O_YS + (size_t)(row - MP) * DM) + cs + 4 * fq;
#pragma unroll
                for (int n = 0; n < 2; ++n) *(f32x4*)(rowp + n * 16) = a[m][n];
            }
        }
    }
    template <int NM> __device__ __forceinline__ void mid(pg8::f32x4 (&)[NM][2], int, int, int) const {}
};

__device__ __forceinline__ int rot_row(int n) { const int L = n & 127, hf = L >> 6, j = L & 63; return (n & ~127) + 32 * (j >> 4) + 8 * ((j >> 2) & 3) + 4 * hf + (j & 3); }
__device__ __forceinline__ void p0_transpose_item(const float* W, int N, bf16* WT, int ldw, int row_off, int koff, int rot_lo, int rot_hi, LAS float* scr, int item, int lane) {
    const int nblk = N / 32, kb = item / nblk, nb = item % nblk, k0 = 64 * kb, n0 = 32 * nb;
#pragma unroll 8
    for (int i = 0; i < 32; ++i) { const int kk = 2 * i + (lane >> 5); scr[kk * 33 + (lane & 31)] = __builtin_nontemporal_load(W + (size_t)(k0 + kk) * N + n0 + (lane & 31)); }
    LDS_WAIT(); asm volatile("" ::: "memory");
    const int c = lane & 7;
#pragma unroll
    for (int j = 0; j < 4; ++j) { const int n = (lane >> 3) + 8 * j; const LAS float* s = scr + (8 * c) * 33 + n;
        v4u o; o.x = pk2(s[0 * 33], s[1 * 33]); o.y = pk2(s[2 * 33], s[3 * 33]); o.z = pk2(s[4 * 33], s[5 * 33]); o.w = pk2(s[6 * 33], s[7 * 33]);
        int nn = n0 + n; if (nn >= rot_lo && nn < rot_hi) nn = rot_row(nn);
        *(GAS v4u*)(WT + (size_t)(row_off + nn) * ldw + koff + k0 + 8 * c) = o; }
    LDS_WAIT(); asm volatile("" ::: "memory");
}
__device__ __forceinline__ void p0_mod_item(Frame& F, int strip) {
    const int n0 = strip * 32, lane = F.lane, fr = lane & 15, fq = lane >> 4, wave = F.wave;
    f32x4 acc[9][2];
#pragma unroll
    for (int a = 0; a < 9; ++a) { acc[a][0] = (f32x4){0.f, 0.f, 0.f, 0.f}; acc[a][1] = (f32x4){0.f, 0.f, 0.f, 0.f}; }
    for (int ks = 0; ks < 8; ++ks) {
        const int k0 = wave * 256 + ks * 32 + 8 * fq;
        bf16x8 bfr[2];
#pragma unroll
        for (int nt = 0; nt < 2; ++nt) {
            float w[8];
#pragma unroll
            for (int j = 0; j < 8; ++j) w[j] = __builtin_nontemporal_load(F.ada_w + (size_t)(k0 + j) * 6144 + n0 + 16 * nt + fr);
            v4u p; p.x = pk2(w[0], w[1]); p.y = pk2(w[2], w[3]); p.z = pk2(w[4], w[5]); p.w = pk2(w[6], w[7]);
            bfr[nt] = __builtin_bit_cast(bf16x8, p);
        }
#pragma unroll
        for (int mt = 0; mt < 9; ++mt) {
            const int row = 16 * mt + fr;
            f32x4 a0 = (f32x4){0.f, 0.f, 0.f, 0.f}, a1 = a0;
            if (row < 132) { const float* cp = (row < 4 ? F.c_p + (size_t)row * DM : F.c_s + (size_t)(row - 4) * DM) + k0; a0 = *(const f32x4*)cp; a1 = *(const f32x4*)(cp + 4); }
            v4u p; p.x = pk2(silu_(a0[0]), silu_(a0[1])); p.y = pk2(silu_(a0[2]), silu_(a0[3])); p.z = pk2(silu_(a1[0]), silu_(a1[1])); p.w = pk2(silu_(a1[2]), silu_(a1[3]));
            const bf16x8 afr = __builtin_bit_cast(bf16x8, p);
            acc[mt][0] = __builtin_amdgcn_mfma_f32_16x16x32_bf16(afr, bfr[0], acc[mt][0], 0, 0, 0);
            acc[mt][1] = __builtin_amdgcn_mfma_f32_16x16x32_bf16(afr, bfr[1], acc[mt][1], 0, 0, 0);
        }
    }
    LAS float* red = (LAS float*)F.lds;
    for (int w = 0; w < 8; ++w) {
        if (wave == w) {
#pragma unroll
            for (int mt = 0; mt < 9; ++mt)
#pragma unroll
                for (int nt = 0; nt < 2; ++nt)
#pragma unroll
                    for (int r = 0; r < 4; ++r) { const int idx = (16 * mt + 4 * fq + r) * 32 + 16 * nt + fr; if (w == 0) red[idx] = acc[mt][nt][r]; else red[idx] += acc[mt][nt][r]; }
        }
        __syncthreads();
    }
    for (int i = F.tid; i < 132 * 32; i += NWAVES * 64) { const int r = i >> 5, cc = i & 31; F.mod[(size_t)r * 6144 + n0 + cc] = red[i] + F.ada_b[n0 + cc]; }
    __syncthreads();
}
__device__ __forceinline__ void rope_entry(int prow, int i, float* cosT, float* sinT) {
    double th = 1.0, bs = 0.8659643233600653;
    for (int e = i; e; e >>= 1) { if (e & 1) th *= bs; bs *= bs; }
    const double t2 = th * th; double c = 1.0, s = th, tc = 1.0, ts = th;
#pragma unroll 1
    for (int n = 1; n <= 12; ++n) { tc *= -t2 / (double)((2 * n - 1) * (2 * n)); c += tc; ts *= -t2 / (double)((2 * n) * (2 * n + 1)); s += ts; }
    const int pos = prow < SEQ ? prow : PAST;
    double rc = 1.0, rs = 0.0, bc = c, bn = s;
    for (int e = pos; e; e >>= 1) { if (e & 1) { const double t = rc * bc - rs * bn; rs = rc * bn + rs * bc; rc = t; } const double t = bc * bc - bn * bn; bn = 2.0 * bc * bn; bc = t; }
    cosT[prow * 64 + i] = (float)rc; sinT[prow * 64 + i] = (float)rs;
}
__device__ __forceinline__ void p0_prologue(Frame& F) {
    if (F.vcu < 192) for (int s = F.vcu; s < 192; s += F.G) p0_mod_item(F, s);
    LAS float* scr = (LAS float*)(F.lds + RING_OFF + F.wave * 16384);
    const int gw = F.vcu * NWAVES + F.wave, NGW = F.G * NWAVES;
    constexpr int I_IN = 32 * 256, I_MG = 32 * 128, I_A = 16 * 64, I_B = 32 * 64, I_O = 32 * 64, I_P = 4 * 8;
    constexpr int NITEMS = I_IN + I_MG + I_A + I_B + I_O + 4 * I_P;
    for (int it = gw; it < NITEMS; it += NGW) {
        int r = it;
        if (r < I_IN) { p0_transpose_item(F.w_in, DIN, F.Wcat, DM, 0, 0, ZC_Q, ZC_V, scr, r, F.lane); continue; } r -= I_IN;
        if (r < I_MG) { p0_transpose_item(F.w_merge, 4096, F.Wcat, DM, DIN, 0, 0, 0, scr, r, F.lane); continue; } r -= I_MG;
        if (r < I_A) { p0_transpose_item(F.w_a, DM, F.Wab, LDY, 0, 0, 0, 0, scr, r, F.lane); continue; } r -= I_A;
        if (r < I_B) { p0_transpose_item(F.w_b, DM, F.Wab, LDY, 0, 1024, 0, 0, scr, r, F.lane); continue; } r -= I_B;
        if (r < I_O) { p0_transpose_item(F.w_out, DM, F.Wout, DM, 0, 0, 0, 0, scr, r, F.lane); continue; } r -= I_O;
        { const int g = r / I_P; p0_transpose_item(F.pool_w + (size_t)g * 65536, 256, F.PoolW, 256, g * 256, 0, 0, 0, scr, r % I_P, F.lane); }
    }
    const int gt = F.vcu * (NWAVES * 64) + F.tid, NGT = F.G * NWAVES * 64;
    for (int e = gt; e < 2049 * 64; e += NGT) rope_entry(e >> 6, e & 63, F.ropec, F.ropes);
}

__device__ __forceinline__ void h_row(Frame& F, const float* xrow, const float* modrow, bf16* orow) {
    const GAS f32x4* xr = (const GAS f32x4*)xrow + F.lane;
    f32x4 v[8]; float s = 0.f;
#pragma unroll
    for (int j = 0; j < 8; ++j) { v[j] = xr[64 * j]; s += (v[j].x * v[j].x + v[j].y * v[j].y) + (v[j].z * v[j].z + v[j].w * v[j].w); }
    const float rstd = 1.0f / sqrtf(wave_sum(s) * (1.0f / DM) + EPS);
    GAS v2u* o8 = (GAS v2u*)orow + F.lane;
#pragma unroll
    for (int j = 0; j < 8; ++j) {
        const int col = 4 * F.lane + 256 * j;
        const f32x4 g = *(const f32x4*)(F.g_pre + col), sh = *(const f32x4*)(modrow + col), sc = *(const f32x4*)(modrow + DM + col);
        const f32x4 o = v[j] * rstd * g * (sc + 1.0f) + sh;
        v2u w; w.x = pk2(o.x, o.y); w.y = pk2(o.z, o.w); o8[64 * j] = w;
    }
}

__device__ __forceinline__ unsigned off_a(unsigned row, unsigned ch) { return 2048u * (row >> 3) + 512u * (ch >> 2) + 64u * (row & 7) + 16u * ((ch & 3) ^ ((row >> 2) & 3)); }
struct RowA { unsigned e, d; };
struct TrA { unsigned t0, t1; };
__device__ __forceinline__ RowA row_addr(unsigned lane) { RowA r; r.e = off_a(lane & 31, lane >> 5); r.d = off_a(lane & 31, 2 + (lane >> 5)) - r.e; return r; }
__device__ __forceinline__ TrA tr_addr(unsigned lane) { const unsigned h = lane >> 5, blk = (lane >> 4) & 1, q = (lane & 15) >> 2, p = lane & 3; TrA t;
    t.t0 = off_a(8 * h + q, 2 * blk + (p >> 1)) + 8 * (p & 1); t.t1 = off_a(8 * h + 4 + q, 2 * blk + (p >> 1)) + 8 * (p & 1); return t; }
__device__ __forceinline__ bf16x8 frag_row(const LAS unsigned char* img, const RowA& ra, int s) { return *(const LAS bf16x8*)(img + (ra.e + (unsigned)(s & 1) * ra.d + 512u * (unsigned)(s >> 1))); }
__device__ __forceinline__ bf16x8 frag_tr(const LAS unsigned char* img, const TrA& ta, int c, int ks) {
    const s16x4 lo = __builtin_bit_cast(s16x4, __builtin_amdgcn_ds_read_tr16_b64_v4i16((LAS s16x4*)(img + ta.t0 + 512 * c + 4096 * ks)));
    const s16x4 hi = __builtin_bit_cast(s16x4, __builtin_amdgcn_ds_read_tr16_b64_v4i16((LAS s16x4*)(img + ta.t1 + 512 * c + 4096 * ks)));
    return __builtin_shufflevector(lo, hi, 0, 1, 2, 3, 4, 5, 6, 7);
}
#define MFMA32(a, b, c) __builtin_amdgcn_mfma_f32_32x32x16_bf16((a), (b), (c), 0, 0, 0)
__device__ __forceinline__ int crow(int reg, int h) { return (reg & 3) + 8 * (reg >> 2) + 4 * h; }

__device__ __forceinline__ void ret_ab_unit(Frame& F, int unit) {
    const int bh = unit >> 3, dh = (unit >> 2) & 1, dq = unit & 3, b = bh >> 3, h = bh & 7, lane = fresh_lane(), wave = F.wave, hh = lane >> 5, tid_ = wave * 64 + lane;
    const float lg = lg2gamma(h);
    const float cdec = __builtin_amdgcn_exp2f(128.0f * lg);
    const int di = wave & 1, dj = (wave >> 1) & 1;
    const TrA ta = tr_addr(lane);
    f32x16 acc;
#pragma unroll
    for (int e = 0; e < 16; ++e) acc[e] = 0.f;
    const bf16* Kh = F.Kb + (size_t)bh * SEQ * DK + dh * 64; const bf16* Vh = F.Vb + (size_t)bh * SEQ * DV + dq * 64;
    v4u r0[4], r1[4];
#define AB_LOAD(c, R) do { _Pragma("unroll") for (int i = 0; i < 2; ++i) { const int n = tid_ + 512 * i, row = n >> 3, ch = n & 7; const size_t tr_ = (size_t)((c) * 128 + row); \
        R[i] = *(const GAS v4u*)(Kh + tr_ * DK + ch * 8); R[2 + i] = *(const GAS v4u*)(Vh + tr_ * DV + ch * 8); } } while (0)
#define AB_STORE(buf, R) do { _Pragma("unroll") for (int i = 0; i < 2; ++i) { const int n = tid_ + 512 * i, row = n >> 3, ch = n & 7; \
        const float d = __builtin_amdgcn_exp2f((float)(127 - row) * lg); v4u kk = R[i]; \
        kk.x = pk2(bflo(kk.x) * d, bfhi(kk.x) * d); kk.y = pk2(bflo(kk.y) * d, bfhi(kk.y) * d); kk.z = pk2(bflo(kk.z) * d, bfhi(kk.z) * d); kk.w = pk2(bflo(kk.w) * d, bfhi(kk.w) * d); \
        const unsigned o = (unsigned)(buf) * 65536u + (unsigned)(row >> 5) * 8192u + off_a(row & 31, ch); \
        *(LAS v4u*)(F.lds + o) = kk; *(LAS v4u*)(F.lds + 32768u + o) = R[2 + i]; } } while (0)
#define AB_STEP(c, RC, RN) do { \
        if ((c) + 2 < 16) AB_LOAD((c) + 2, RC); \
        if (wave < 4) { \
            if ((c) > 0) { v4u w0, w1; w0.x = pk2(acc[0], acc[1]); w0.y = pk2(acc[2], acc[3]); w0.z = pk2(acc[4], acc[5]); w0.w = pk2(acc[6], acc[7]); \
                w1.x = pk2(acc[8], acc[9]); w1.y = pk2(acc[10], acc[11]); w1.z = pk2(acc[12], acc[13]); w1.w = pk2(acc[14], acc[15]); \
                bf16* sn = F.SN + ((((size_t)(bh * 16 + (c)) * 32 + (2 * dh + di) * 8 + (2 * dq + dj)) * 64 + lane) * 16); \
                *(GAS v4u*)sn = w0; *(GAS v4u*)(sn + 8) = w1; } \
            _Pragma("unroll") for (int e = 0; e < 16; ++e) acc[e] *= cdec; \
            const LAS unsigned char* kb = F.lds + ((c) & 1) * 65536; const LAS unsigned char* vb = kb + 32768; \
            _Pragma("unroll") for (int kk = 0; kk < 8; ++kk) acc = MFMA32(frag_tr(kb + (kk >> 1) * 8192, ta, di, kk & 1), frag_tr(vb + (kk >> 1) * 8192, ta, dj, kk & 1), acc); \
        } \
        if ((c) + 1 < 16) AB_STORE(((c) + 1) & 1, RN); \
        __syncthreads(); } while (0)
    AB_LOAD(0, r0); AB_LOAD(1, r1); AB_STORE(0, r0); __syncthreads();
#pragma unroll 1
    for (int c = 0; c < 16; c += 2) { AB_STEP(c, r0, r1); AB_STEP(c + 1, r1, r0); }
#undef AB_LOAD
#undef AB_STORE
#undef AB_STEP
    if (wave < 4) {
        float* so = F.out + O_RP + (size_t)bh * (DK * DV);
        const int dv = 64 * dq + 32 * dj + (lane & 31);
#pragma unroll
        for (int e = 0; e < 16; ++e) so[(size_t)(64 * dh + 32 * di + crow(e, hh)) * DV + dv] = acc[e];
    }
}

__device__ __forceinline__ void pooled_prompt(Frame& F, int it0, int it1) {
    for (int it = it0 + F.tid; it < it1; it += NWAVES * 64) {
        const int row = it >> 7, q = it & 127, t = row & (SEQ - 1), w = 2 << (q >> 5), cnt = (t + 1 < w) ? t + 1 : w;
        const bf16* p = F.AX + (size_t)row * DPOOL + q * 8;
        v4u x[16];
#pragma unroll
        for (int j = 0; j < 16; ++j) x[j] = (j < cnt) ? *(const GAS v4u*)(p - (size_t)j * DPOOL) : (v4u){0u, 0u, 0u, 0u};
        float s[8] = {0.f, 0.f, 0.f, 0.f, 0.f, 0.f, 0.f, 0.f};
#pragma unroll
        for (int j = 0; j < 16; ++j) { s[0] += bflo(x[j].x); s[1] += bfhi(x[j].x); s[2] += bflo(x[j].y); s[3] += bfhi(x[j].y); s[4] += bflo(x[j].z); s[5] += bfhi(x[j].z); s[6] += bflo(x[j].w); s[7] += bfhi(x[j].w); }
        const float inv = 1.0f / (float)cnt;
        const float a[8] = {bflo(x[0].x), bfhi(x[0].x), bflo(x[0].y), bfhi(x[0].y), bflo(x[0].z), bfhi(x[0].z), bflo(x[0].w), bfhi(x[0].w)};
        v4u o; o.x = pk2(s[0] * inv - a[0], s[1] * inv - a[1]); o.y = pk2(s[2] * inv - a[2], s[3] * inv - a[3]); o.z = pk2(s[4] * inv - a[4], s[5] * inv - a[5]); o.w = pk2(s[6] * inv - a[6], s[7] * inv - a[7]);
        *(GAS v4u*)(F.POOLED + (size_t)row * DPOOL + q * 8) = o;
    }
}
__device__ __forceinline__ void pooled_sample(Frame& F, int it0, int it1) {
    for (int it = it0 + F.tid; it < it1; it += NWAVES * 64) {
        const int bs = it >> 7, q = it & 127, w = 2 << (q >> 5);
        const v4u x = *(const GAS v4u*)(F.AX + (size_t)(MP + bs) * DPOOL + q * 8);
        float a[8] = {bflo(x.x), bfhi(x.x), bflo(x.y), bfhi(x.y), bflo(x.z), bfhi(x.z), bflo(x.w), bfhi(x.w)}, s[8];
#pragma unroll
        for (int e = 0; e < 8; ++e) s[e] = a[e];
        const float* sp = F.st_pool + (size_t)bs * 15 * DPOOL + q * 8;
        float* op = F.out + O_PS + (size_t)bs * 15 * DPOOL + q * 8;
#pragma unroll
        for (int i = 14; i >= 0; --i) {
            const f32x4 b0 = *(const f32x4*)(sp + (size_t)i * DPOOL), b1 = *(const f32x4*)(sp + (size_t)i * DPOOL + 4);
            if (i >= 1) { *(f32x4*)(op + (size_t)(i - 1) * DPOOL) = b0; *(f32x4*)(op + (size_t)(i - 1) * DPOOL + 4) = b1; }
            if (15 - i < w) { s[0] += b0.x; s[1] += b0.y; s[2] += b0.z; s[3] += b0.w; s[4] += b1.x; s[5] += b1.y; s[6] += b1.z; s[7] += b1.w; }
        }
        const float inv = 1.0f / (float)w;
        v4u o; o.x = pk2(s[0] * inv - a[0], s[1] * inv - a[1]); o.y = pk2(s[2] * inv - a[2], s[3] * inv - a[3]); o.z = pk2(s[4] * inv - a[4], s[5] * inv - a[5]); o.w = pk2(s[6] * inv - a[6], s[7] * inv - a[7]);
        *(GAS v4u*)(F.POOLED + (size_t)(MP + bs) * DPOOL + q * 8) = o;
    }
}
__device__ __forceinline__ void ret_sample_items(Frame& F, int first, int count) {
    const int lane = fresh_lane(), wave = F.wave;
    f32x4 svA[16], svB[16];
#define RS_LOAD(item, SV) do { const float* s0_ = F.st_ret + ((size_t)(item) * DK + 16 * wave) * DV + 4 * lane; \
        _Pragma("unroll") for (int r = 0; r < 16; ++r) SV[r] = __builtin_nontemporal_load((const f32x4*)(s0_ + (size_t)r * DV)); } while (0)
#define RS_BODY(item, SV, buf) do { \
        const int bs_ = (item) >> 3, h_ = (item) & 7, row_ = MP + bs_; \
        const float gam_ = 1.0f - __builtin_amdgcn_exp2f((float)(-5 - h_)); \
        const size_t hr_ = (size_t)(MP * NH) + (size_t)(item); \
        f32x4 v4_; { const v2u x_ = *(const GAS v2u*)(F.Vb + hr_ * DV + 4 * lane); v4_ = (f32x4){bflo(x_.x), bfhi(x_.x), bflo(x_.y), bfhi(x_.y)}; } \
        const v4u q0_ = *(const GAS v4u*)(F.Qb + hr_ * DK + 16 * wave), q1_ = *(const GAS v4u*)(F.Qb + hr_ * DK + 16 * wave + 8); \
        const v4u k0_ = *(const GAS v4u*)(F.Kb + hr_ * DK + 16 * wave), k1_ = *(const GAS v4u*)(F.Kb + hr_ * DK + 16 * wave + 8); \
        const float qv_[16] = {bflo(q0_.x), bfhi(q0_.x), bflo(q0_.y), bfhi(q0_.y), bflo(q0_.z), bfhi(q0_.z), bflo(q0_.w), bfhi(q0_.w), bflo(q1_.x), bfhi(q1_.x), bflo(q1_.y), bfhi(q1_.y), bflo(q1_.z), bfhi(q1_.z), bflo(q1_.w), bfhi(q1_.w)}; \
        const float kv_[16] = {bflo(k0_.x), bfhi(k0_.x), bflo(k0_.y), bfhi(k0_.y), bflo(k0_.z), bfhi(k0_.z), bflo(k0_.w), bfhi(k0_.w), bflo(k1_.x), bfhi(k1_.x), bflo(k1_.y), bfhi(k1_.y), bflo(k1_.z), bfhi(k1_.z), bflo(k1_.w), bfhi(k1_.w)}; \
        float* s1_ = F.out + O_RS + ((size_t)(item) * DK + 16 * wave) * DV + 4 * lane; \
        f32x4 o4_ = (f32x4){0.f, 0.f, 0.f, 0.f}; \
        _Pragma("unroll") for (int r = 0; r < 16; ++r) { const f32x4 sn_ = SV[r] * gam_ + v4_ * kv_[r]; __builtin_nontemporal_store(sn_, (f32x4*)(s1_ + (size_t)r * DV)); o4_ += sn_ * qv_[r]; } \
        LAS float* part_ = (LAS float*)(F.lds) + (buf) * 2048; \
        *(LAS f32x4*)(part_ + wave * 256 + 4 * lane) = o4_; \
        __syncthreads(); \
        if (wave == 0) { \
            f32x4 o_ = *(LAS f32x4*)(part_ + 4 * lane); \
            _Pragma("unroll") for (int w = 1; w < 8; ++w) o_ += *(LAS f32x4*)(part_ + w * 256 + 4 * lane); \
            const float mu_ = wave_sum((o_.x + o_.y) + (o_.z + o_.w)) * (1.0f / DV); \
            o_ = o_ - mu_; \
            const float var_ = wave_sum((o_.x * o_.x + o_.y * o_.y) + (o_.z * o_.z + o_.w * o_.w)) * (1.0f / DV); \
            const float rstd_ = 1.0f / sqrtf(var_ + EPS); \
            const f32x4 g_ = *(const f32x4*)(F.gn_g + h_ * DV + 4 * lane); \
            const v2u x_ = *(const GAS v2u*)(F.BG + hr_ * DV + 4 * lane); \
            o_ = o_ * rstd_ * g_; o_.x *= bflo(x_.x); o_.y *= bfhi(x_.x); o_.z *= bflo(x_.y); o_.w *= bfhi(x_.y); \
            v2u wv_; wv_.x = pk2(o_.x, o_.y); wv_.y = pk2(o_.z, o_.w); \
            *(GAS v2u*)(F.YAB + (size_t)row_ * LDY + 1024 + h_ * DV + 4 * lane) = wv_; \
        } } while (0)
    RS_LOAD(first, svA);
#pragma unroll 1
    for (int k = 0; k < count; k += 2) {
        if (k + 1 < count) RS_LOAD(first + k + 1, svB);
        RS_BODY(first + k, svA, 0);
        if (k + 1 < count) { if (k + 2 < count) RS_LOAD(first + k + 2, svA); RS_BODY(first + k + 1, svB, 1); }
    }
#undef RS_LOAD
#undef RS_BODY
    __syncthreads();
}

__device__ __forceinline__ void ret_c_unit(Frame& F, int unit) {
    const int bh = unit >> 4, c = unit & 15, b = bh >> 3, h = bh & 7, lane = fresh_lane(), wave = F.wave, hh = lane >> 5, l31 = lane & 31, tid_ = wave * 64 + lane;
    const float lg = lg2gamma(h);
    const int ti = wave & 3, wh = wave >> 2;
    const RowA ra = row_addr(lane); const TrA ta = tr_addr(lane);
    const int rowbase = b * SEQ + c * 128;
    const size_t hrow = (size_t)bh * SEQ + c * 128;
    const bf16* Qg = F.Qb + hrow * DK; const bf16* Kg = F.Kb + hrow * DK; const bf16* Vg = F.Vb + hrow * DV; const bf16* Bg = F.BG + hrow * DV;
    LAS unsigned char* Qi = F.lds; LAS unsigned char* Ki = F.lds + 32768; LAS unsigned char* Vi = F.lds + 65536;
    {
        v4u rq[4], rk[4], rv[8];
#pragma unroll
        for (int i = 0; i < 4; ++i) { const int n = tid_ + 512 * i;
            rq[i] = *(const GAS v4u*)(Qg + (size_t)n * 8); rk[i] = *(const GAS v4u*)(Kg + (size_t)n * 8); }
#pragma unroll
        for (int i = 0; i < 8; ++i) { const int n = tid_ + 512 * i; rv[i] = *(const GAS v4u*)(Vg + (size_t)n * 8); }
#pragma unroll
        for (int i = 0; i < 4; ++i) { const int n = tid_ + 512 * i, row = n >> 4, ch = n & 15; const unsigned o = (unsigned)(row >> 5) * 8192u + off_a(row & 31, ch);
            *(LAS v4u*)(Qi + o) = rq[i]; *(LAS v4u*)(Ki + o) = rk[i]; }
#pragma unroll
        for (int i = 0; i < 8; ++i) { const int n = tid_ + 512 * i, row = n >> 5, ch = n & 31;
            *(LAS v4u*)(Vi + (unsigned)((row >> 5) * 2 + (ch >> 4)) * 8192u + off_a(row & 31, ch & 15)) = rv[i]; }
    }
    const bf16* snb = F.SN + (((size_t)(bh * 16 + c) * 32) * 64 + lane) * 16;
    v4u sf[2][2][4];
    if (c > 0) {
#pragma unroll
        for (int i = 0; i < 2; ++i)
#pragma unroll
            for (int s2 = 0; s2 < 2; ++s2)
#pragma unroll
                for (int j = 0; j < 4; ++j) sf[i][s2][j] = *(const GAS v4u*)(snb + (size_t)(i * 8 + 4 * wh + j) * 1024 + 8 * s2);
    }
    __syncthreads();
    f32x16 X[2];
#pragma unroll
    for (int t = 0; t < 2; ++t) {
        const int sj = 2 * wh + t;
#pragma unroll
        for (int e = 0; e < 16; ++e) X[t][e] = 0.f;
        if (sj <= ti) {
#pragma unroll
            for (int ks = 0; ks < 8; ++ks) X[t] = MFMA32(frag_row(Ki + sj * 8192, ra, ks), frag_row(Qi + ti * 8192, ra, ks), X[t]);
        }
    }
    __syncthreads();
#pragma unroll
    for (int t = 0; t < 2; ++t) {
        const int sj = 2 * wh + t;
        if (sj <= ti) {
            const int tt = 32 * ti + l31;
#pragma unroll
            for (int g = 0; g < 4; ++g) {
                float p[4];
#pragma unroll
                for (int e = 0; e < 4; ++e) { const int s = 32 * sj + 8 * g + 4 * hh + e; const float f = __builtin_amdgcn_exp2f(-(float)(s + 1) * lg); p[e] = (s <= tt) ? X[t][4 * g + e] * f : 0.f; }
                v2u w; w.x = pk2(p[0], p[1]); w.y = pk2(p[2], p[3]);
                *(LAS v2u*)(Ki + ti * 8192 + off_a(l31, 4 * sj + g) + 8 * hh) = w;
            }
        }
    }
    f32x16 O[4];
#pragma unroll
    for (int j = 0; j < 4; ++j)
#pragma unroll
        for (int e = 0; e < 16; ++e) O[j][e] = 0.f;
    const unsigned qb = 2048u * (l31 >> 3) + 64u * (l31 & 7) + 8u * hh, qm = (l31 >> 2) & 3;
    const LAS unsigned char* Qt = Qi + ti * 8192 + qb;
#define QFRAG(i, s2) __builtin_shufflevector(*(const LAS s16x4*)(Qt + 512 * (i) + 16 * ((2 * (s2)) ^ qm)), *(const LAS s16x4*)(Qt + 512 * (i) + 16 * ((2 * (s2) + 1) ^ qm)), 0, 1, 2, 3, 4, 5, 6, 7)
    if (c > 0) {
#pragma unroll
        for (int i = 0; i < 2; ++i)
#pragma unroll
            for (int s2 = 0; s2 < 2; ++s2) { const bf16x8 a = QFRAG(i, s2);
#pragma unroll
                for (int j = 0; j < 4; ++j) O[j] = MFMA32(a, __builtin_bit_cast(bf16x8, sf[i][s2][j]), O[j]); }
#pragma unroll
        for (int i = 0; i < 2; ++i)
#pragma unroll
            for (int s2 = 0; s2 < 2; ++s2)
#pragma unroll
                for (int j = 0; j < 4; ++j) sf[i][s2][j] = *(const GAS v4u*)(snb + (size_t)((i + 2) * 8 + 4 * wh + j) * 1024 + 8 * s2);
    }
    __syncthreads();
    for (int kk = 0; kk < 2 * (ti + 1); ++kk) {
        const bf16x8 a = frag_row(Ki + ti * 8192, ra, kk);
        const LAS unsigned char* vimg = Vi + ((kk >> 1) * 2 + wh) * 8192;
#pragma unroll
        for (int j = 0; j < 4; ++j) O[j] = MFMA32(a, frag_tr(vimg, ta, j, kk & 1), O[j]);
    }
    if (c > 0) {
#pragma unroll
        for (int i = 0; i < 2; ++i)
#pragma unroll
            for (int s2 = 0; s2 < 2; ++s2) { const bf16x8 a = QFRAG(i + 2, s2);
#pragma unroll
                for (int j = 0; j < 4; ++j) O[j] = MFMA32(a, __builtin_bit_cast(bf16x8, sf[i][s2][j]), O[j]); }
    }
#undef QFRAG
    LAS float* st = (LAS float*)(F.lds + STAT_OFF);
    float mu[16], rs[16];
#pragma unroll
    for (int e = 0; e < 16; ++e) {
        const float f = __builtin_amdgcn_exp2f((float)(crow(e, hh) + 32 * ti + 1) * lg);
        float s = 0.f;
#pragma unroll
        for (int j = 0; j < 4; ++j) { O[j][e] *= f; s += O[j][e]; }
        s += __shfl_xor(s, 1); s += __shfl_xor(s, 2); s += __shfl_xor(s, 4); s += __shfl_xor(s, 8); s += __shfl_xor(s, 16);
        if (l31 == 0) st[(32 * ti + crow(e, hh)) * 2 + wh] = s;
    }
    __syncthreads();
#pragma unroll
    for (int e = 0; e < 16; ++e) { const int r = 32 * ti + crow(e, hh); mu[e] = (st[r * 2] + st[r * 2 + 1]) * (1.0f / DV); }
#pragma unroll
    for (int e = 0; e < 16; ++e) {
        float s = 0.f;
#pragma unroll
        for (int j = 0; j < 4; ++j) { O[j][e] -= mu[e]; s += O[j][e] * O[j][e]; }
        s += __shfl_xor(s, 1); s += __shfl_xor(s, 2); s += __shfl_xor(s, 4); s += __shfl_xor(s, 8); s += __shfl_xor(s, 16);
        if (l31 == 0) st[256 + (32 * ti + crow(e, hh)) * 2 + wh] = s;
    }
    __syncthreads();
#pragma unroll
    for (int e = 0; e < 16; ++e) { const int r = 32 * ti + crow(e, hh); rs[e] = 1.0f / sqrtf((st[256 + r * 2] + st[256 + r * 2 + 1]) * (1.0f / DV) + EPS); }
    LAS float* T = (LAS float*)F.lds;
#pragma unroll
    for (int j = 0; j < 4; ++j) {
        const float g = F.gn_g[h * DV + 128 * wh + 32 * j + l31];
#pragma unroll
        for (int e = 0; e < 16; ++e) T[(32 * ti + crow(e, hh)) * 256 + 128 * wh + 32 * j + l31] = O[j][e] * rs[e] * g;
    }
    __syncthreads();
    {
        v4u bg[8];
#pragma unroll
        for (int i = 0; i < 8; ++i) { const int n = tid_ + 512 * i; bg[i] = *(const GAS v4u*)(Bg + (size_t)n * 8); }
#pragma unroll
        for (int i = 0; i < 8; ++i) { const int n = tid_ + 512 * i, row = n >> 5, ch = n & 31;
            const f32x4 t0 = *(const LAS f32x4*)(T + row * 256 + ch * 8), t1 = *(const LAS f32x4*)(T + row * 256 + ch * 8 + 4);
            v4u o; o.x = pk2(t0.x * bflo(bg[i].x), t0.y * bfhi(bg[i].x)); o.y = pk2(t0.z * bflo(bg[i].y), t0.w * bfhi(bg[i].y));
            o.z = pk2(t1.x * bflo(bg[i].z), t1.y * bfhi(bg[i].z)); o.w = pk2(t1.z * bflo(bg[i].w), t1.w * bfhi(bg[i].w));
            *(GAS v4u*)(F.YAB + (size_t)(rowbase + row) * LDY + 1024 + h * DV + ch * 8) = o; }
    }
    __syncthreads();
}


constexpr int CW_Q = 8192;
__device__ __forceinline__ int wg_ticket(Frame& F, int q, int n) {
    __syncthreads();
    if (F.tid == 0) F.MISC[16] = __hip_atomic_fetch_add((unsigned*)(F.ctl + CW_Q + 64 * q), (unsigned)n, __ATOMIC_RELAXED, __HIP_MEMORY_SCOPE_AGENT);
    __syncthreads();
    return (int)F.MISC[16];
}

__device__ __forceinline__ void final_row(Frame& F, const float* xrow, float* yrow, const float* ssrow, const float* gaterow) {
    const float s = ssrow[F.lane];
    const float rstd = 1.0f / sqrtf(wave_sum(s) * (1.0f / DM) + EPS);
#pragma unroll
    for (int j = 0; j < 8; ++j) {
        const int col = 4 * F.lane + 256 * j;
        const f32x4 x = __builtin_nontemporal_load((const f32x4*)(xrow + col)), o = __builtin_nontemporal_load((const f32x4*)(yrow + col)), g = *(const f32x4*)(F.g_post + col), gt = *(const f32x4*)(gaterow + col);
        __builtin_nontemporal_store(x + gt * (o * rstd * g), (f32x4*)(yrow + col));
    }
}

struct Args { const float* in[19]; float* out; unsigned char* ws; int ph_lo, ph_hi; };
constexpr int N_PHASES = 8;
__global__ void __launch_bounds__(NWAVES * 64, 2) hybrid_fwd(Args args) {
    extern __shared__ __attribute__((aligned(16))) unsigned char lds[];
    Frame F;
    F.lds = (LAS unsigned char*)lds;
    F.MISC = (volatile LAS unsigned*)(F.lds + MISC_OFF);
    F.wave = __builtin_amdgcn_readfirstlane((int)threadIdx.x >> 6); F.lane = fresh_lane(); F.tid = F.wave * 64 + F.lane;
    F.G = gridDim.x; { const int bx = blockIdx.x; F.vcu = (F.G % 8 == 0) ? (bx % 8) * (F.G / 8) + bx / 8 : bx; }
    unsigned char* ws = args.ws;
    F.ctl = (gu32*)(ws + WS_CTL);
    F.x_p = args.in[0]; F.x_s = args.in[1]; F.st_pool = args.in[2]; F.st_ret = args.in[3]; F.c_p = args.in[4]; F.c_s = args.in[5]; F.ada_w = args.in[6]; F.ada_b = args.in[7];
    F.g_pre = args.in[8]; F.g_post = args.in[9]; F.w_in = args.in[10]; F.pool_w = args.in[11]; F.pool_scale = args.in[12]; F.gn_g = args.in[13]; F.w_a = args.in[14]; F.w_b = args.in[15];
    F.w_merge = args.in[16]; F.b_merge = args.in[17]; F.w_out = args.in[18]; F.out = args.out;
    F.ropec = (float*)(ws + WS_ROPE); F.ropes = F.ropec + 2049 * 64; F.mod = (float*)(ws + WS_MOD); F.ss = (float*)(ws + WS_SS);
    F.Wcat = (bf16*)(ws + WS_WCAT); F.Wab = (bf16*)(ws + WS_WAB); F.Wout = (bf16*)(ws + WS_WOUT); F.PoolW = (bf16*)(ws + WS_POOLW);
    F.H = (bf16*)(ws + WS_H); F.AX = (bf16*)(ws + WS_AX); F.AG = (bf16*)(ws + WS_AG); F.Qb = (bf16*)(ws + WS_Q); F.Kb = (bf16*)(ws + WS_K); F.Vb = (bf16*)(ws + WS_V); F.BG = (bf16*)(ws + WS_BG); F.GA = (bf16*)(ws + WS_GA); F.GB = (bf16*)(ws + WS_GB); F.YAB = (bf16*)(ws + WS_YAB); F.POOLED = (bf16*)(ws + WS_POOLED); F.SN = (bf16*)(ws + WS_SN); F.MB = (bf16*)(ws + WS_MB);
    for (int u = F.tid; u < (LDS_BYTES - LDSCTL_OFF) / 4; u += NWAVES * 64) ((LAS unsigned*)(F.lds + LDSCTL_OFF))[u] = 0u;
    __syncthreads();
    const int lo = args.ph_lo, hi = args.ph_hi;
    XcdBarrier bar; bar.bar = (unsigned*)(F.ctl + CW_BAR); bar.x = 0; bar.st = nullptr; bar.wave = F.wave;
    if (hi - lo > 1) bar = xcd_barrier_post((unsigned*)(F.ctl + CW_BAR), F.MISC + 8, F.wave);
#define IN(k) (lo <= (k) && (k) < hi)
#define PHASE_BEGIN() do { F.lane = fresh_lane(); F.tid = F.wave * 64 + F.lane; } while (0)
#define SEAM(k) do { if (IN(k) && IN((k) + 1)) xcd_barrier(bar); } while (0)
    const int gw = F.vcu * NWAVES + F.wave, NGW = F.G * NWAVES;

    if (((PH_MASK >> 0) & 1) && IN(0)) for (int rep_ = 0; rep_ < (REP_PHASE == 0 ? REP_N : 1); ++rep_) { PHASE_BEGIN(); p0_prologue(F); } SEAM(0);

    if (((PH_MASK >> 1) & 1) && IN(1)) for (int rep_ = 0; rep_ < (REP_PHASE == 1 ? REP_N : 1); ++rep_) { PHASE_BEGIN();
        for (int m = gw; m < MP + MS; m += NGW) {
            const float* xr = m < MP ? F.x_p + (size_t)m * DM : F.x_s + (size_t)(m - MP) * DM;
            const float* mr = F.mod + (size_t)(m < MP ? (m >> 11) : 4 + (m - MP)) * 6144;
            h_row(F, xr, mr, F.H + (size_t)m * DM);
        }
    } SEAM(1);

    if (((PH_MASK >> 2) & 1) && IN(2)) for (int rep_ = 0; rep_ < (REP_PHASE == 2 ? REP_N : 1); ++rep_) { PHASE_BEGIN();
        pg8::Gemm g{F.H, F.Wcat, DM, DM, DM, 0}; pg8::StaticOrder S; S.init(MP, LDZ, F.G, (int)blockIdx.x);
        EpiZ E{F.AX, F.AG, F.Qb, F.Kb, F.Vb, F.BG, F.GA, F.GB, F.b_merge, F.ropec, F.ropes, F.out + O_PP, F.out + O_PS};
        pg8::gemm_phase<EpiZ, pg8::StaticOrder, true, true>(F.lds + RING_OFF, g, S, E, F.tid);
        PHASE_BEGIN();
        { pg8::Gemm gs{F.H + (size_t)MP * DM, F.Wcat, DM, DM, DM, 0}; pg8::sgemm_phase<EpiZ>(F.lds + RING_OFF, gs, MP, LDZ / 64, F.vcu, F.G, E, F.tid); }
    } SEAM(2);

    if (((PH_MASK >> 3) & 1) && IN(3)) for (int rep_ = 0; rep_ < (REP_PHASE == 3 ? REP_N : 1); ++rep_) { PHASE_BEGIN();
        for (int r2 = 0; r2 < (REP_PHASE == 30 ? REP_N : 1); ++r2) for (int u = F.vcu; u < 256; u += F.G) ret_ab_unit(F, u);
        PHASE_BEGIN();
        for (int r2 = 0; r2 < (REP_PHASE == 31 ? REP_N : 1); ++r2) { const int gw512 = F.vcu; for (int k = gw512; k < 2048 + 32; k += F.G) { if (k < 2048) pooled_prompt(F, k * 512, k * 512 + 512); else pooled_sample(F, (k - 2048) * 512, (k - 2048) * 512 + 512); } }
        PHASE_BEGIN();
        for (int r2 = 0; r2 < (REP_PHASE == 32 ? REP_N : 1); ++r2) { const int per = (MS * NH + F.G - 1) / F.G; const int f0 = F.vcu * per; if (f0 < MS * NH) ret_sample_items(F, f0, (f0 + per <= MS * NH) ? per : MS * NH - f0); }
    } SEAM(3);

    if (((PH_MASK >> 4) & 1) && IN(4)) for (int rep_ = 0; rep_ < (REP_PHASE == 4 ? REP_N : 1); ++rep_) { PHASE_BEGIN();
        { pg8::Gemm g{F.POOLED, F.PoolW, 256, DPOOL, 256, 512}; pg8::StaticOrder S; S.init(MT, DPOOL, F.G, (int)blockIdx.x);
          EpiPool E{F.YAB, F.AG, F.pool_scale};
          pg8::gemm_phase<EpiPool, pg8::StaticOrder, true, true>(F.lds + RING_OFF, g, S, E, F.tid); }
        PHASE_BEGIN();
        for (int r2 = 0; r2 < (REP_PHASE == 41 ? REP_N : 1); ++r2) for (;;) { const int t = wg_ticket(F, 4 * (rep_ + 2 * r2) + 3, 1); if (t >= 512) break; ret_c_unit(F, t); }
    } SEAM(4);

    if (((PH_MASK >> 5) & 1) && IN(5)) for (int rep_ = 0; rep_ < (REP_PHASE == 5 ? REP_N : 1); ++rep_) { PHASE_BEGIN();
        pg8::Gemm g{F.YAB, F.Wab, LDY, LDY, LDY, 0}; pg8::StaticOrder S; S.init(MP, DM, F.G, (int)blockIdx.x);
        EpiMerge E{F.MB, F.GA, F.GB};
        pg8::gemm_phase<EpiMerge, pg8::StaticOrder, true, true>(F.lds + RING_OFF, g, S, E, F.tid);
        PHASE_BEGIN();
        { pg8::Gemm gs{F.YAB + (size_t)MP * LDY, F.Wab, LDY, LDY, LDY, 0}; pg8::sgemm_phase<EpiMerge>(F.lds + RING_OFF, gs, MP, DM / 64, F.vcu, F.G, E, F.tid); }
    } SEAM(5);

    if (((PH_MASK >> 6) & 1) && IN(6)) for (int rep_ = 0; rep_ < (REP_PHASE == 6 ? REP_N : 1); ++rep_) { PHASE_BEGIN();
        pg8::Gemm g{F.MB, F.Wout, DM, DM, DM, 0}; pg8::StaticOrder S; S.init(MP, DM, F.G, (int)blockIdx.x);
        EpiOut E{F.out, F.ss};
        pg8::gemm_phase<EpiOut, pg8::StaticOrder, true, true>(F.lds + RING_OFF, g, S, E, F.tid);
        PHASE_BEGIN();
        { pg8::Gemm gs{F.MB + (size_t)MP * DM, F.Wout, DM, DM, DM, 0}; pg8::sgemm_phase<EpiOut>(F.lds + RING_OFF, gs, MP, DM / 64, F.vcu, F.G, E, F.tid); }
    } SEAM(6);

    if (((PH_MASK >> 7) & 1) && IN(7)) for (int rep_ = 0; rep_ < (REP_PHASE == 7 ? REP_N : 1); ++rep_) { PHASE_BEGIN();
        for (int m = gw; m < MP + MS; m += NGW) {
            const float* xr = m < MP ? F.x_p + (size_t)m * DM : F.x_s + (size_t)(m - MP) * DM;
            float* yr = F.out + (m < MP ? O_YP + (size_t)m * DM : O_YS + (size_t)(m - MP) * DM);
            const float* gr = F.mod + (size_t)(m < MP ? (m >> 11) : 4 + (m - MP)) * 6144 + 2 * DM;
            final_row(F, xr, yr, F.ss + (size_t)m * 64, gr);
        }
    }
#undef IN
#undef SEAM
}

extern "C" void kernel_launch(void* const* d_in, const int* in_sizes, int n_in, void* d_out, int out_size, void* d_ws, size_t ws_size, hipStream_t stream) {
    static int grid = 0;
    if (grid == 0) {
        if (n_in != 19 || ws_size < WS_END) { fprintf(stderr, "kernel_launch: unexpected inputs (n_in %d, ws %zu)\n", n_in, ws_size); grid = -1; return; }
        int dev = 0, cus = 0, per_cu = 0;
        if (hipGetDevice(&dev) != hipSuccess || hipDeviceGetAttribute(&cus, hipDeviceAttributeMultiprocessorCount, dev) != hipSuccess) { grid = -1; return; }
        if (hipFuncSetAttribute((const void*)hybrid_fwd, hipFuncAttributeMaxDynamicSharedMemorySize, LDS_BYTES) != hipSuccess) { fprintf(stderr, "kernel_launch: hipFuncSetAttribute failed\n"); grid = -1; return; }
        if (hipOccupancyMaxActiveBlocksPerMultiprocessor(&per_cu, (const void*)hybrid_fwd, NWAVES * 64, LDS_BYTES) != hipSuccess || per_cu < 1) { fprintf(stderr, "kernel_launch: occupancy query says %d\n", per_cu); per_cu = 1; }
        (void)hipGetLastError();
        grid = cus;
    }
    if (grid < 0) return;
    (void)hipMemsetAsync((char*)d_ws + WS_CTL, 0, CTL_ZERO_BYTES, stream);
    Args a{};
    for (int i = 0; i < 19; ++i) a.in[i] = (const float*)d_in[i];
    a.out = (float*)d_out; a.ws = (unsigned char*)d_ws;
    if (MK_N_LAUNCHES == 1) { a.ph_lo = 0; a.ph_hi = N_PHASES; hipLaunchKernelGGL(hybrid_fwd, dim3(grid), dim3(NWAVES * 64), LDS_BYTES, stream, a); }
    else for (int p = 0; p < N_PHASES; ++p) { a.ph_lo = p; a.ph_hi = p + 1; hipLaunchKernelGGL(hybrid_fwd, dim3(grid), dim3(NWAVES * 64), LDS_BYTES, stream, a); }
}
```

```cpp
#include <hip/hip_runtime.h>
#include <cstdio>
#include <cstdint>

#ifndef PH_MASK
#define PH_MASK 511
#endif
#ifndef REP_PHASE
#define REP_PHASE -1
#define REP_N 1
#endif
#ifndef MK_N_LAUNCHES
#define MK_N_LAUNCHES 1
#endif

namespace pg8 {
#define PG8_LAS __attribute__((address_space(3)))
typedef unsigned short bf16_t;
typedef short bf16x8 __attribute__((ext_vector_type(8)));
typedef float f32x4 __attribute__((ext_vector_type(4)));
typedef unsigned u32x4 __attribute__((ext_vector_type(4)));
typedef unsigned u32x2 __attribute__((ext_vector_type(2)));
constexpr int BM = 256, BK = 64, HALF = 128, HTB = HALF * BK * 2  , STAGE_BYTES = 8 * HTB, NXCD = 8, WGM = 8;

__host__ __device__ __forceinline__ int lds_byte(int r, int c) { const int st = (r >> 4) * 2 + (c >> 5), rr = r & 15, cc = c & 31, ob = rr * 64 + cc * 2; return st * 1024 + (ob ^ (((ob >> 9) & 1) << 5)); }
__host__ __device__ __forceinline__ void stage_rc(int b, int& R, int& C) { const int st = b / 1024, sb = b % 1024, swz = sb ^ (((sb >> 9) & 1) << 5); R = (st >> 1) * 16 + swz / 64; C = (st & 1) * 32 + (swz % 64) / 2; }
__host__ __device__ __forceinline__ int perm32(int rho) { const int n = rho >> 4, i = rho & 15; return 8 * (i >> 2) + 4 * n + (i & 3); }

struct Unit { int pm, pn; };
struct Gemm { const bf16_t* A; const bf16_t* Bt; int K, lda, ldb, a_pn_bytes; };

struct StaticOrder {
    int nM, nN, nwg, G, c;
    __host__ __device__ void init(int M, int N, int G_, int c_) { nM = M / BM; nN = N / BM; nwg = nM * nN; G = G_; c = c_; }
    __host__ __device__ bool next(int i, Unit& u) const {
        const long L = (long)i * G + c; if (L >= nwg) return false;
        int wgid = (int)L; { const int q = nwg / NXCD, r = nwg % NXCD, xcd = wgid % NXCD, off = wgid / NXCD; wgid = (xcd < r ? xcd * (q + 1) : r * (q + 1) + (xcd - r) * q) + off; }
        const int nig = WGM * nN, gid = wgid / nig, fm = gid * WGM, gsz = (nM - fm) < WGM ? (nM - fm) : WGM;
        u.pm = fm + ((wgid % nig) % gsz); u.pn = (wgid % nig) / gsz; return true;
    }
};

struct RangeOrder : StaticOrder {
    int i0, i1;
    __host__ __device__ bool next(int i, Unit& u) const { return (i + i0 < i1) && StaticOrder::next(i + i0, u); }
};
__device__ __forceinline__ unsigned cvt_pk_bf16(float lo, float hi) { unsigned r; asm volatile("v_cvt_pk_bf16_f32 %0, %1, %2" : "=v"(r) : "v"(lo), "v"(hi)); return r; }
__device__ __forceinline__ float bf_lo(unsigned w) { return __uint_as_float(w << 16); }
__device__ __forceinline__ float bf_hi(unsigned w) { return __uint_as_float(w & 0xffff0000u); }
__device__ __forceinline__ float sigmoidf_(float v) { return __builtin_amdgcn_rcpf(1.0f + __builtin_amdgcn_exp2f(-1.4426950408889634f * v)); }


template <class Epi, class Sched, bool ALIGN_EPI = false, bool SP2 = false>
__device__ __forceinline__ void gemm_phase(PG8_LAS unsigned char* lds, const Gemm g, const Sched& S, const Epi& E, const int tid) {
    const int wid = __builtin_amdgcn_readfirstlane(tid >> 6), lane = tid & 63, wr = wid >> 2, wc = wid & 3, fr = lane & 15, fq = lane >> 4;
    const int K = g.K, nt = K / BK;
    unsigned voffA[2], voffB[2];
#pragma unroll
    for (int i = 0; i < 2; ++i) { int R, C; stage_rc(tid * 16 + i * 8192, R, C); const int Rb = Epi::PERM ? ((R & ~31) + perm32(R & 31)) : R;
        voffA[i] = (unsigned)(R * g.lda + C) * 2u; voffB[i] = (unsigned)(Rb * g.ldb + C) * 2u; }
    const size_t kstep = (size_t)(BK * 2);
    const size_t hstepA = (size_t)HALF * g.lda * 2, hstepB = (size_t)HALF * g.ldb * 2;
    const size_t tstepA = 2 * hstepA, tstepB = 2 * hstepB;
    const unsigned ldsw = (unsigned)wid * 1024u;
    const int aoff = lds_byte(wr * 64 + fr, fq * 8), boff = lds_byte(wc * 32 + fr, fq * 8);
#define PG8_SA(b, h) (((b) * 2 + (h)) * HTB)
#define PG8_SB(b, h) ((4 + (b) * 2 + (h)) * HTB)
#define PG8_STAGE(bufoff, gbase, voff) do { _Pragma("unroll") for (int _i = 0; _i < 2; ++_i) \
        __builtin_amdgcn_global_load_lds((const unsigned*)((const char*)(gbase) + (voff)[_i]), (PG8_LAS unsigned*)(lds + (bufoff) + ldsw + _i * 8192), 16, 0, 0); } while (0)
#define PG8_LDA(dst, b, h) do { _Pragma("unroll") for (int m = 0; m < 4; ++m) _Pragma("unroll") for (int k = 0; k < 2; ++k) dst[m][k] = *(const PG8_LAS bf16x8*)(lds + PG8_SA(b, h) + aoff + m * 2048 + k * 1024); } while (0)
#define PG8_LDB(dst, b, h) do { _Pragma("unroll") for (int n = 0; n < 2; ++n) _Pragma("unroll") for (int k = 0; k < 2; ++k) dst[n][k] = *(const PG8_LAS bf16x8*)(lds + PG8_SB(b, h) + boff + n * 2048 + k * 1024); } while (0)
#define PG8_MMA(ai, bj, At, Bt) do { __builtin_amdgcn_s_setprio(1); _Pragma("unroll") for (int m = 0; m < 4; ++m) _Pragma("unroll") for (int n = 0; n < 2; ++n) _Pragma("unroll") for (int k = 0; k < 2; ++k) \
        acc[ai][bj][m][n] = __builtin_amdgcn_mfma_f32_16x16x32_bf16(Bt[n][k], At[m][k], acc[ai][bj][m][n], 0, 0, 0); __builtin_amdgcn_s_setprio(0); } while (0)
#define PG8_WAIT_V(n) asm volatile("s_waitcnt vmcnt(" #n ")" ::: "memory")
#define PG8_WAIT_L(n) asm volatile("s_waitcnt lgkmcnt(" #n ")" ::: "memory")
#define PG8_BAR __builtin_amdgcn_s_barrier()
#define PG8_SCHED __builtin_amdgcn_sched_barrier(0)
    Unit cur, nxt; int ui = 0;
    if (!S.next(0, cur)) return;
    f32x4 acc[2][2][4][2];
#pragma unroll
    for (int a = 0; a < 2; ++a)
#pragma unroll
        for (int b = 0; b < 2; ++b)
#pragma unroll
            for (int m = 0; m < 4; ++m)
#pragma unroll
                for (int n = 0; n < 2; ++n) acc[a][b][m][n] = (f32x4){0.f, 0.f, 0.f, 0.f};
    bf16x8 At[4][2], B0[2][2], B1[2][2];
    const char* cA = (const char*)g.A + (size_t)cur.pm * tstepA + (size_t)cur.pn * g.a_pn_bytes; const char* cB = (const char*)g.Bt + (size_t)cur.pn * tstepB;
    if constexpr (SP2) {
        PG8_STAGE(PG8_SB(0, 0), cB, voffB); PG8_STAGE(PG8_SB(0, 1), cB + hstepB, voffB); PG8_STAGE(PG8_SA(0, 0), cA, voffA); PG8_STAGE(PG8_SA(0, 1), cA + hstepA, voffA);
        if (wr == 1) PG8_BAR;
        PG8_WAIT_V(2); PG8_BAR;
        PG8_STAGE(PG8_SB(1, 0), cB + kstep, voffB); PG8_STAGE(PG8_SA(1, 0), cA + kstep, voffA); PG8_STAGE(PG8_SB(1, 1), cB + hstepB + kstep, voffB);
        PG8_WAIT_V(6); PG8_BAR;
    } else {
        PG8_STAGE(PG8_SB(0, 0), cB, voffB); PG8_STAGE(PG8_SA(0, 0), cA, voffA); PG8_STAGE(PG8_SB(0, 1), cB + hstepB, voffB); PG8_STAGE(PG8_SA(0, 1), cA + hstepA, voffA);
        if (wr == 1) PG8_BAR;
        PG8_WAIT_V(4); PG8_BAR;
        PG8_STAGE(PG8_SB(1, 0), cB + kstep, voffB); PG8_STAGE(PG8_SA(1, 0), cA + kstep, voffA); PG8_STAGE(PG8_SB(1, 1), cB + hstepB + kstep, voffB);
        PG8_WAIT_V(6); PG8_BAR;
    }
    for (;;) {
        const bool has_next = S.next(ui + 1, nxt);
        const char* nA = has_next ? (const char*)g.A + (size_t)nxt.pm * tstepA + (size_t)nxt.pn * g.a_pn_bytes : cA; const char* nB = has_next ? (const char*)g.Bt + (size_t)nxt.pn * tstepB : cB;
        for (int t = 0; t < nt; t += 2) {
            if constexpr (Epi::MID_T > 0) { if (t == Epi::MID_T) {
#pragma unroll
                for (int ai = 0; ai < 2; ++ai)
#pragma unroll
                    for (int bj = 0; bj < 2; ++bj) E.template mid<4>(acc[ai][bj], cur.pm * BM + ai * HALF + wr * 64 + fr, cur.pn * BM + bj * HALF + wc * 32, fq); } }
            const bool last = (t == nt - 2);
            const char* a1 = cA + (size_t)(t + 1) * kstep;
            const char* a2 = last ? nA : cA + (size_t)(t + 2) * kstep; const char* b2 = last ? nB : cB + (size_t)(t + 2) * kstep;
            const char* a3 = a2 + kstep; const char* b3 = b2 + kstep;
            if constexpr (SP2) {
            PG8_LDB(B0, 0, 0); PG8_LDB(B1, 0, 1); PG8_SCHED; PG8_LDA(At, 0, 0); PG8_STAGE(PG8_SA(1, 1), a1 + hstepA, voffA);
            PG8_WAIT_V(8); PG8_WAIT_L(0); PG8_BAR; PG8_MMA(0, 0, At, B0); PG8_MMA(0, 1, At, B1); PG8_BAR; PG8_SCHED;
            PG8_LDA(At, 0, 1); PG8_STAGE(PG8_SB(0, 0), b2, voffB); PG8_STAGE(PG8_SB(0, 1), b2 + hstepB, voffB); PG8_STAGE(PG8_SA(0, 0), a2, voffA);
            PG8_WAIT_V(8); PG8_WAIT_L(0); PG8_BAR; PG8_MMA(1, 0, At, B0); PG8_MMA(1, 1, At, B1); PG8_BAR; PG8_SCHED;
            PG8_LDB(B0, 1, 0); PG8_LDB(B1, 1, 1); PG8_SCHED; PG8_LDA(At, 1, 0); PG8_STAGE(PG8_SA(0, 1), a2 + hstepA, voffA);
            PG8_WAIT_V(8); PG8_WAIT_L(0); PG8_BAR; PG8_MMA(0, 0, At, B0); PG8_MMA(0, 1, At, B1); PG8_BAR; PG8_SCHED;
            PG8_LDA(At, 1, 1); PG8_STAGE(PG8_SB(1, 0), b3, voffB); PG8_STAGE(PG8_SB(1, 1), b3 + hstepB, voffB); PG8_STAGE(PG8_SA(1, 0), a3, voffA);
            PG8_WAIT_V(8); PG8_WAIT_L(0); PG8_BAR; PG8_MMA(1, 0, At, B0); PG8_MMA(1, 1, At, B1); PG8_BAR; PG8_SCHED;
            } else {
            PG8_LDB(B0, 0, 0); PG8_SCHED; PG8_LDA(At, 0, 0); PG8_STAGE(PG8_SA(1, 1), a1 + hstepA, voffA);
            PG8_WAIT_L(8); PG8_BAR; PG8_WAIT_L(0); PG8_MMA(0, 0, At, B0); PG8_BAR; PG8_SCHED;
            PG8_LDB(B1, 0, 1); PG8_STAGE(PG8_SB(0, 0), b2, voffB);
            PG8_BAR; PG8_WAIT_L(0); PG8_MMA(0, 1, At, B1); PG8_BAR;
            PG8_LDA(At, 0, 1); PG8_STAGE(PG8_SA(0, 0), a2, voffA);
            PG8_BAR; PG8_WAIT_L(0); PG8_MMA(1, 0, At, B0); PG8_BAR; PG8_SCHED;
            PG8_STAGE(PG8_SB(0, 1), b2 + hstepB, voffB);
            PG8_WAIT_V(6); PG8_BAR; PG8_MMA(1, 1, At, B1); PG8_BAR;
            PG8_LDB(B0, 1, 0); PG8_SCHED; PG8_LDA(At, 1, 0); PG8_STAGE(PG8_SA(0, 1), a2 + hstepA, voffA);
            PG8_WAIT_L(8); PG8_BAR; PG8_WAIT_L(0); PG8_MMA(0, 0, At, B0); PG8_BAR; PG8_SCHED;
            PG8_LDB(B1, 1, 1); PG8_STAGE(PG8_SB(1, 0), b3, voffB);
            PG8_BAR; PG8_WAIT_L(0); PG8_MMA(0, 1, At, B1); PG8_BAR;
            PG8_LDA(At, 1, 1); PG8_STAGE(PG8_SA(1, 0), a3, voffA);
            PG8_BAR; PG8_WAIT_L(0); PG8_MMA(1, 0, At, B0); PG8_BAR; PG8_SCHED;
            PG8_STAGE(PG8_SB(1, 1), b3 + hstepB, voffB);
            PG8_WAIT_V(6); PG8_BAR; PG8_MMA(1, 1, At, B1); PG8_BAR;
            }
        }
        if constexpr (ALIGN_EPI) { if (wr == 0) PG8_BAR; }
#pragma unroll
        for (int ai = 0; ai < 2; ++ai)
#pragma unroll
            for (int bj = 0; bj < 2; ++bj) E.template core<4>(acc[ai][bj], cur.pm * BM + ai * HALF + wr * 64 + fr, cur.pn * BM + bj * HALF + wc * 32, fq);
        if (!has_next) break;
#pragma unroll
        for (int a = 0; a < 2; ++a)
#pragma unroll
            for (int b = 0; b < 2; ++b)
#pragma unroll
                for (int m = 0; m < 4; ++m)
#pragma unroll
                    for (int n = 0; n < 2; ++n) acc[a][b][m][n] = (f32x4){0.f, 0.f, 0.f, 0.f};
        cur = nxt; cA = nA; cB = nB; ++ui;
        if constexpr (ALIGN_EPI) { if (wr == 1) PG8_BAR; }
    }
    PG8_WAIT_V(0);
    if constexpr (!ALIGN_EPI) { if (wr == 0) PG8_BAR; }
    PG8_BAR;
#undef PG8_SA
#undef PG8_SB
#undef PG8_STAGE
#undef PG8_LDA
#undef PG8_LDB
#undef PG8_MMA
#undef PG8_WAIT_V
#undef PG8_WAIT_L
#undef PG8_BAR
#undef PG8_SCHED
}

template <class Epi>
__device__ __forceinline__ void sgemm_phase(PG8_LAS unsigned char* lds, const Gemm g, const int row_base, const int n_units, const int first, const int stride, const Epi& E, const int tid) {
    const int wid = __builtin_amdgcn_readfirstlane(tid >> 6), lane = tid & 63, wr = wid >> 1, wc = wid & 1, fr = lane & 15, fq = lane >> 4;
    const int nt = g.K / BK;
    unsigned voffA[2], voffB;
#pragma unroll
    for (int i = 0; i < 2; ++i) { int R, C; stage_rc(tid * 16 + i * 8192, R, C); voffA[i] = (unsigned)(R * g.lda + C) * 2u;
        if (i == 0) { const int Rb = Epi::PERM ? ((R & ~31) + perm32(R & 31)) : R; voffB = (unsigned)(Rb * g.ldb + C) * 2u; } }
    const unsigned ldsw = (unsigned)wid * 1024u;
    const int aoff = lds_byte(wr * 32 + fr, fq * 8), boff = 16384 + lds_byte(wc * 32 + fr, fq * 8);
    constexpr int SLOT = 24576;
#define SG_STAGE(slot, pa, pb) do { \
        __builtin_amdgcn_global_load_lds((const unsigned*)((pa) + voffA[0]), (PG8_LAS unsigned*)(lds + (slot) * SLOT + ldsw), 16, 0, 0); \
        __builtin_amdgcn_global_load_lds((const unsigned*)((pa) + voffA[1]), (PG8_LAS unsigned*)(lds + (slot) * SLOT + ldsw + 8192), 16, 0, 0); \
        __builtin_amdgcn_global_load_lds((const unsigned*)((pb) + voffB), (PG8_LAS unsigned*)(lds + (slot) * SLOT + 16384 + ldsw), 16, 0, 0); } while (0)
    const char* cA = (const char*)g.A;
    for (int ui = first; ui < n_units; ui += stride) {
        const char* cB = (const char*)g.Bt + (size_t)ui * 64 * g.ldb * 2;
        f32x4 acc[2][2];
#pragma unroll
        for (int m = 0; m < 2; ++m)
#pragma unroll
            for (int n = 0; n < 2; ++n) acc[m][n] = (f32x4){0.f, 0.f, 0.f, 0.f};
        SG_STAGE(0, cA, cB); SG_STAGE(1, cA + 128, cB + 128); SG_STAGE(2, cA + 256, cB + 256);
        for (int t = 0; t < nt; ++t) {
            if constexpr (Epi::MID_T > 0) { if (t == Epi::MID_T) E.template mid<2>(acc, row_base + wr * 32 + fr, ui * 64 + wc * 32, fq); }
            asm volatile("s_waitcnt vmcnt(6)" ::: "memory"); __builtin_amdgcn_s_barrier();
            { const int tn = (t + 3 < nt) ? t + 3 : nt - 1; const int sl = (t + 3) & 3; SG_STAGE(sl, cA + (size_t)tn * 128, cB + (size_t)tn * 128); }
            const PG8_LAS unsigned char* sp = lds + (t & 3) * SLOT;
            bf16x8 At[2][2], Bt[2][2];
#pragma unroll
            for (int m = 0; m < 2; ++m)
#pragma unroll
                for (int k = 0; k < 2; ++k) At[m][k] = *(const PG8_LAS bf16x8*)(sp + aoff + m * 2048 + k * 1024);
#pragma unroll
            for (int n = 0; n < 2; ++n)
#pragma unroll
                for (int k = 0; k < 2; ++k) Bt[n][k] = *(const PG8_LAS bf16x8*)(sp + boff + n * 2048 + k * 1024);
            asm volatile("s_waitcnt lgkmcnt(0)" ::: "memory");
            __builtin_amdgcn_sched_barrier(0);
#pragma unroll
            for (int m = 0; m < 2; ++m)
#pragma unroll
                for (int n = 0; n < 2; ++n)
#pragma unroll
                    for (int k = 0; k < 2; ++k) acc[m][n] = __builtin_amdgcn_mfma_f32_16x16x32_bf16(Bt[n][k], At[m][k], acc[m][n], 0, 0, 0);
        }
        asm volatile("s_waitcnt vmcnt(0)" ::: "memory"); __builtin_amdgcn_s_barrier();
        E.template core<2>(acc, row_base + wr * 32 + fr, ui * 64 + wc * 32, fq);
    }
#undef SG_STAGE
}
}

constexpr int NWAVES = 8;
constexpr int DM = 2048, MP = 8192, MS = 128, SEQ = 2048, MT = 8448;
constexpr int DPOOL = 1024, NH = 8, DK = 128, DV = 256, DIN = 8192, LDZ = 12288, LDY = 3072;
constexpr int ZC_AX = 0, ZC_AG = 1024, ZC_Q = 2048, ZC_K = 3072, ZC_V = 4096, ZC_BG = 6144, ZC_GA = 8192, ZC_GB = 10240;
constexpr float EPS = 1e-6f;
__host__ __device__ __forceinline__ int hm_row(int r, int h) { return r < MP ? (((r >> 11) * NH + h) * SEQ + (r & (SEQ - 1))) : (MP * NH + (r - MP) * NH + h); }
constexpr int PAST = 16384;
constexpr size_t O_YP = 0, O_YS = 16777216, O_PP = 17039360, O_RP = 17100800, O_PS = 18149376, O_RS = 20115456;

constexpr size_t MiB = 1u << 20;
constexpr size_t WS_CTL = 0, CTL_ZERO_BYTES = 1 * MiB;
constexpr size_t WS_ROPE = 1 * MiB;
constexpr size_t WS_MOD = 3 * MiB;
constexpr size_t WS_SS = 7 * MiB;
constexpr size_t WS_WCAT = 16 * MiB;
constexpr size_t WS_WAB = 64 * MiB;
constexpr size_t WS_WOUT = 76 * MiB;
constexpr size_t WS_POOLW = 84 * MiB;
constexpr size_t WS_H = 96 * MiB;
constexpr size_t WS_AX = 130 * MiB, WS_AG = 147 * MiB, WS_Q = 164 * MiB, WS_K = 181 * MiB, WS_V = 198 * MiB, WS_BG = 231 * MiB, WS_GA = 264 * MiB, WS_GB = 297 * MiB;
constexpr size_t WS_Z = WS_AX;
constexpr size_t WS_YAB = 330 * MiB;
constexpr size_t WS_POOLED = 380 * MiB;
constexpr size_t WS_SN = 397 * MiB;
constexpr size_t WS_MB = 430 * MiB;
constexpr size_t WS_END = 464 * MiB;
constexpr int CW_BAR = 4096;

constexpr int RING_OFF = 0, RING_BYTES = 131072;
constexpr int LDSCTL_OFF = RING_BYTES, MISC_OFF = LDSCTL_OFF + 320;
constexpr int STAT_OFF = RING_BYTES + 1024;
constexpr int LDS_BYTES = 147456;

#define GAS __attribute__((address_space(1)))
#define LAS __attribute__((address_space(3)))
typedef unsigned short bf16;
typedef unsigned v4u __attribute__((ext_vector_type(4)));
typedef unsigned v2u __attribute__((ext_vector_type(2)));
typedef float f32x4 __attribute__((ext_vector_type(4)));
typedef float f32x16 __attribute__((ext_vector_type(16)));
typedef short bf16x8 __attribute__((ext_vector_type(8)));
typedef short s16x4 __attribute__((ext_vector_type(4)));
typedef GAS unsigned gu32;
#define RLX_AGENT __ATOMIC_RELAXED, __HIP_MEMORY_SCOPE_AGENT
#define LDS_WAIT() asm volatile("s_waitcnt lgkmcnt(0)" ::: "memory")
#define VM_WAIT() asm volatile("s_waitcnt vmcnt(0)" ::: "memory")
__device__ __forceinline__ unsigned f2bf(float f) { unsigned u = __builtin_bit_cast(unsigned, f); return (u + 0x7fffu + ((u >> 16) & 1u)) >> 16; }
__device__ __forceinline__ unsigned pk2(float lo, float hi) { return f2bf(lo) | (f2bf(hi) << 16); }
__device__ __forceinline__ float bflo(unsigned w) { return __uint_as_float(w << 16); }
__device__ __forceinline__ float bfhi(unsigned w) { return __uint_as_float(w & 0xffff0000u); }
__device__ __forceinline__ float bf1(bf16 b) { return __uint_as_float((unsigned)b << 16); }
__device__ __forceinline__ float silu_(float v) { return v * __builtin_amdgcn_rcpf(1.0f + __builtin_amdgcn_exp2f(-1.4426950408889634f * v)); }
__device__ __forceinline__ float wave_sum(float v) {
#pragma unroll
    for (int o = 1; o < 64; o <<= 1) v += __shfl_xor(v, o);
    return v;
}
__device__ __forceinline__ float lg2gamma(int h) {
    const float t[8] = {-0.04580368961312479f, -0.02272007650008353f, -0.011315313227834146f, -0.005646563141142063f, -0.0028205190623786626f, -0.0014095702546713536f, -0.0007046129765893727f, -0.0003522634716290214f};
    float r = t[0];
#pragma unroll
    for (int i = 1; i < 8; ++i) r = (h == i) ? t[i] : r;
    return r;
}

__device__ __forceinline__ int fresh_lane() { unsigned m_ = ~0u; asm volatile("" : "+s"(m_)); return (int)__builtin_amdgcn_mbcnt_hi(m_, __builtin_amdgcn_mbcnt_lo(m_, 0u)); }
#define XB_TMO      128
#define XB_XCNT(j)  (256  + 64 * (j))
#define XB_XSUB(j)  (1280 + 64 * (j))
#define XB_XGEN(j)  (2304 + 64 * (j))
#define XB_TOP      3328
#define XB_TOPGEN   3392
#define XCD_BAR_WORDS 3456
#define XB_SPIN_CAP (1u << 18)
__device__ __forceinline__ unsigned xb_ld(unsigned* p)              { return __hip_atomic_load(p, __ATOMIC_RELAXED, __HIP_MEMORY_SCOPE_AGENT); }
__device__ __forceinline__ unsigned xb_add(unsigned* p, unsigned v) { return __hip_atomic_fetch_add(p, v, __ATOMIC_RELAXED, __HIP_MEMORY_SCOPE_AGENT); }
__device__ __forceinline__ unsigned xb_xcc_id() { return (unsigned)__builtin_amdgcn_s_getreg((3 << 11) | 20) & 0xFu; }
#define XB_SPIN(cond, bar) do { unsigned _sp = 0; while (cond) { __builtin_amdgcn_s_sleep(1); \
    if ((++_sp & 255u) == 0u) { if (xb_ld(&(bar)[XB_TMO])) break; if (_sp > XB_SPIN_CAP) { atomicAdd(&(bar)[XB_TMO], 1u); break; } } } } while (0)
struct XcdBarrier { unsigned* bar; unsigned x; volatile LAS unsigned* st; int wave; };
__device__ __forceinline__ XcdBarrier xcd_barrier_post(unsigned* bar, volatile LAS unsigned* st, int wave) {
    XcdBarrier b; b.bar = bar; b.x = xb_xcc_id(); b.st = st; b.wave = wave;
    if (wave == 0 && fresh_lane() == 0) (void)xb_add(&bar[XB_XCNT(b.x)], 1u);
    return b;
}
__device__ __forceinline__ void xcd_barrier_complete(unsigned* bar, unsigned x, unsigned& nloc, unsigned& nx) {
    const unsigned G = gridDim.x * gridDim.y * gridDim.z;
    unsigned sum, cnt, mine, sp = 0u;
    for (;;) {
        sum = 0u; cnt = 0u; mine = 0u;
#pragma unroll
        for (unsigned j = 0; j < 16; ++j) { const unsigned c = xb_ld(&bar[XB_XCNT(j)]); sum += c; cnt += (c > 0u) ? 1u : 0u; mine = (j == x) ? c : mine; }
        if (sum == G) break;
        __builtin_amdgcn_s_sleep(1);
        if ((++sp & 255u) == 0u) { if (xb_ld(&bar[XB_TMO])) break; if (sp > XB_SPIN_CAP) { atomicAdd(&bar[XB_TMO], 1u); break; } }
    }
    nloc = mine > 0u ? mine : 1u; nx = cnt > 0u ? cnt : 1u;
}
__device__ __forceinline__ void xcd_barrier(const XcdBarrier& b) {
    asm volatile("s_waitcnt vmcnt(0)" ::: "memory");
    __syncthreads();
    if (b.wave == 0 && fresh_lane() == 0) {
        unsigned* bar = b.bar;
        __builtin_amdgcn_s_waitcnt(0);
        unsigned nloc = b.st[0], nx = b.st[1];
        if (nloc == 0u) { xcd_barrier_complete(bar, b.x, nloc, nx); b.st[0] = nloc; b.st[1] = nx; }
        const unsigned old = xb_add(&bar[XB_XSUB(b.x)], 1u);
        const unsigned gen = old / nloc;
        if (old + 1u == (gen + 1u) * nloc) {
            __builtin_amdgcn_fence(__ATOMIC_RELEASE, "agent");
            asm volatile("s_waitcnt vmcnt(0)" ::: "memory");
            const unsigned og = xb_add(&bar[XB_TOP], 1u);
            const unsigned tg = og / nx;
            if (og + 1u == (tg + 1u) * nx) xb_add(&bar[XB_TOPGEN], 1u);
            else XB_SPIN(xb_ld(&bar[XB_TOPGEN]) == tg, bar);
            __builtin_amdgcn_fence(__ATOMIC_ACQUIRE, "agent");
            xb_add(&bar[XB_XGEN(b.x)], 1u);
            asm volatile("s_waitcnt vmcnt(0)" ::: "memory");
        } else {
            XB_SPIN(xb_ld(&bar[XB_XGEN(b.x)]) == gen, bar);
            __builtin_amdgcn_fence(__ATOMIC_ACQUIRE, "agent");
            asm volatile("s_waitcnt vmcnt(0)" ::: "memory");
        }
    }
    __syncthreads();
}

struct Frame {
    LAS unsigned char* lds;
    volatile LAS unsigned* MISC;
    gu32* ctl;
    int tid, lane, wave;
    int vcu, G;
    const float *x_p, *x_s, *st_pool, *st_ret, *c_p, *c_s, *ada_w, *ada_b, *g_pre, *g_post, *w_in, *pool_w, *pool_scale, *gn_g, *w_a, *w_b, *w_merge, *b_merge, *w_out;
    float* out;
    float *ropec, *ropes, *mod, *ss;
    bf16 *Wcat, *Wab, *Wout, *PoolW, *H, *AX, *AG, *Qb, *Kb, *Vb, *BG, *GA, *GB, *YAB, *POOLED, *SN, *MB;
};

struct EpiZ {
    static constexpr bool PERM = true; static constexpr int MID_T = 0;
    bf16 *AX, *AG, *Qb, *Kb, *Vb, *BG, *GA, *GB; const float* bmerge; const float* ropec; const float* ropes; float* out_pp; float* out_ps;
    template <int NM> __device__ __forceinline__ void core(const pg8::f32x4 (&a)[NM][2], int row0, int cs, int fq) const {
        using namespace pg8;
        if (cs >= ZC_Q && cs < ZC_V) {
            const float ksc = (cs >= ZC_K) ? 0.08838834764831845f : 1.0f;
            const int j0 = 16 * ((cs & 127) >> 5) + 4 * fq, hd = (cs >> 7) & 7; bf16* qk = (cs >= ZC_K) ? Kb : Qb;
#pragma unroll
            for (int m = 0; m < NM; ++m) {
                const int row = row0 + m * 16; const int pos = row < MP ? (row & (SEQ - 1)) : SEQ;
                const f32x4 c4 = *(const f32x4*)(ropec + pos * 64 + j0), s4 = *(const f32x4*)(ropes + pos * 64 + j0);
                bf16* rowp = qk + (size_t)hm_row(row, hd) * DK + j0;
                const f32x4 v0 = a[m][0], v1 = a[m][1];
                const f32x4 o1 = (v0 * c4 - v1 * s4) * ksc, o2 = (v0 * s4 + v1 * c4) * ksc;
                u32x2 w1, w2; w1.x = cvt_pk_bf16(o1[0], o1[1]); w1.y = cvt_pk_bf16(o1[2], o1[3]); w2.x = cvt_pk_bf16(o2[0], o2[1]); w2.y = cvt_pk_bf16(o2[2], o2[3]);
                *(u32x2*)rowp = w1; *(u32x2*)(rowp + 64) = w2;
            }
            return;
        }
        const int act = (cs >= ZC_GA) ? 2 : (((cs >= ZC_AG && cs < ZC_Q) || (cs >= ZC_BG)) ? 1 : 0);
        const int col = cs + 8 * fq;
        f32x4 bv[2];
#pragma unroll
        for (int n = 0; n < 2; ++n) bv[n] = (act == 2) ? *(const f32x4*)(bmerge + (col - ZC_GA) + 4 * n) : (f32x4){0.f, 0.f, 0.f, 0.f};
#pragma unroll
        for (int m = 0; m < NM; ++m) {
            const int row = row0 + m * 16;
            f32x4 v0 = a[m][0] + bv[0], v1 = a[m][1] + bv[1];
            if (act == 1) {
#pragma unroll
                for (int e = 0; e < 4; ++e) { v0[e] = silu_(v0[e]); v1[e] = silu_(v1[e]); }
            } else if (act == 2) {
#pragma unroll
                for (int e = 0; e < 4; ++e) { v0[e] = sigmoidf_(v0[e]); v1[e] = sigmoidf_(v1[e]); }
            }
            u32x4 w; w.x = cvt_pk_bf16(v0[0], v0[1]); w.y = cvt_pk_bf16(v0[2], v0[3]); w.z = cvt_pk_bf16(v1[0], v1[1]); w.w = cvt_pk_bf16(v1[2], v1[3]);
            bf16* dst = (cs < ZC_AG) ? AX + (size_t)row * DPOOL + col : (cs < ZC_Q) ? AG + (size_t)row * DPOOL + (col - ZC_AG) : (cs < ZC_BG) ? Vb + (size_t)hm_row(row, (cs - ZC_V) >> 8) * DV + (col & 255)
                      : (cs < ZC_GA) ? BG + (size_t)hm_row(row, (cs - ZC_BG) >> 8) * DV + (col & 255) : (cs < ZC_GB) ? GA + (size_t)row * DM + (col - ZC_GA) : GB + (size_t)row * DM + (col - ZC_GB);
            *(u32x4*)dst = w;
            if (cs < ZC_AG) {
                if (row < MP) { const int t = row & (SEQ - 1); if (t >= SEQ - 15) { float* o = out_pp + ((size_t)((row >> 11) * 15 + (t - (SEQ - 15)))) * DPOOL + col; *(f32x4*)o = v0; *(f32x4*)(o + 4) = v1; } }
                else if (row < MP + MS) { float* o = out_ps + ((size_t)((row - MP) * 15 + 14)) * DPOOL + col; *(f32x4*)o = v0; *(f32x4*)(o + 4) = v1; }
            }
        }
    }
    template <int NM> __device__ __forceinline__ void mid(pg8::f32x4 (&)[NM][2], int, int, int) const {}
};
struct EpiPool {
    static constexpr bool PERM = true; static constexpr int MID_T = 0;
    bf16* Y; const bf16* AG; const float* pscale;
    template <int NM> __device__ __forceinline__ void core(const pg8::f32x4 (&a)[NM][2], int row0, int cs, int fq) const {
        using namespace pg8;
        const int col = cs + 8 * fq;
        const f32x4 ps0 = *(const f32x4*)(pscale + col), ps1 = *(const f32x4*)(pscale + col + 4);
#pragma unroll
        for (int m = 0; m < NM; ++m) {
            const int row = row0 + m * 16;
            const u32x4 g = *(const u32x4*)(AG + (size_t)row * DPOOL + col);
            f32x4 v0 = a[m][0] * ps0, v1 = a[m][1] * ps1;
            v0[0] *= bf_lo(g.x); v0[1] *= bf_hi(g.x); v0[2] *= bf_lo(g.y); v0[3] *= bf_hi(g.y);
            v1[0] *= bf_lo(g.z); v1[1] *= bf_hi(g.z); v1[2] *= bf_lo(g.w); v1[3] *= bf_hi(g.w);
            u32x4 w; w.x = cvt_pk_bf16(v0[0], v0[1]); w.y = cvt_pk_bf16(v0[2], v0[3]); w.z = cvt_pk_bf16(v1[0], v1[1]); w.w = cvt_pk_bf16(v1[2], v1[3]);
            *(u32x4*)(Y + (size_t)row * LDY + col) = w;
        }
    }
    template <int NM> __device__ __forceinline__ void mid(pg8::f32x4 (&)[NM][2], int, int, int) const {}
};
struct EpiMerge {
    static constexpr bool PERM = true; static constexpr int MID_T = 16;
    bf16* O; const bf16* GA; const bf16* GB;
    template <int NM> __device__ __forceinline__ void mid(pg8::f32x4 (&a)[NM][2], int row0, int cs, int fq) const {
        using namespace pg8;
        const size_t zoff = (size_t)row0 * DM + cs + 8 * fq; const bf16* za = GA + zoff; const bf16* zb = GB + zoff;
        asm volatile("" : "+v"(za), "+v"(zb));
#pragma unroll
        for (int m = 0; m < NM; ++m) {
            const u32x4 ga = *(const u32x4*)(za + (size_t)(m * 16) * DM), gb = *(const u32x4*)(zb + (size_t)(m * 16) * DM);
            f32x4& v0 = a[m][0]; f32x4& v1 = a[m][1];
            v0[0] *= bf_lo(ga.x) * __builtin_amdgcn_rcpf(bf_lo(gb.x)); v0[1] *= bf_hi(ga.x) * __builtin_amdgcn_rcpf(bf_hi(gb.x)); v0[2] *= bf_lo(ga.y) * __builtin_amdgcn_rcpf(bf_lo(gb.y)); v0[3] *= bf_hi(ga.y) * __builtin_amdgcn_rcpf(bf_hi(gb.y));
            v1[0] *= bf_lo(ga.z) * __builtin_amdgcn_rcpf(bf_lo(gb.z)); v1[1] *= bf_hi(ga.z) * __builtin_amdgcn_rcpf(bf_hi(gb.z)); v1[2] *= bf_lo(ga.w) * __builtin_amdgcn_rcpf(bf_lo(gb.w)); v1[3] *= bf_hi(ga.w) * __builtin_amdgcn_rcpf(bf_hi(gb.w));
            if (m & 1) asm volatile("" ::: "memory");
        }
    }
    template <int NM> __device__ __forceinline__ void core(const pg8::f32x4 (&a)[NM][2], int row0, int cs, int fq) const {
        using namespace pg8;
        const int col = cs + 8 * fq;
#pragma unroll
        for (int m = 0; m < NM; ++m) {
            const int row = row0 + m * 16;
            const u32x4 g = *(const u32x4*)(GB + (size_t)row * DM + col);
            f32x4 v0 = a[m][0], v1 = a[m][1];
            v0[0] *= bf_lo(g.x); v0[1] *= bf_hi(g.x); v0[2] *= bf_lo(g.y); v0[3] *= bf_hi(g.y);
            v1[0] *= bf_lo(g.z); v1[1] *= bf_hi(g.z); v1[2] *= bf_lo(g.w); v1[3] *= bf_hi(g.w);
            u32x4 w; w.x = cvt_pk_bf16(v0[0], v0[1]); w.y = cvt_pk_bf16(v0[2], v0[3]); w.z = cvt_pk_bf16(v1[0], v1[1]); w.w = cvt_pk_bf16(v1[2], v1[3]);
            *(u32x4*)(O + (size_t)row * DM + col) = w;
        }
    }
};
struct EpiOut {
    static constexpr bool PERM = false; static constexpr int MID_T = 0;
    float* out; float* ss;
    template <int NM> __device__ __forceinline__ void core(const pg8::f32x4 (&a)[NM][2], int row0, int cs, int fq) const {
        using namespace pg8;
#pragma unroll
        for (int m = 0; m < NM; ++m) {
            const int row = row0 + m * 16;
            float s = 0.f;
#pragma unroll
            for (int n = 0; n < 2; ++n) { const f32x4 v = a[m][n]; s += (v[0] * v[0] + v[1] * v[1]) + (v[2] * v[2] + v[3] * v[3]); }
            s += __shfl_xor(s, 16); s += __shfl_xor(s, 32);
            if (fq == 0) ss[(size_t)row * 64 + (cs >> 5)] = s;
            if (row < MP + MS) {
                float* rowp = out + (row < MP ? O_YP + (size_t)row * DM : O_YS + (size_t)(row - MP) * DM) + cs + 4 * fq;
#pragma unroll
                for (int n = 0; n < 2; ++n) *(f32x4*)(rowp + n * 16) = a[m][n];
            }
        }
    }
    template <int NM> __device__ __forceinline__ void mid(pg8::f32x4 (&)[NM][2], int, int, int) const {}
};

__device__ __forceinline__ int rot_row(int n) { const int L = n & 127, hf = L >> 6, j = L & 63; return (n & ~127) + 32 * (j >> 4) + 8 * ((j >> 2) & 3) + 4 * hf + (j & 3); }
__device__ __forceinline__ void p0_transpose_item(const float* W, int N, bf16* WT, int ldw, int row_off, int koff, int rot_lo, int rot_hi, LAS float* scr, int item, int lane) {
    const int nblk = N / 32, kb = item / nblk, nb = item % nblk, k0 = 64 * kb, n0 = 32 * nb;
#pragma unroll 8
    for (int i = 0; i < 32; ++i) { const int kk = 2 * i + (lane >> 5); scr[kk * 33 + (lane & 31)] = __builtin_nontemporal_load(W + (size_t)(k0 + kk) * N + n0 + (lane & 31)); }
    LDS_WAIT(); asm volatile("" ::: "memory");
    const int c = lane & 7;
#pragma unroll
    for (int j = 0; j < 4; ++j) { const int n = (lane >> 3) + 8 * j; const LAS float* s = scr + (8 * c) * 33 + n;
        v4u o; o.x = pk2(s[0 * 33], s[1 * 33]); o.y = pk2(s[2 * 33], s[3 * 33]); o.z = pk2(s[4 * 33], s[5 * 33]); o.w = pk2(s[6 * 33], s[7 * 33]);
        int nn = n0 + n; if (nn >= rot_lo && nn < rot_hi) nn = rot_row(nn);
        *(GAS v4u*)(WT + (size_t)(row_off + nn) * ldw + koff + k0 + 8 * c) = o; }
    LDS_WAIT(); asm volatile("" ::: "memory");
}
__device__ __forceinline__ void p0_mod_item(Frame& F, int strip) {
    const int n0 = strip * 32, lane = F.lane, fr = lane & 15, fq = lane >> 4, wave = F.wave;
    f32x4 acc[9][2];
#pragma unroll
    for (int a = 0; a < 9; ++a) { acc[a][0] = (f32x4){0.f, 0.f, 0.f, 0.f}; acc[a][1] = (f32x4){0.f, 0.f, 0.f, 0.f}; }
    for (int ks = 0; ks < 8; ++ks) {
        const int k0 = wave * 256 + ks * 32 + 8 * fq;
        bf16x8 bfr[2];
#pragma unroll
        for (int nt = 0; nt < 2; ++nt) {
            float w[8];
#pragma unroll
            for (int j = 0; j < 8; ++j) w[j] = __builtin_nontemporal_load(F.ada_w + (size_t)(k0 + j) * 6144 + n0 + 16 * nt + fr);
            v4u p; p.x = pk2(w[0], w[1]); p.y = pk2(w[2], w[3]); p.z = pk2(w[4], w[5]); p.w = pk2(w[6], w[7]);
            bfr[nt] = __builtin_bit_cast(bf16x8, p);
        }
#pragma unroll
        for (int mt = 0; mt < 9; ++mt) {
            const int row = 16 * mt + fr;
            f32x4 a0 = (f32x4){0.f, 0.f, 0.f, 0.f}, a1 = a0;
            if (row < 132) { const float* cp = (row < 4 ? F.c_p + (size_t)row * DM : F.c_s + (size_t)(row - 4) * DM) + k0; a0 = *(const f32x4*)cp; a1 = *(const f32x4*)(cp + 4); }
            v4u p; p.x = pk2(silu_(a0[0]), silu_(a0[1])); p.y = pk2(silu_(a0[2]), silu_(a0[3])); p.z = pk2(silu_(a1[0]), silu_(a1[1])); p.w = pk2(silu_(a1[2]), silu_(a1[3]));
            const bf16x8 afr = __builtin_bit_cast(bf16x8, p);
            acc[mt][0] = __builtin_amdgcn_mfma_f32_16x16x32_bf16(afr, bfr[0], acc[mt][0], 0, 0, 0);
            acc[mt][1] = __builtin_amdgcn_mfma_f32_16x16x32_bf16(afr, bfr[1], acc[mt][1], 0, 0, 0);
        }
    }
    LAS float* red = (LAS float*)F.lds;
    for (int w = 0; w < 8; ++w) {
        if (wave == w) {
#pragma unroll
            for (int mt = 0; mt < 9; ++mt)
#pragma unroll
                for (int nt = 0; nt < 2; ++nt)
#pragma unroll
                    for (int r = 0; r < 4; ++r) { const int idx = (16 * mt + 4 * fq + r) * 32 + 16 * nt + fr; if (w == 0) red[idx] = acc[mt][nt][r]; else red[idx] += acc[mt][nt][r]; }
        }
        __syncthreads();
    }
    for (int i = F.tid; i < 132 * 32; i += NWAVES * 64) { const int r = i >> 5, cc = i & 31; F.mod[(size_t)r * 6144 + n0 + cc] = red[i] + F.ada_b[n0 + cc]; }
    __syncthreads();
}
__device__ __forceinline__ void rope_entry(int prow, int i, float* cosT, float* sinT) {
    double th = 1.0, bs = 0.8659643233600653;
    for (int e = i; e; e >>= 1) { if (e & 1) th *= bs; bs *= bs; }
    const double t2 = th * th; double c = 1.0, s = th, tc = 1.0, ts = th;
#pragma unroll 1
    for (int n = 1; n <= 12; ++n) { tc *= -t2 / (double)((2 * n - 1) * (2 * n)); c += tc; ts *= -t2 / (double)((2 * n) * (2 * n + 1)); s += ts; }
    const int pos = prow < SEQ ? prow : PAST;
    double rc = 1.0, rs = 0.0, bc = c, bn = s;
    for (int e = pos; e; e >>= 1) { if (e & 1) { const double t = rc * bc - rs * bn; rs = rc * bn + rs * bc; rc = t; } const double t = bc * bc - bn * bn; bn = 2.0 * bc * bn; bc = t; }
    cosT[prow * 64 + i] = (float)rc; sinT[prow * 64 + i] = (float)rs;
}
__device__ __forceinline__ void p0_prologue(Frame& F) {
    if (F.vcu < 192) for (int s = F.vcu; s < 192; s += F.G) p0_mod_item(F, s);
    LAS float* scr = (LAS float*)(F.lds + RING_OFF + F.wave * 16384);
    const int gw = F.vcu * NWAVES + F.wave, NGW = F.G * NWAVES;
    constexpr int I_IN = 32 * 256, I_MG = 32 * 128, I_A = 16 * 64, I_B = 32 * 64, I_O = 32 * 64, I_P = 4 * 8;
    constexpr int NITEMS = I_IN + I_MG + I_A + I_B + I_O + 4 * I_P;
    for (int it = gw; it < NITEMS; it += NGW) {
        int r = it;
        if (r < I_IN) { p0_transpose_item(F.w_in, DIN, F.Wcat, DM, 0, 0, ZC_Q, ZC_V, scr, r, F.lane); continue; } r -= I_IN;
        if (r < I_MG) { p0_transpose_item(F.w_merge, 4096, F.Wcat, DM, DIN, 0, 0, 0, scr, r, F.lane); continue; } r -= I_MG;
        if (r < I_A) { p0_transpose_item(F.w_a, DM, F.Wab, LDY, 0, 0, 0, 0, scr, r, F.lane); continue; } r -= I_A;
        if (r < I_B) { p0_transpose_item(F.w_b, DM, F.Wab, LDY, 0, 1024, 0, 0, scr, r, F.lane); continue; } r -= I_B;
        if (r < I_O) { p0_transpose_item(F.w_out, DM, F.Wout, DM, 0, 0, 0, 0, scr, r, F.lane); continue; } r -= I_O;
        { const int g = r / I_P; p0_transpose_item(F.pool_w + (size_t)g * 65536, 256, F.PoolW, 256, g * 256, 0, 0, 0, scr, r % I_P, F.lane); }
    }
    const int gt = F.vcu * (NWAVES * 64) + F.tid, NGT = F.G * NWAVES * 64;
    for (int e = gt; e < 2049 * 64; e += NGT) rope_entry(e >> 6, e & 63, F.ropec, F.ropes);
}

__device__ __forceinline__ void h_row(Frame& F, const float* xrow, const float* modrow, bf16* orow) {
    const GAS f32x4* xr = (const GAS f32x4*)xrow + F.lane;
    f32x4 v[8]; float s = 0.f;
#pragma unroll
    for (int j = 0; j < 8; ++j) { v[j] = xr[64 * j]; s += (v[j].x * v[j].x + v[j].y * v[j].y) + (v[j].z * v[j].z + v[j].w * v[j].w); }
    const float rstd = 1.0f / sqrtf(wave_sum(s) * (1.0f / DM) + EPS);
    GAS v2u* o8 = (GAS v2u*)orow + F.lane;
#pragma unroll
    for (int j = 0; j < 8; ++j) {
        const int col = 4 * F.lane + 256 * j;
        const f32x4 g = *(const f32x4*)(F.g_pre + col), sh = *(const f32x4*)(modrow + col), sc = *(const f32x4*)(modrow + DM + col);
        const f32x4 o = v[j] * rstd * g * (sc + 1.0f) + sh;
        v2u w; w.x = pk2(o.x, o.y); w.y = pk2(o.z, o.w); o8[64 * j] = w;
    }
}

__device__ __forceinline__ unsigned off_a(unsigned row, unsigned ch) { return 2048u * (row >> 3) + 512u * (ch >> 2) + 64u * (row & 7) + 16u * ((ch & 3) ^ ((row >> 2) & 3)); }
struct RowA { unsigned e, d; };
struct TrA { unsigned t0, t1; };
__device__ __forceinline__ RowA row_addr(unsigned lane) { RowA r; r.e = off_a(lane & 31, lane >> 5); r.d = off_a(lane & 31, 2 + (lane >> 5)) - r.e; return r; }
__device__ __forceinline__ TrA tr_addr(unsigned lane) { const unsigned h = lane >> 5, blk = (lane >> 4) & 1, q = (lane & 15) >> 2, p = lane & 3; TrA t;
    t.t0 = off_a(8 * h + q, 2 * blk + (p >> 1)) + 8 * (p & 1); t.t1 = off_a(8 * h + 4 + q, 2 * blk + (p >> 1)) + 8 * (p & 1); return t; }
__device__ __forceinline__ bf16x8 frag_row(const LAS unsigned char* img, const RowA& ra, int s) { return *(const LAS bf16x8*)(img + (ra.e + (unsigned)(s & 1) * ra.d + 512u * (unsigned)(s >> 1))); }
__device__ __forceinline__ bf16x8 frag_tr(const LAS unsigned char* img, const TrA& ta, int c, int ks) {
    const s16x4 lo = __builtin_bit_cast(s16x4, __builtin_amdgcn_ds_read_tr16_b64_v4i16((LAS s16x4*)(img + ta.t0 + 512 * c + 4096 * ks)));
    const s16x4 hi = __builtin_bit_cast(s16x4, __builtin_amdgcn_ds_read_tr16_b64_v4i16((LAS s16x4*)(img + ta.t1 + 512 * c + 4096 * ks)));
    return __builtin_shufflevector(lo, hi, 0, 1, 2, 3, 4, 5, 6, 7);
}
#define MFMA32(a, b, c) __builtin_amdgcn_mfma_f32_32x32x16_bf16((a), (b), (c), 0, 0, 0)
__device__ __forceinline__ int crow(int reg, int h) { return (reg & 3) + 8 * (reg >> 2) + 4 * h; }

__device__ __forceinline__ void ret_ab_unit(Frame& F, int unit) {
    const int bh = unit >> 3, dh = (unit >> 2) & 1, dq = unit & 3, b = bh >> 3, h = bh & 7, lane = fresh_lane(), wave = F.wave, hh = lane >> 5, tid_ = wave * 64 + lane;
    const float lg = lg2gamma(h);
    const float cdec = __builtin_amdgcn_exp2f(128.0f * lg);
    const int di = wave & 1, dj = (wave >> 1) & 1;
    const TrA ta = tr_addr(lane);
    f32x16 acc;
#pragma unroll
    for (int e = 0; e < 16; ++e) acc[e] = 0.f;
    const bf16* Kh = F.Kb + (size_t)bh * SEQ * DK + dh * 64; const bf16* Vh = F.Vb + (size_t)bh * SEQ * DV + dq * 64;
    v4u r0[4], r1[4];
#define AB_LOAD(c, R) do { _Pragma("unroll") for (int i = 0; i < 2; ++i) { const int n = tid_ + 512 * i, row = n >> 3, ch = n & 7; const size_t tr_ = (size_t)((c) * 128 + row); \
        R[i] = *(const GAS v4u*)(Kh + tr_ * DK + ch * 8); R[2 + i] = *(const GAS v4u*)(Vh + tr_ * DV + ch * 8); } } while (0)
#define AB_STORE(buf, R) do { _Pragma("unroll") for (int i = 0; i < 2; ++i) { const int n = tid_ + 512 * i, row = n >> 3, ch = n & 7; \
        const float d = __builtin_amdgcn_exp2f((float)(127 - row) * lg); v4u kk = R[i]; \
        kk.x = pk2(bflo(kk.x) * d, bfhi(kk.x) * d); kk.y = pk2(bflo(kk.y) * d, bfhi(kk.y) * d); kk.z = pk2(bflo(kk.z) * d, bfhi(kk.z) * d); kk.w = pk2(bflo(kk.w) * d, bfhi(kk.w) * d); \
        const unsigned o = (unsigned)(buf) * 65536u + (unsigned)(row >> 5) * 8192u + off_a(row & 31, ch); \
        *(LAS v4u*)(F.lds + o) = kk; *(LAS v4u*)(F.lds + 32768u + o) = R[2 + i]; } } while (0)
#define AB_STEP(c, RC, RN) do { \
        if ((c) + 2 < 16) AB_LOAD((c) + 2, RC); \
        if (wave < 4) { \
            if ((c) > 0) { v4u w0, w1; w0.x = pk2(acc[0], acc[1]); w0.y = pk2(acc[2], acc[3]); w0.z = pk2(acc[4], acc[5]); w0.w = pk2(acc[6], acc[7]); \
                w1.x = pk2(acc[8], acc[9]); w1.y = pk2(acc[10], acc[11]); w1.z = pk2(acc[12], acc[13]); w1.w = pk2(acc[14], acc[15]); \
                bf16* sn = F.SN + ((((size_t)(bh * 16 + (c)) * 32 + (2 * dh + di) * 8 + (2 * dq + dj)) * 64 + lane) * 16); \
                *(GAS v4u*)sn = w0; *(GAS v4u*)(sn + 8) = w1; } \
            _Pragma("unroll") for (int e = 0; e < 16; ++e) acc[e] *= cdec; \
            const LAS unsigned char* kb = F.lds + ((c) & 1) * 65536; const LAS unsigned char* vb = kb + 32768; \
            _Pragma("unroll") for (int kk = 0; kk < 8; ++kk) acc = MFMA32(frag_tr(kb + (kk >> 1) * 8192, ta, di, kk & 1), frag_tr(vb + (kk >> 1) * 8192, ta, dj, kk & 1), acc); \
        } \
        if ((c) + 1 < 16) AB_STORE(((c) + 1) & 1, RN); \
        __syncthreads(); } while (0)
    AB_LOAD(0, r0); AB_LOAD(1, r1); AB_STORE(0, r0); __syncthreads();
#pragma unroll 1
    for (int c = 0; c < 16; c += 2) { AB_STEP(c, r0, r1); AB_STEP(c + 1, r1, r0); }
#undef AB_LOAD
#undef AB_STORE
#undef AB_STEP
    if (wave < 4) {
        float* so = F.out + O_RP + (size_t)bh * (DK * DV);
        const int dv = 64 * dq + 32 * dj + (lane & 31);
#pragma unroll
        for (int e = 0; e < 16; ++e) so[(size_t)(64 * dh + 32 * di + crow(e, hh)) * DV + dv] = acc[e];
    }
}

__device__ __forceinline__ void pooled_prompt(Frame& F, int it0, int it1) {
    for (int it = it0 + F.tid; it < it1; it += NWAVES * 64) {
        const int row = it >> 7, q = it & 127, t = row & (SEQ - 1), w = 2 << (q >> 5), cnt = (t + 1 < w) ? t + 1 : w;
        const bf16* p = F.AX + (size_t)row * DPOOL + q * 8;
        v4u x[16];
#pragma unroll
        for (int j = 0; j < 16; ++j) x[j] = (j < cnt) ? *(const GAS v4u*)(p - (size_t)j * DPOOL) : (v4u){0u, 0u, 0u, 0u};
        float s[8] = {0.f, 0.f, 0.f, 0.f, 0.f, 0.f, 0.f, 0.f};
#pragma unroll
        for (int j = 0; j < 16; ++j) { s[0] += bflo(x[j].x); s[1] += bfhi(x[j].x); s[2] += bflo(x[j].y); s[3] += bfhi(x[j].y); s[4] += bflo(x[j].z); s[5] += bfhi(x[j].z); s[6] += bflo(x[j].w); s[7] += bfhi(x[j].w); }
        const float inv = 1.0f / (float)cnt;
        const float a[8] = {bflo(x[0].x), bfhi(x[0].x), bflo(x[0].y), bfhi(x[0].y), bflo(x[0].z), bfhi(x[0].z), bflo(x[0].w), bfhi(x[0].w)};
        v4u o; o.x = pk2(s[0] * inv - a[0], s[1] * inv - a[1]); o.y = pk2(s[2] * inv - a[2], s[3] * inv - a[3]); o.z = pk2(s[4] * inv - a[4], s[5] * inv - a[5]); o.w = pk2(s[6] * inv - a[6], s[7] * inv - a[7]);
        *(GAS v4u*)(F.POOLED + (size_t)row * DPOOL + q * 8) = o;
    }
}
__device__ __forceinline__ void pooled_sample(Frame& F, int it0, int it1) {
    for (int it = it0 + F.tid; it < it1; it += NWAVES * 64) {
        const int bs = it >> 7, q = it & 127, w = 2 << (q >> 5);
        const v4u x = *(const GAS v4u*)(F.AX + (size_t)(MP + bs) * DPOOL + q * 8);
        float a[8] = {bflo(x.x), bfhi(x.x), bflo(x.y), bfhi(x.y), bflo(x.z), bfhi(x.z), bflo(x.w), bfhi(x.w)}, s[8];
#pragma unroll
        for (int e = 0; e < 8; ++e) s[e] = a[e];
        const float* sp = F.st_pool + (size_t)bs * 15 * DPOOL + q * 8;
        float* op = F.out + O_PS + (size_t)bs * 15 * DPOOL + q * 8;
#pragma unroll
        for (int i = 14; i >= 0; --i) {
            const f32x4 b0 = *(const f32x4*)(sp + (size_t)i * DPOOL), b1 = *(const f32x4*)(sp + (size_t)i * DPOOL + 4);
            if (i >= 1) { *(f32x4*)(op + (size_t)(i - 1) * DPOOL) = b0; *(f32x4*)(op + (size_t)(i - 1) * DPOOL + 4) = b1; }
            if (15 - i < w) { s[0] += b0.x; s[1] += b0.y; s[2] += b0.z; s[3] += b0.w; s[4] += b1.x; s[5] += b1.y; s[6] += b1.z; s[7] += b1.w; }
        }
        const float inv = 1.0f / (float)w;
        v4u o; o.x = pk2(s[0] * inv - a[0], s[1] * inv - a[1]); o.y = pk2(s[2] * inv - a[2], s[3] * inv - a[3]); o.z = pk2(s[4] * inv - a[4], s[5] * inv - a[5]); o.w = pk2(s[6] * inv - a[6], s[7] * inv - a[7]);
        *(GAS v4u*)(F.POOLED + (size_t)(MP + bs) * DPOOL + q * 8) = o;
    }
}
__device__ __forceinline__ void ret_sample_items(Frame& F, int first, int count) {
    const int lane = fresh_lane(), wave = F.wave;
    f32x4 svA[16], svB[16];
#define RS_LOAD(item, SV) do { const float* s0_ = F.st_ret + ((size_t)(item) * DK + 16 * wave) * DV + 4 * lane; \
        _Pragma("unroll") for (int r = 0; r < 16; ++r) SV[r] = __builtin_nontemporal_load((const f32x4*)(s0_ + (size_t)r * DV)); } while (0)
#define RS_BODY(item, SV, buf) do { \
        const int bs_ = (item) >> 3, h_ = (item) & 7, row_ = MP + bs_; \
        const float gam_ = 1.0f - __builtin_amdgcn_exp2f((float)(-5 - h_)); \
        const size_t hr_ = (size_t)(MP * NH) + (size_t)(item); \
        f32x4 v4_; { const v2u x_ = *(const GAS v2u*)(F.Vb + hr_ * DV + 4 * lane); v4_ = (f32x4){bflo(x_.x), bfhi(x_.x), bflo(x_.y), bfhi(x_.y)}; } \
        const v4u q0_ = *(const GAS v4u*)(F.Qb + hr_ * DK + 16 * wave), q1_ = *(const GAS v4u*)(F.Qb + hr_ * DK + 16 * wave + 8); \
        const v4u k0_ = *(const GAS v4u*)(F.Kb + hr_ * DK + 16 * wave), k1_ = *(const GAS v4u*)(F.Kb + hr_ * DK + 16 * wave + 8); \
        const float qv_[16] = {bflo(q0_.x), bfhi(q0_.x), bflo(q0_.y), bfhi(q0_.y), bflo(q0_.z), bfhi(q0_.z), bflo(q0_.w), bfhi(q0_.w), bflo(q1_.x), bfhi(q1_.x), bflo(q1_.y), bfhi(q1_.y), bflo(q1_.z), bfhi(q1_.z), bflo(q1_.w), bfhi(q1_.w)}; \
        const float kv_[16] = {bflo(k0_.x), bfhi(k0_.x), bflo(k0_.y), bfhi(k0_.y), bflo(k0_.z), bfhi(k0_.z), bflo(k0_.w), bfhi(k0_.w), bflo(k1_.x), bfhi(k1_.x), bflo(k1_.y), bfhi(k1_.y), bflo(k1_.z), bfhi(k1_.z), bflo(k1_.w), bfhi(k1_.w)}; \
        float* s1_ = F.out + O_RS + ((size_t)(item) * DK + 16 * wave) * DV + 4 * lane; \
        f32x4 o4_ = (f32x4){0.f, 0.f, 0.f, 0.f}; \
        _Pragma("unroll") for (int r = 0; r < 16; ++r) { const f32x4 sn_ = SV[r] * gam_ + v4_ * kv_[r]; __builtin_nontemporal_store(sn_, (f32x4*)(s1_ + (size_t)r * DV)); o4_ += sn_ * qv_[r]; } \
        LAS float* part_ = (LAS float*)(F.lds) + (buf) * 2048; \
        *(LAS f32x4*)(part_ + wave * 256 + 4 * lane) = o4_; \
        __syncthreads(); \
        if (wave == 0) { \
            f32x4 o_ = *(LAS f32x4*)(part_ + 4 * lane); \
            _Pragma("unroll") for (int w = 1; w < 8; ++w) o_ += *(LAS f32x4*)(part_ + w * 256 + 4 * lane); \
            const float mu_ = wave_sum((o_.x + o_.y) + (o_.z + o_.w)) * (1.0f / DV); \
            o_ = o_ - mu_; \
            const float var_ = wave_sum((o_.x * o_.x + o_.y * o_.y) + (o_.z * o_.z + o_.w * o_.w)) * (1.0f / DV); \
            const float rstd_ = 1.0f / sqrtf(var_ + EPS); \
            const f32x4 g_ = *(const f32x4*)(F.gn_g + h_ * DV + 4 * lane); \
            const v2u x_ = *(const GAS v2u*)(F.BG + hr_ * DV + 4 * lane); \
            o_ = o_ * rstd_ * g_; o_.x *= bflo(x_.x); o_.y *= bfhi(x_.x); o_.z *= bflo(x_.y); o_.w *= bfhi(x_.y); \
            v2u wv_; wv_.x = pk2(o_.x, o_.y); wv_.y = pk2(o_.z, o_.w); \
            *(GAS v2u*)(F.YAB + (size_t)row_ * LDY + 1024 + h_ * DV + 4 * lane) = wv_; \
        } } while (0)
    RS_LOAD(first, svA);
#pragma unroll 1
    for (int k = 0; k < count; k += 2) {
        if (k + 1 < count) RS_LOAD(first + k + 1, svB);
        RS_BODY(first + k, svA, 0);
        if (k + 1 < count) { if (k + 2 < count) RS_LOAD(first + k + 2, svA); RS_BODY(first + k + 1, svB, 1); }
    }
#undef RS_LOAD
#undef RS_BODY
    __syncthreads();
}

__device__ __forceinline__ void ret_c_unit(Frame& F, int unit) {
    const int bh = unit >> 4, c = unit & 15, b = bh >> 3, h = bh & 7, lane = fresh_lane(), wave = F.wave, hh = lane >> 5, l31 = lane & 31, tid_ = wave * 64 + lane;
    const float lg = lg2gamma(h);
    const int ti = wave & 3, wh = wave >> 2;
    const RowA ra = row_addr(lane); const TrA ta = tr_addr(lane);
    const int rowbase = b * SEQ + c * 128;
    const size_t hrow = (size_t)bh * SEQ + c * 128;
    const bf16* Qg = F.Qb + hrow * DK; const bf16* Kg = F.Kb + hrow * DK; const bf16* Vg = F.Vb + hrow * DV; const bf16* Bg = F.BG + hrow * DV;
    LAS unsigned char* Qi = F.lds; LAS unsigned char* Ki = F.lds + 32768; LAS unsigned char* Vi = F.lds + 65536;
    {
        v4u rq[4], rk[4], rv[8];
#pragma unroll
        for (int i = 0; i < 4; ++i) { const int n = tid_ + 512 * i;
            rq[i] = *(const GAS v4u*)(Qg + (size_t)n * 8); rk[i] = *(const GAS v4u*)(Kg + (size_t)n * 8); }
#pragma unroll
        for (int i = 0; i < 8; ++i) { const int n = tid_ + 512 * i; rv[i] = *(const GAS v4u*)(Vg + (size_t)n * 8); }
#pragma unroll
        for (int i = 0; i < 4; ++i) { const int n = tid_ + 512 * i, row = n >> 4, ch = n & 15; const unsigned o = (unsigned)(row >> 5) * 8192u + off_a(row & 31, ch);
            *(LAS v4u*)(Qi + o) = rq[i]; *(LAS v4u*)(Ki + o) = rk[i]; }
#pragma unroll
        for (int i = 0; i < 8; ++i) { const int n = tid_ + 512 * i, row = n >> 5, ch = n & 31;
            *(LAS v4u*)(Vi + (unsigned)((row >> 5) * 2 + (ch >> 4)) * 8192u + off_a(row & 31, ch & 15)) = rv[i]; }
    }
    const bf16* snb = F.SN + (((size_t)(bh * 16 + c) * 32) * 64 + lane) * 16;
    v4u sf[2][2][4];
    if (c > 0) {
#pragma unroll
        for (int i = 0; i < 2; ++i)
#pragma unroll
            for (int s2 = 0; s2 < 2; ++s2)
#pragma unroll
                for (int j = 0; j < 4; ++j) sf[i][s2][j] = *(const GAS v4u*)(snb + (size_t)(i * 8 + 4 * wh + j) * 1024 + 8 * s2);
    }
    __syncthreads();
    f32x16 X[2];
#pragma unroll
    for (int t = 0; t < 2; ++t) {
        const int sj = 2 * wh + t;
#pragma unroll
        for (int e = 0; e < 16; ++e) X[t][e] = 0.f;
        if (sj <= ti) {
#pragma unroll
            for (int ks = 0; ks < 8; ++ks) X[t] = MFMA32(frag_row(Ki + sj * 8192, ra, ks), frag_row(Qi + ti * 8192, ra, ks), X[t]);
        }
    }
    __syncthreads();
#pragma unroll
    for (int t = 0; t < 2; ++t) {
        const int sj = 2 * wh + t;
        if (sj <= ti) {
            const int tt = 32 * ti + l31;
#pragma unroll
            for (int g = 0; g < 4; ++g) {
                float p[4];
#pragma unroll
                for (int e = 0; e < 4; ++e) { const int s = 32 * sj + 8 * g + 4 * hh + e; const float f = __builtin_amdgcn_exp2f(-(float)(s + 1) * lg); p[e] = (s <= tt) ? X[t][4 * g + e] * f : 0.f; }
                v2u w; w.x = pk2(p[0], p[1]); w.y = pk2(p[2], p[3]);
                *(LAS v2u*)(Ki + ti * 8192 + off_a(l31, 4 * sj + g) + 8 * hh) = w;
            }
        }
    }
    f32x16 O[4];
#pragma unroll
    for (int j = 0; j < 4; ++j)
#pragma unroll
        for (int e = 0; e < 16; ++e) O[j][e] = 0.f;
    const unsigned qb = 2048u * (l31 >> 3) + 64u * (l31 & 7) + 8u * hh, qm = (l31 >> 2) & 3;
    const LAS unsigned char* Qt = Qi + ti * 8192 + qb;
#define QFRAG(i, s2) __builtin_shufflevector(*(const LAS s16x4*)(Qt + 512 * (i) + 16 * ((2 * (s2)) ^ qm)), *(const LAS s16x4*)(Qt + 512 * (i) + 16 * ((2 * (s2) + 1) ^ qm)), 0, 1, 2, 3, 4, 5, 6, 7)
    if (c > 0) {
#pragma unroll
        for (int i = 0; i < 2; ++i)
#pragma unroll
            for (int s2 = 0; s2 < 2; ++s2) { const bf16x8 a = QFRAG(i, s2);
#pragma unroll
                for (int j = 0; j < 4; ++j) O[j] = MFMA32(a, __builtin_bit_cast(bf16x8, sf[i][s2][j]), O[j]); }
#pragma unroll
        for (int i = 0; i < 2; ++i)
#pragma unroll
            for (int s2 = 0; s2 < 2; ++s2)
#pragma unroll
                for (int j = 0; j < 4; ++j) sf[i][s2][j] = *(const GAS v4u*)(snb + (size_t)((i + 2) * 8 + 4 * wh + j) * 1024 + 8 * s2);
    }
    __syncthreads();
    for (int kk = 0; kk < 2 * (ti + 1); ++kk) {
        const bf16x8 a = frag_row(Ki + ti * 8192, ra, kk);
        const LAS unsigned char* vimg = Vi + ((kk >> 1) * 2 + wh) * 8192;
#pragma unroll
        for (int j = 0; j < 4; ++j) O[j] = MFMA32(a, frag_tr(vimg, ta, j, kk & 1), O[j]);
    }
    if (c > 0) {
#pragma unroll
        for (int i = 0; i < 2; ++i)
#pragma unroll
            for (int s2 = 0; s2 < 2; ++s2) { const bf16x8 a = QFRAG(i + 2, s2);
#pragma unroll
                for (int j = 0; j < 4; ++j) O[j] = MFMA32(a, __builtin_bit_cast(bf16x8, sf[i][s2][j]), O[j]); }
    }
#undef QFRAG
    LAS float* st = (LAS float*)(F.lds + STAT_OFF);
    float mu[16], rs[16];
#pragma unroll
    for (int e = 0; e < 16; ++e) {
        const float f = __builtin_amdgcn_exp2f((float)(crow(e, hh) + 32 * ti + 1) * lg);
        float s = 0.f;
#pragma unroll
        for (int j = 0; j < 4; ++j) { O[j][e] *= f; s += O[j][e]; }
        s += __shfl_xor(s, 1); s += __shfl_xor(s, 2); s += __shfl_xor(s, 4); s += __shfl_xor(s, 8); s += __shfl_xor(s, 16);
        if (l31 == 0) st[(32 * ti + crow(e, hh)) * 2 + wh] = s;
    }
    __syncthreads();
#pragma unroll
    for (int e = 0; e < 16; ++e) { const int r = 32 * ti + crow(e, hh); mu[e] = (st[r * 2] + st[r * 2 + 1]) * (1.0f / DV); }
#pragma unroll
    for (int e = 0; e < 16; ++e) {
        float s = 0.f;
#pragma unroll
        for (int j = 0; j < 4; ++j) { O[j][e] -= mu[e]; s += O[j][e] * O[j][e]; }
        s += __shfl_xor(s, 1); s += __shfl_xor(s, 2); s += __shfl_xor(s, 4); s += __shfl_xor(s, 8); s += __shfl_xor(s, 16);
        if (l31 == 0) st[256 + (32 * ti + crow(e, hh)) * 2 + wh] = s;
    }
    __syncthreads();
#pragma unroll
    for (int e = 0; e < 16; ++e) { const int r = 32 * ti + crow(e, hh); rs[e] = 1.0f / sqrtf((st[256 + r * 2] + st[256 + r * 2 + 1]) * (1.0f / DV) + EPS); }
    LAS float* T = (LAS float*)F.lds;
#pragma unroll
    for (int j = 0; j < 4; ++j) {
        const float g = F.gn_g[h * DV + 128 * wh + 32 * j + l31];
#pragma unroll
        for (int e = 0; e < 16; ++e) T[(32 * ti + crow(e, hh)) * 256 + 128 * wh + 32 * j + l31] = O[j][e] * rs[e] * g;
    }
    __syncthreads();
    {
        v4u bg[8];
#pragma unroll
        for (int i = 0; i < 8; ++i) { const int n = tid_ + 512 * i; bg[i] = *(const GAS v4u*)(Bg + (size_t)n * 8); }
#pragma unroll
        for (int i = 0; i < 8; ++i) { const int n = tid_ + 512 * i, row = n >> 5, ch = n & 31;
            const f32x4 t0 = *(const LAS f32x4*)(T + row * 256 + ch * 8), t1 = *(const LAS f32x4*)(T + row * 256 + ch * 8 + 4);
            v4u o; o.x = pk2(t0.x * bflo(bg[i].x), t0.y * bfhi(bg[i].x)); o.y = pk2(t0.z * bflo(bg[i].y), t0.w * bfhi(bg[i].y));
            o.z = pk2(t1.x * bflo(bg[i].z), t1.y * bfhi(bg[i].z)); o.w = pk2(t1.z * bflo(bg[i].w), t1.w * bfhi(bg[i].w));
            *(GAS v4u*)(F.YAB + (size_t)(rowbase + row) * LDY + 1024 + h * DV + ch * 8) = o; }
    }
    __syncthreads();
}


constexpr int CW_Q = 8192;
__device__ __forceinline__ int wg_ticket(Frame& F, int q, int n) {
    __syncthreads();
    if (F.tid == 0) F.MISC[16] = __hip_atomic_fetch_add((unsigned*)(F.ctl + CW_Q + 64 * q), (unsigned)n, __ATOMIC_RELAXED, __HIP_MEMORY_SCOPE_AGENT);
    __syncthreads();
    return (int)F.MISC[16];
}

__device__ __forceinline__ void final_row(Frame& F, const float* xrow, float* yrow, const float* ssrow, const float* gaterow) {
    const float s = ssrow[F.lane];
    const float rstd = 1.0f / sqrtf(wave_sum(s) * (1.0f / DM) + EPS);
#pragma unroll
    for (int j = 0; j < 8; ++j) {
        const int col = 4 * F.lane + 256 * j;
        const f32x4 x = __builtin_nontemporal_load((const f32x4*)(xrow + col)), o = __builtin_nontemporal_load((const f32x4*)(yrow + col)), g = *(const f32x4*)(F.g_post + col), gt = *(const f32x4*)(gaterow + col);
        __builtin_nontemporal_store(x + gt * (o * rstd * g), (f32x4*)(yrow + col));
    }
}

struct Args { const float* in[19]; float* out; unsigned char* ws; int ph_lo, ph_hi; };
constexpr int N_PHASES = 9;
__global__ void __launch_bounds__(NWAVES * 64, 2) hybrid_fwd(Args args) {
    extern __shared__ __attribute__((aligned(16))) unsigned char lds[];
    Frame F;
    F.lds = (LAS unsigned char*)lds;
    F.MISC = (volatile LAS unsigned*)(F.lds + MISC_OFF);
    F.wave = __builtin_amdgcn_readfirstlane((int)threadIdx.x >> 6); F.lane = fresh_lane(); F.tid = F.wave * 64 + F.lane;
    F.G = gridDim.x; { const int bx = blockIdx.x; F.vcu = (F.G % 8 == 0) ? (bx % 8) * (F.G / 8) + bx / 8 : bx; }
    unsigned char* ws = args.ws;
    F.ctl = (gu32*)(ws + WS_CTL);
    F.x_p = args.in[0]; F.x_s = args.in[1]; F.st_pool = args.in[2]; F.st_ret = args.in[3]; F.c_p = args.in[4]; F.c_s = args.in[5]; F.ada_w = args.in[6]; F.ada_b = args.in[7];
    F.g_pre = args.in[8]; F.g_post = args.in[9]; F.w_in = args.in[10]; F.pool_w = args.in[11]; F.pool_scale = args.in[12]; F.gn_g = args.in[13]; F.w_a = args.in[14]; F.w_b = args.in[15];
    F.w_merge = args.in[16]; F.b_merge = args.in[17]; F.w_out = args.in[18]; F.out = args.out;
    F.ropec = (float*)(ws + WS_ROPE); F.ropes = F.ropec + 2049 * 64; F.mod = (float*)(ws + WS_MOD); F.ss = (float*)(ws + WS_SS);
    F.Wcat = (bf16*)(ws + WS_WCAT); F.Wab = (bf16*)(ws + WS_WAB); F.Wout = (bf16*)(ws + WS_WOUT); F.PoolW = (bf16*)(ws + WS_POOLW);
    F.H = (bf16*)(ws + WS_H); F.AX = (bf16*)(ws + WS_AX); F.AG = (bf16*)(ws + WS_AG); F.Qb = (bf16*)(ws + WS_Q); F.Kb = (bf16*)(ws + WS_K); F.Vb = (bf16*)(ws + WS_V); F.BG = (bf16*)(ws + WS_BG); F.GA = (bf16*)(ws + WS_GA); F.GB = (bf16*)(ws + WS_GB); F.YAB = (bf16*)(ws + WS_YAB); F.POOLED = (bf16*)(ws + WS_POOLED); F.SN = (bf16*)(ws + WS_SN); F.MB = (bf16*)(ws + WS_MB);
    for (int u = F.tid; u < (LDS_BYTES - LDSCTL_OFF) / 4; u += NWAVES * 64) ((LAS unsigned*)(F.lds + LDSCTL_OFF))[u] = 0u;
    __syncthreads();
    const int lo = args.ph_lo, hi = args.ph_hi;
    XcdBarrier bar; bar.bar = (unsigned*)(F.ctl + CW_BAR); bar.x = 0; bar.st = nullptr; bar.wave = F.wave;
    if (hi - lo > 1) bar = xcd_barrier_post((unsigned*)(F.ctl + CW_BAR), F.MISC + 8, F.wave);
#define IN(k) (lo <= (k) && (k) < hi)
#define PHASE_BEGIN() do { F.lane = fresh_lane(); F.tid = F.wave * 64 + F.lane; } while (0)
#define SEAM(k) do { if (IN(k) && IN((k) + 1)) xcd_barrier(bar); } while (0)
    const int gw = F.vcu * NWAVES + F.wave, NGW = F.G * NWAVES;

    if (((PH_MASK >> 0) & 1) && IN(0)) for (int rep_ = 0; rep_ < (REP_PHASE == 0 ? REP_N : 1); ++rep_) { PHASE_BEGIN(); p0_prologue(F); } SEAM(0);

    if (((PH_MASK >> 1) & 1) && IN(1)) for (int rep_ = 0; rep_ < (REP_PHASE == 1 ? REP_N : 1); ++rep_) { PHASE_BEGIN();
        for (int m = gw; m < MP + MS; m += NGW) {
            const float* xr = m < MP ? F.x_p + (size_t)m * DM : F.x_s + (size_t)(m - MP) * DM;
            const float* mr = F.mod + (size_t)(m < MP ? (m >> 11) : 4 + (m - MP)) * 6144;
            h_row(F, xr, mr, F.H + (size_t)m * DM);
        }
    } SEAM(1);

    if (((PH_MASK >> 2) & 1) && IN(2)) for (int rep_ = 0; rep_ < (REP_PHASE == 2 ? REP_N : 1); ++rep_) { PHASE_BEGIN();
        EpiZ E{F.AX, F.AG, F.Qb, F.Kb, F.Vb, F.BG, F.GA, F.GB, F.b_merge, F.ropec, F.ropes, F.out + O_PP, F.out + O_PS};
        pg8::Gemm gs{F.H + (size_t)MP * DM, F.Wcat, DM, DM, DM, 0}; pg8::sgemm_phase<EpiZ>(F.lds + RING_OFF, gs, MP, LDZ / 64, F.vcu, F.G, E, F.tid);
    } SEAM(2);

    if (((PH_MASK >> 3) & 1) && IN(3)) for (int rep_ = 0; rep_ < (REP_PHASE == 3 ? REP_N : 1); ++rep_) { PHASE_BEGIN();
        pg8::Gemm g{F.H, F.Wcat, DM, DM, DM, 0};
        EpiZ E{F.AX, F.AG, F.Qb, F.Kb, F.Vb, F.BG, F.GA, F.GB, F.b_merge, F.ropec, F.ropes, F.out + O_PP, F.out + O_PS};
        const int n1 = 1 + (F.vcu % 5);
        { pg8::RangeOrder S; S.init(MP, LDZ, F.G, (int)blockIdx.x); S.i0 = 0; S.i1 = n1;
          pg8::gemm_phase<EpiZ, pg8::RangeOrder, true, true>(F.lds + RING_OFF, g, S, E, F.tid); }
        PHASE_BEGIN();
        { const int per = (MS * NH + F.G - 1) / F.G; const int f0 = F.vcu * per; if (f0 < MS * NH) ret_sample_items(F, f0, (f0 + per <= MS * NH) ? per : MS * NH - f0); }
        PHASE_BEGIN();
        { pg8::RangeOrder S; S.init(MP, LDZ, F.G, (int)blockIdx.x); S.i0 = n1; S.i1 = 1 << 20;
          pg8::gemm_phase<EpiZ, pg8::RangeOrder, true, true>(F.lds + RING_OFF, g, S, E, F.tid); }
    } SEAM(3);

    if (((PH_MASK >> 4) & 1) && IN(4)) for (int rep_ = 0; rep_ < (REP_PHASE == 4 ? REP_N : 1); ++rep_) { PHASE_BEGIN();
        for (int u = F.vcu; u < 256; u += F.G) ret_ab_unit(F, u);
        PHASE_BEGIN();
        { const int gw512 = F.vcu; for (int k = gw512; k < 2048 + 32; k += F.G) { if (k < 2048) pooled_prompt(F, k * 512, k * 512 + 512); else pooled_sample(F, (k - 2048) * 512, (k - 2048) * 512 + 512); } }
    } SEAM(4);

    if (((PH_MASK >> 5) & 1) && IN(5)) for (int rep_ = 0; rep_ < (REP_PHASE == 5 ? REP_N : 1); ++rep_) { PHASE_BEGIN();
        { pg8::Gemm g{F.POOLED, F.PoolW, 256, DPOOL, 256, 512}; pg8::StaticOrder S; S.init(MT, DPOOL, F.G, (int)blockIdx.x);
          EpiPool E{F.YAB, F.AG, F.pool_scale};
          pg8::gemm_phase<EpiPool, pg8::StaticOrder, true, true>(F.lds + RING_OFF, g, S, E, F.tid); }
        PHASE_BEGIN();
        for (;;) { const int t = wg_ticket(F, 4 * rep_ + 3, 1); if (t >= 512) break; ret_c_unit(F, t); }
    } SEAM(5);

    if (((PH_MASK >> 6) & 1) && IN(6)) for (int rep_ = 0; rep_ < (REP_PHASE == 6 ? REP_N : 1); ++rep_) { PHASE_BEGIN();
        pg8::Gemm g{F.YAB, F.Wab, LDY, LDY, LDY, 0}; pg8::StaticOrder S; S.init(MP, DM, F.G, (int)blockIdx.x);
        EpiMerge E{F.MB, F.GA, F.GB};
        pg8::gemm_phase<EpiMerge, pg8::StaticOrder, true, true>(F.lds + RING_OFF, g, S, E, F.tid);
        PHASE_BEGIN();
        { pg8::Gemm gs{F.YAB + (size_t)MP * LDY, F.Wab, LDY, LDY, LDY, 0}; pg8::sgemm_phase<EpiMerge>(F.lds + RING_OFF, gs, MP, DM / 64, F.vcu, F.G, E, F.tid); }
    } SEAM(6);

    if (((PH_MASK >> 7) & 1) && IN(7)) for (int rep_ = 0; rep_ < (REP_PHASE == 7 ? REP_N : 1); ++rep_) { PHASE_BEGIN();
        pg8::Gemm g{F.MB, F.Wout, DM, DM, DM, 0}; pg8::StaticOrder S; S.init(MP, DM, F.G, (int)blockIdx.x);
        EpiOut E{F.out, F.ss};
        pg8::gemm_phase<EpiOut, pg8::StaticOrder, true, true>(F.lds + RING_OFF, g, S, E, F.tid);
        PHASE_BEGIN();
        { pg8::Gemm gs{F.MB + (size_t)MP * DM, F.Wout, DM, DM, DM, 0}; pg8::sgemm_phase<EpiOut>(F.lds + RING_OFF, gs, MP, DM / 64, F.vcu, F.G, E, F.tid); }
    } SEAM(7);

    if (((PH_MASK >> 8) & 1) && IN(8)) for (int rep_ = 0; rep_ < (REP_PHASE == 8 ? REP_N : 1); ++rep_) { PHASE_BEGIN();
        for (int m = gw; m < MP + MS; m += NGW) {
            const float* xr = m < MP ? F.x_p + (size_t)m * DM : F.x_s + (size_t)(m - MP) * DM;
            float* yr = F.out + (m < MP ? O_YP + (size_t)m * DM : O_YS + (size_t)(m - MP) * DM);
            const float* gr = F.mod + (size_t)(m < MP ? (m >> 11) : 4 + (m - MP)) * 6144 + 2 * DM;
            final_row(F, xr, yr, F.ss + (size_t)m * 64, gr);
        }
    }
#undef IN
#undef SEAM
}

extern "C" void kernel_launch(void* const* d_in, const int* in_sizes, int n_in, void* d_out, int out_size, void* d_ws, size_t ws_size, hipStream_t stream) {
    static int grid = 0;
    if (grid == 0) {
        if (n_in != 19 || ws_size < WS_END) { fprintf(stderr, "kernel_launch: unexpected inputs (n_in %d, ws %zu)\n", n_in, ws_size); grid = -1; return; }
        int dev = 0, cus = 0, per_cu = 0;
        if (hipGetDevice(&dev) != hipSuccess || hipDeviceGetAttribute(&cus, hipDeviceAttributeMultiprocessorCount, dev) != hipSuccess) { grid = -1; return; }
        if (hipFuncSetAttribute((const void*)hybrid_fwd, hipFuncAttributeMaxDynamicSharedMemorySize, LDS_BYTES) != hipSuccess) { fprintf(stderr, "kernel_launch: hipFuncSetAttribute failed\n"); grid = -1; return; }
        if (hipOccupancyMaxActiveBlocksPerMultiprocessor(&per_cu, (const void*)hybrid_fwd, NWAVES * 64, LDS_BYTES) != hipSuccess || per_cu < 1) { fprintf(stderr, "kernel_launch: occupancy query says %d\n", per_cu); per_cu = 1; }
        (void)hipGetLastError();
        grid = cus;
    }
    if (grid < 0) return;
    (void)hipMemsetAsync((char*)d_ws + WS_CTL, 0, CTL_ZERO_BYTES, stream);
    Args a{};
    for (int i = 0; i < 19; ++i) a.in[i] = (const float*)d_in[i];
    a.out = (float*)d_out; a.ws = (unsigned char*)d_ws;
    if (MK_N_LAUNCHES == 1) { a.ph_lo = 0; a.ph_hi = N_PHASES; hipLaunchKernelGGL(hybrid_fwd, dim3(grid), dim3(NWAVES * 64), LDS_BYTES, stream, a); }
    else for (int p = 0; p < N_PHASES; ++p) { a.ph_lo = p; a.ph_hi = p + 1; hipLaunchKernelGGL(hybrid_fwd, dim3(grid), dim3(NWAVES * 64), LDS_BYTES, stream, a); }
}
```

```cpp
#include <hip/hip_runtime.h>
#include <cstdio>
#include <cstdint>

#ifndef PH_MASK
#define PH_MASK 511
#endif
#ifndef REP_PHASE
#define REP_PHASE -1
#define REP_N 1
#endif
#ifndef MK_N_LAUNCHES
#define MK_N_LAUNCHES 1
#endif

namespace pg8 {
#define PG8_LAS __attribute__((address_space(3)))
typedef unsigned short bf16_t;
typedef short bf16x8 __attribute__((ext_vector_type(8)));
typedef float f32x4 __attribute__((ext_vector_type(4)));
typedef unsigned u32x4 __attribute__((ext_vector_type(4)));
typedef unsigned u32x2 __attribute__((ext_vector_type(2)));
constexpr int BM = 256, BK = 64, HALF = 128, HTB = HALF * BK * 2  , STAGE_BYTES = 8 * HTB, NXCD = 8, WGM = 8;

__host__ __device__ __forceinline__ int lds_byte(int r, int c) { const int st = (r >> 4) * 2 + (c >> 5), rr = r & 15, cc = c & 31, ob = rr * 64 + cc * 2; return st * 1024 + (ob ^ (((ob >> 9) & 1) << 5)); }
__host__ __device__ __forceinline__ void stage_rc(int b, int& R, int& C) { const int st = b / 1024, sb = b % 1024, swz = sb ^ (((sb >> 9) & 1) << 5); R = (st >> 1) * 16 + swz / 64; C = (st & 1) * 32 + (swz % 64) / 2; }
__host__ __device__ __forceinline__ int perm32(int rho) { const int n = rho >> 4, i = rho & 15; return 8 * (i >> 2) + 4 * n + (i & 3); }

struct Unit { int pm, pn; };
struct Gemm { const bf16_t* A; const bf16_t* Bt; int K, lda, ldb, a_pn_bytes; };

struct StaticOrder {
    int nM, nN, nwg, G, c;
    __host__ __device__ void init(int M, int N, int G_, int c_) { nM = M / BM; nN = N / BM; nwg = nM * nN; G = G_; c = c_; }
    __host__ __device__ bool next(int i, Unit& u) const {
        const long L = (long)i * G + c; if (L >= nwg) return false;
        int wgid = (int)L; { const int q = nwg / NXCD, r = nwg % NXCD, xcd = wgid % NXCD, off = wgid / NXCD; wgid = (xcd < r ? xcd * (q + 1) : r * (q + 1) + (xcd - r) * q) + off; }
        const int nig = WGM * nN, gid = wgid / nig, fm = gid * WGM, gsz = (nM - fm) < WGM ? (nM - fm) : WGM;
        u.pm = fm + ((wgid % nig) % gsz); u.pn = (wgid % nig) / gsz; return true;
    }
};

struct RangeOrder : StaticOrder {
    int i0, i1;
    __host__ __device__ bool next(int i, Unit& u) const { return (i + i0 < i1) && StaticOrder::next(i + i0, u); }
};
__device__ __forceinline__ unsigned cvt_pk_bf16(float lo, float hi) { unsigned r; asm volatile("v_cvt_pk_bf16_f32 %0, %1, %2" : "=v"(r) : "v"(lo), "v"(hi)); return r; }
__device__ __forceinline__ float bf_lo(unsigned w) { return __uint_as_float(w << 16); }
__device__ __forceinline__ float bf_hi(unsigned w) { return __uint_as_float(w & 0xffff0000u); }
__device__ __forceinline__ float sigmoidf_(float v) { return __builtin_amdgcn_rcpf(1.0f + __builtin_amdgcn_exp2f(-1.4426950408889634f * v)); }


template <class Epi, class Sched, bool ALIGN_EPI = false, bool SP2 = false>
__device__ __forceinline__ void gemm_phase(PG8_LAS unsigned char* lds, const Gemm g, const Sched& S, const Epi& E, const int tid) {
    const int wid = __builtin_amdgcn_readfirstlane(tid >> 6), lane = tid & 63, wr = wid >> 2, wc = wid & 3, fr = lane & 15, fq = lane >> 4;
    const int K = g.K, nt = K / BK;
    unsigned voffA[2], voffB[2];
#pragma unroll
    for (int i = 0; i < 2; ++i) { int R, C; stage_rc(tid * 16 + i * 8192, R, C); const int Rb = Epi::PERM ? ((R & ~31) + perm32(R & 31)) : R;
        voffA[i] = (unsigned)(R * g.lda + C) * 2u; voffB[i] = (unsigned)(Rb * g.ldb + C) * 2u; }
    const size_t kstep = (size_t)(BK * 2);
    const size_t hstepA = (size_t)HALF * g.lda * 2, hstepB = (size_t)HALF * g.ldb * 2;
    const size_t tstepA = 2 * hstepA, tstepB = 2 * hstepB;
    const unsigned ldsw = (unsigned)wid * 1024u;
    const int aoff = lds_byte(wr * 64 + fr, fq * 8), boff = lds_byte(wc * 32 + fr, fq * 8);
#define PG8_SA(b, h) (((b) * 2 + (h)) * HTB)
#define PG8_SB(b, h) ((4 + (b) * 2 + (h)) * HTB)
#define PG8_STAGE(bufoff, gbase, voff) do { _Pragma("unroll") for (int _i = 0; _i < 2; ++_i) \
        __builtin_amdgcn_global_load_lds((const unsigned*)((const char*)(gbase) + (voff)[_i]), (PG8_LAS unsigned*)(lds + (bufoff) + ldsw + _i * 8192), 16, 0, 0); } while (0)
#define PG8_LDA(dst, b, h) do { _Pragma("unroll") for (int m = 0; m < 4; ++m) _Pragma("unroll") for (int k = 0; k < 2; ++k) dst[m][k] = *(const PG8_LAS bf16x8*)(lds + PG8_SA(b, h) + aoff + m * 2048 + k * 1024); } while (0)
#define PG8_LDB(dst, b, h) do { _Pragma("unroll") for (int n = 0; n < 2; ++n) _Pragma("unroll") for (int k = 0; k < 2; ++k) dst[n][k] = *(const PG8_LAS bf16x8*)(lds + PG8_SB(b, h) + boff + n * 2048 + k * 1024); } while (0)
#define PG8_MMA(ai, bj, At, Bt) do { __builtin_amdgcn_s_setprio(1); _Pragma("unroll") for (int m = 0; m < 4; ++m) _Pragma("unroll") for (int n = 0; n < 2; ++n) _Pragma("unroll") for (int k = 0; k < 2; ++k) \
        acc[ai][bj][m][n] = __builtin_amdgcn_mfma_f32_16x16x32_bf16(Bt[n][k], At[m][k], acc[ai][bj][m][n], 0, 0, 0); __builtin_amdgcn_s_setprio(0); } while (0)
#define PG8_WAIT_V(n) asm volatile("s_waitcnt vmcnt(" #n ")" ::: "memory")
#define PG8_WAIT_L(n) asm volatile("s_waitcnt lgkmcnt(" #n ")" ::: "memory")
#define PG8_BAR __builtin_amdgcn_s_barrier()
#define PG8_SCHED __builtin_amdgcn_sched_barrier(0)
    Unit cur, nxt; int ui = 0;
    if (!S.next(0, cur)) return;
    f32x4 acc[2][2][4][2];
#pragma unroll
    for (int a = 0; a < 2; ++a)
#pragma unroll
        for (int b = 0; b < 2; ++b)
#pragma unroll
            for (int m = 0; m < 4; ++m)
#pragma unroll
                for (int n = 0; n < 2; ++n) acc[a][b][m][n] = (f32x4){0.f, 0.f, 0.f, 0.f};
    bf16x8 At[4][2], B0[2][2], B1[2][2];
    const char* cA = (const char*)g.A + (size_t)cur.pm * tstepA + (size_t)cur.pn * g.a_pn_bytes; const char* cB = (const char*)g.Bt + (size_t)cur.pn * tstepB;
    if constexpr (SP2) {
        PG8_STAGE(PG8_SB(0, 0), cB, voffB); PG8_STAGE(PG8_SB(0, 1), cB + hstepB, voffB); PG8_STAGE(PG8_SA(0, 0), cA, voffA); PG8_STAGE(PG8_SA(0, 1), cA + hstepA, voffA);
        if (wr == 1) PG8_BAR;
        PG8_WAIT_V(2); PG8_BAR;
        PG8_STAGE(PG8_SB(1, 0), cB + kstep, voffB); PG8_STAGE(PG8_SA(1, 0), cA + kstep, voffA); PG8_STAGE(PG8_SB(1, 1), cB + hstepB + kstep, voffB);
        PG8_WAIT_V(6); PG8_BAR;
    } else {
        PG8_STAGE(PG8_SB(0, 0), cB, voffB); PG8_STAGE(PG8_SA(0, 0), cA, voffA); PG8_STAGE(PG8_SB(0, 1), cB + hstepB, voffB); PG8_STAGE(PG8_SA(0, 1), cA + hstepA, voffA);
        if (wr == 1) PG8_BAR;
        PG8_WAIT_V(4); PG8_BAR;
        PG8_STAGE(PG8_SB(1, 0), cB + kstep, voffB); PG8_STAGE(PG8_SA(1, 0), cA + kstep, voffA); PG8_STAGE(PG8_SB(1, 1), cB + hstepB + kstep, voffB);
        PG8_WAIT_V(6); PG8_BAR;
    }
    for (;;) {
        const bool has_next = S.next(ui + 1, nxt);
        const char* nA = has_next ? (const char*)g.A + (size_t)nxt.pm * tstepA + (size_t)nxt.pn * g.a_pn_bytes : cA; const char* nB = has_next ? (const char*)g.Bt + (size_t)nxt.pn * tstepB : cB;
        for (int t = 0; t < nt; t += 2) {
            if constexpr (Epi::MID_T > 0) { if (t == Epi::MID_T) {
#pragma unroll
                for (int ai = 0; ai < 2; ++ai)
#pragma unroll
                    for (int bj = 0; bj < 2; ++bj) E.template mid<4>(acc[ai][bj], cur.pm * BM + ai * HALF + wr * 64 + fr, cur.pn * BM + bj * HALF + wc * 32, fq); } }
            const bool last = (t == nt - 2);
            const char* a1 = cA + (size_t)(t + 1) * kstep;
            const char* a2 = last ? nA : cA + (size_t)(t + 2) * kstep; const char* b2 = last ? nB : cB + (size_t)(t + 2) * kstep;
            const char* a3 = a2 + kstep; const char* b3 = b2 + kstep;
            if constexpr (SP2) {
            PG8_LDB(B0, 0, 0); PG8_LDB(B1, 0, 1); PG8_SCHED; PG8_LDA(At, 0, 0); PG8_STAGE(PG8_SA(1, 1), a1 + hstepA, voffA);
            PG8_WAIT_V(8); PG8_WAIT_L(0); PG8_BAR; PG8_MMA(0, 0, At, B0); PG8_MMA(0, 1, At, B1); PG8_BAR; PG8_SCHED;
            PG8_LDA(At, 0, 1); PG8_STAGE(PG8_SB(0, 0), b2, voffB); PG8_STAGE(PG8_SB(0, 1), b2 + hstepB, voffB); PG8_STAGE(PG8_SA(0, 0), a2, voffA);
            PG8_WAIT_V(8); PG8_WAIT_L(0); PG8_BAR; PG8_MMA(1, 0, At, B0); PG8_MMA(1, 1, At, B1); PG8_BAR; PG8_SCHED;
            PG8_LDB(B0, 1, 0); PG8_LDB(B1, 1, 1); PG8_SCHED; PG8_LDA(At, 1, 0); PG8_STAGE(PG8_SA(0, 1), a2 + hstepA, voffA);
            PG8_WAIT_V(8); PG8_WAIT_L(0); PG8_BAR; PG8_MMA(0, 0, At, B0); PG8_MMA(0, 1, At, B1); PG8_BAR; PG8_SCHED;
            PG8_LDA(At, 1, 1); PG8_STAGE(PG8_SB(1, 0), b3, voffB); PG8_STAGE(PG8_SB(1, 1), b3 + hstepB, voffB); PG8_STAGE(PG8_SA(1, 0), a3, voffA);
            PG8_WAIT_V(8); PG8_WAIT_L(0); PG8_BAR; PG8_MMA(1, 0, At, B0); PG8_MMA(1, 1, At, B1); PG8_BAR; PG8_SCHED;
            } else {
            PG8_LDB(B0, 0, 0); PG8_SCHED; PG8_LDA(At, 0, 0); PG8_STAGE(PG8_SA(1, 1), a1 + hstepA, voffA);
            PG8_WAIT_L(8); PG8_BAR; PG8_WAIT_L(0); PG8_MMA(0, 0, At, B0); PG8_BAR; PG8_SCHED;
            PG8_LDB(B1, 0, 1); PG8_STAGE(PG8_SB(0, 0), b2, voffB);
            PG8_BAR; PG8_WAIT_L(0); PG8_MMA(0, 1, At, B1); PG8_BAR;
            PG8_LDA(At, 0, 1); PG8_STAGE(PG8_SA(0, 0), a2, voffA);
            PG8_BAR; PG8_WAIT_L(0); PG8_MMA(1, 0, At, B0); PG8_BAR; PG8_SCHED;
            PG8_STAGE(PG8_SB(0, 1), b2 + hstepB, voffB);
            PG8_WAIT_V(6); PG8_BAR; PG8_MMA(1, 1, At, B1); PG8_BAR;
            PG8_LDB(B0, 1, 0); PG8_SCHED; PG8_LDA(At, 1, 0); PG8_STAGE(PG8_SA(0, 1), a2 + hstepA, voffA);
            PG8_WAIT_L(8); PG8_BAR; PG8_WAIT_L(0); PG8_MMA(0, 0, At, B0); PG8_BAR; PG8_SCHED;
            PG8_LDB(B1, 1, 1); PG8_STAGE(PG8_SB(1, 0), b3, voffB);
            PG8_BAR; PG8_WAIT_L(0); PG8_MMA(0, 1, At, B1); PG8_BAR;
            PG8_LDA(At, 1, 1); PG8_STAGE(PG8_SA(1, 0), a3, voffA);
            PG8_BAR; PG8_WAIT_L(0); PG8_MMA(1, 0, At, B0); PG8_BAR; PG8_SCHED;
            PG8_STAGE(PG8_SB(1, 1), b3 + hstepB, voffB);
            PG8_WAIT_V(6); PG8_BAR; PG8_MMA(1, 1, At, B1); PG8_BAR;
            }
        }
        if constexpr (ALIGN_EPI) { if (wr == 0) PG8_BAR; }
#pragma unroll
        for (int ai = 0; ai < 2; ++ai)
#pragma unroll
            for (int bj = 0; bj < 2; ++bj) E.template core<4>(acc[ai][bj], cur.pm * BM + ai * HALF + wr * 64 + fr, cur.pn * BM + bj * HALF + wc * 32, fq);
        if (!has_next) break;
#pragma unroll
        for (int a = 0; a < 2; ++a)
#pragma unroll
            for (int b = 0; b < 2; ++b)
#pragma unroll
                for (int m = 0; m < 4; ++m)
#pragma unroll
                    for (int n = 0; n < 2; ++n) acc[a][b][m][n] = (f32x4){0.f, 0.f, 0.f, 0.f};
        cur = nxt; cA = nA; cB = nB; ++ui;
        if constexpr (ALIGN_EPI) { if (wr == 1) PG8_BAR; }
    }
    PG8_WAIT_V(0);
    if constexpr (!ALIGN_EPI) { if (wr == 0) PG8_BAR; }
    PG8_BAR;
#undef PG8_SA
#undef PG8_SB
#undef PG8_STAGE
#undef PG8_LDA
#undef PG8_LDB
#undef PG8_MMA
#undef PG8_WAIT_V
#undef PG8_WAIT_L
#undef PG8_BAR
#undef PG8_SCHED
}

template <class Epi>
__device__ __forceinline__ void sgemm_phase(PG8_LAS unsigned char* lds, const Gemm g, const int row_base, const int n_units, const int first, const int stride, const Epi& E, const int tid) {
    const int wid = __builtin_amdgcn_readfirstlane(tid >> 6), lane = tid & 63, wr = wid >> 1, wc = wid & 1, fr = lane & 15, fq = lane >> 4;
    const int nt = g.K / BK;
    unsigned voffA[2], voffB;
#pragma unroll
    for (int i = 0; i < 2; ++i) { int R, C; stage_rc(tid * 16 + i * 8192, R, C); voffA[i] = (unsigned)(R * g.lda + C) * 2u;
        if (i == 0) { const int Rb = Epi::PERM ? ((R & ~31) + perm32(R & 31)) : R; voffB = (unsigned)(Rb * g.ldb + C) * 2u; } }
    const unsigned ldsw = (unsigned)wid * 1024u;
    const int aoff = lds_byte(wr * 32 + fr, fq * 8), boff = 16384 + lds_byte(wc * 32 + fr, fq * 8);
    constexpr int SLOT = 24576;
#define SG_STAGE(slot, pa, pb) do { \
        __builtin_amdgcn_global_load_lds((const unsigned*)((pa) + voffA[0]), (PG8_LAS unsigned*)(lds + (slot) * SLOT + ldsw), 16, 0, 0); \
        __builtin_amdgcn_global_load_lds((const unsigned*)((pa) + voffA[1]), (PG8_LAS unsigned*)(lds + (slot) * SLOT + ldsw + 8192), 16, 0, 0); \
        __builtin_amdgcn_global_load_lds((const unsigned*)((pb) + voffB), (PG8_LAS unsigned*)(lds + (slot) * SLOT + 16384 + ldsw), 16, 0, 0); } while (0)
    const char* cA = (const char*)g.A;
    for (int ui = first; ui < n_units; ui += stride) {
        const char* cB = (const char*)g.Bt + (size_t)ui * 64 * g.ldb * 2;
        f32x4 acc[2][2];
#pragma unroll
        for (int m = 0; m < 2; ++m)
#pragma unroll
            for (int n = 0; n < 2; ++n) acc[m][n] = (f32x4){0.f, 0.f, 0.f, 0.f};
        SG_STAGE(0, cA, cB); SG_STAGE(1, cA + 128, cB + 128); SG_STAGE(2, cA + 256, cB + 256);
        for (int t = 0; t < nt; ++t) {
            if constexpr (Epi::MID_T > 0) { if (t == Epi::MID_T) E.template mid<2>(acc, row_base + wr * 32 + fr, ui * 64 + wc * 32, fq); }
            asm volatile("s_waitcnt vmcnt(6)" ::: "memory"); __builtin_amdgcn_s_barrier();
            { const int tn = (t + 3 < nt) ? t + 3 : nt - 1; const int sl = (t + 3) & 3; SG_STAGE(sl, cA + (size_t)tn * 128, cB + (size_t)tn * 128); }
            const PG8_LAS unsigned char* sp = lds + (t & 3) * SLOT;
            bf16x8 At[2][2], Bt[2][2];
#pragma unroll
            for (int m = 0; m < 2; ++m)
#pragma unroll
                for (int k = 0; k < 2; ++k) At[m][k] = *(const PG8_LAS bf16x8*)(sp + aoff + m * 2048 + k * 1024);
#pragma unroll
            for (int n = 0; n < 2; ++n)
#pragma unroll
                for (int k = 0; k < 2; ++k) Bt[n][k] = *(const PG8_LAS bf16x8*)(sp + boff + n * 2048 + k * 1024);
            asm volatile("s_waitcnt lgkmcnt(0)" ::: "memory");
            __builtin_amdgcn_sched_barrier(0);
#pragma unroll
            for (int m = 0; m < 2; ++m)
#pragma unroll
                for (int n = 0; n < 2; ++n)
#pragma unroll
                    for (int k = 0; k < 2; ++k) acc[m][n] = __builtin_amdgcn_mfma_f32_16x16x32_bf16(Bt[n][k], At[m][k], acc[m][n], 0, 0, 0);
        }
        asm volatile("s_waitcnt vmcnt(0)" ::: "memory"); __builtin_amdgcn_s_barrier();
        E.template core<2>(acc, row_base + wr * 32 + fr, ui * 64 + wc * 32, fq);
    }
#undef SG_STAGE
}
}

constexpr int NWAVES = 8;
constexpr int DM = 2048, MP = 8192, MS = 128, SEQ = 2048, MT = 8448;
constexpr int DPOOL = 1024, NH = 8, DK = 128, DV = 256, DIN = 8192, LDZ = 12288, LDY = 3072;
constexpr int ZC_AX = 0, ZC_AG = 1024, ZC_Q = 2048, ZC_K = 3072, ZC_V = 4096, ZC_BG = 6144, ZC_GA = 8192, ZC_GB = 10240;
constexpr float EPS = 1e-6f;
__host__ __device__ __forceinline__ int hm_row(int r, int h) { return r < MP ? (((r >> 11) * NH + h) * SEQ + (r & (SEQ - 1))) : (MP * NH + (r - MP) * NH + h); }
constexpr int PAST = 16384;
constexpr size_t O_YP = 0, O_YS = 16777216, O_PP = 17039360, O_RP = 17100800, O_PS = 18149376, O_RS = 20115456;

constexpr size_t MiB = 1u << 20;
constexpr size_t WS_CTL = 0, CTL_ZERO_BYTES = 1 * MiB;
constexpr size_t WS_ROPE = 1 * MiB;
constexpr size_t WS_MOD = 3 * MiB;
constexpr size_t WS_SS = 7 * MiB;
constexpr size_t WS_WCAT = 16 * MiB;
constexpr size_t WS_WAB = 64 * MiB;
constexpr size_t WS_WOUT = 76 * MiB;
constexpr size_t WS_POOLW = 84 * MiB;
constexpr size_t WS_H = 96 * MiB;
constexpr size_t WS_AX = 130 * MiB, WS_AG = 147 * MiB, WS_Q = 164 * MiB, WS_K = 181 * MiB, WS_V = 198 * MiB, WS_BG = 231 * MiB, WS_GA = 264 * MiB, WS_GB = 297 * MiB;
constexpr size_t WS_Z = WS_AX;
constexpr size_t WS_YAB = 330 * MiB;
constexpr size_t WS_POOLED = 380 * MiB;
constexpr size_t WS_SN = 397 * MiB;
constexpr size_t WS_MB = 430 * MiB;
constexpr size_t WS_END = 464 * MiB;
constexpr int CW_BAR = 4096;

constexpr int RING_OFF = 0, RING_BYTES = 131072;
constexpr int LDSCTL_OFF = RING_BYTES, MISC_OFF = LDSCTL_OFF + 320;
constexpr int STAT_OFF = RING_BYTES + 1024;
constexpr int LDS_BYTES = 147456;

#define GAS __attribute__((address_space(1)))
#define LAS __attribute__((address_space(3)))
typedef unsigned short bf16;
typedef unsigned v4u __attribute__((ext_vector_type(4)));
typedef unsigned v2u __attribute__((ext_vector_type(2)));
typedef float f32x4 __attribute__((ext_vector_type(4)));
typedef float f32x16 __attribute__((ext_vector_type(16)));
typedef short bf16x8 __attribute__((ext_vector_type(8)));
typedef short s16x4 __attribute__((ext_vector_type(4)));
typedef GAS unsigned gu32;
#define RLX_AGENT __ATOMIC_RELAXED, __HIP_MEMORY_SCOPE_AGENT
#define LDS_WAIT() asm volatile("s_waitcnt lgkmcnt(0)" ::: "memory")
#define VM_WAIT() asm volatile("s_waitcnt vmcnt(0)" ::: "memory")
__device__ __forceinline__ unsigned f2bf(float f) { unsigned u = __builtin_bit_cast(unsigned, f); return (u + 0x7fffu + ((u >> 16) & 1u)) >> 16; }
__device__ __forceinline__ unsigned pk2(float lo, float hi) { return f2bf(lo) | (f2bf(hi) << 16); }
__device__ __forceinline__ float bflo(unsigned w) { return __uint_as_float(w << 16); }
__device__ __forceinline__ float bfhi(unsigned w) { return __uint_as_float(w & 0xffff0000u); }
__device__ __forceinline__ float bf1(bf16 b) { return __uint_as_float((unsigned)b << 16); }
__device__ __forceinline__ float silu_(float v) { return v * __builtin_amdgcn_rcpf(1.0f + __builtin_amdgcn_exp2f(-1.4426950408889634f * v)); }
__device__ __forceinline__ float wave_sum(float v) {
#pragma unroll
    for (int o = 1; o < 64; o <<= 1) v += __shfl_xor(v, o);
    return v;
}
__device__ __forceinline__ float lg2gamma(int h) {
    const float t[8] = {-0.04580368961312479f, -0.02272007650008353f, -0.011315313227834146f, -0.005646563141142063f, -0.0028205190623786626f, -0.0014095702546713536f, -0.0007046129765893727f, -0.0003522634716290214f};
    float r = t[0];
#pragma unroll
    for (int i = 1; i < 8; ++i) r = (h == i) ? t[i] : r;
    return r;
}

__device__ __forceinline__ int fresh_lane() { unsigned m_ = ~0u; asm volatile("" : "+s"(m_)); return (int)__builtin_amdgcn_mbcnt_hi(m_, __builtin_amdgcn_mbcnt_lo(m_, 0u)); }
#define XB_TMO      128
#define XB_XCNT(j)  (256  + 64 * (j))
#define XB_XSUB(j)  (1280 + 64 * (j))
#define XB_XGEN(j)  (2304 + 64 * (j))
#define XB_TOP      3328
#define XB_TOPGEN   3392
#define XCD_BAR_WORDS 3456
#define XB_SPIN_CAP (1u << 18)
__device__ __forceinline__ unsigned xb_ld(unsigned* p)              { return __hip_atomic_load(p, __ATOMIC_RELAXED, __HIP_MEMORY_SCOPE_AGENT); }
__device__ __forceinline__ unsigned xb_add(unsigned* p, unsigned v) { return __hip_atomic_fetch_add(p, v, __ATOMIC_RELAXED, __HIP_MEMORY_SCOPE_AGENT); }
__device__ __forceinline__ unsigned xb_xcc_id() { return (unsigned)__builtin_amdgcn_s_getreg((3 << 11) | 20) & 0xFu; }
#define XB_SPIN(cond, bar) do { unsigned _sp = 0; while (cond) { __builtin_amdgcn_s_sleep(1); \
    if ((++_sp & 255u) == 0u) { if (xb_ld(&(bar)[XB_TMO])) break; if (_sp > XB_SPIN_CAP) { atomicAdd(&(bar)[XB_TMO], 1u); break; } } } } while (0)
struct XcdBarrier { unsigned* bar; unsigned x; volatile LAS unsigned* st; int wave; };
__device__ __forceinline__ XcdBarrier xcd_barrier_post(unsigned* bar, volatile LAS unsigned* st, int wave) {
    XcdBarrier b; b.bar = bar; b.x = xb_xcc_id(); b.st = st; b.wave = wave;
    if (wave == 0 && fresh_lane() == 0) (void)xb_add(&bar[XB_XCNT(b.x)], 1u);
    return b;
}
__device__ __forceinline__ void xcd_barrier_complete(unsigned* bar, unsigned x, unsigned& nloc, unsigned& nx) {
    const unsigned G = gridDim.x * gridDim.y * gridDim.z;
    unsigned sum, cnt, mine, sp = 0u;
    for (;;) {
        sum = 0u; cnt = 0u; mine = 0u;
#pragma unroll
        for (unsigned j = 0; j < 16; ++j) { const unsigned c = xb_ld(&bar[XB_XCNT(j)]); sum += c; cnt += (c > 0u) ? 1u : 0u; mine = (j == x) ? c : mine; }
        if (sum == G) break;
        __builtin_amdgcn_s_sleep(1);
        if ((++sp & 255u) == 0u) { if (xb_ld(&bar[XB_TMO])) break; if (sp > XB_SPIN_CAP) { atomicAdd(&bar[XB_TMO], 1u); break; } }
    }
    nloc = mine > 0u ? mine : 1u; nx = cnt > 0u ? cnt : 1u;
}
__device__ __forceinline__ void xcd_barrier(const XcdBarrier& b) {
    asm volatile("s_waitcnt vmcnt(0)" ::: "memory");
    __syncthreads();
    if (b.wave == 0 && fresh_lane() == 0) {
        unsigned* bar = b.bar;
        __builtin_amdgcn_s_waitcnt(0);
        unsigned nloc = b.st[0], nx = b.st[1];
        if (nloc == 0u) { xcd_barrier_complete(bar, b.x, nloc, nx); b.st[0] = nloc; b.st[1] = nx; }
        const unsigned old = xb_add(&bar[XB_XSUB(b.x)], 1u);
        const unsigned gen = old / nloc;
        if (old + 1u == (gen + 1u) * nloc) {
            __builtin_amdgcn_fence(__ATOMIC_RELEASE, "agent");
            asm volatile("s_waitcnt vmcnt(0)" ::: "memory");
            const unsigned og = xb_add(&bar[XB_TOP], 1u);
            const unsigned tg = og / nx;
            if (og + 1u == (tg + 1u) * nx) xb_add(&bar[XB_TOPGEN], 1u);
            else XB_SPIN(xb_ld(&bar[XB_TOPGEN]) == tg, bar);
            __builtin_amdgcn_fence(__ATOMIC_ACQUIRE, "agent");
            xb_add(&bar[XB_XGEN(b.x)], 1u);
            asm volatile("s_waitcnt vmcnt(0)" ::: "memory");
        } else {
            XB_SPIN(xb_ld(&bar[XB_XGEN(b.x)]) == gen, bar);
            __builtin_amdgcn_fence(__ATOMIC_ACQUIRE, "agent");
            asm volatile("s_waitcnt vmcnt(0)" ::: "memory");
        }
    }
    __syncthreads();
}

struct Frame {
    LAS unsigned char* lds;
    volatile LAS unsigned* MISC;
    gu32* ctl;
    int tid, lane, wave;
    int vcu, G;
    const float *x_p, *x_s, *st_pool, *st_ret, *c_p, *c_s, *ada_w, *ada_b, *g_pre, *g_post, *w_in, *pool_w, *pool_scale, *gn_g, *w_a, *w_b, *w_merge, *b_merge, *w_out;
    float* out;
    float *ropec, *ropes, *mod, *ss;
    bf16 *Wcat, *Wab, *Wout, *PoolW, *H, *AX, *AG, *Qb, *Kb, *Vb, *BG, *GA, *GB, *YAB, *POOLED, *SN, *MB;
};

struct EpiZ {
    static constexpr bool PERM = true; static constexpr int MID_T = 0;
    bf16 *AX, *AG, *Qb, *Kb, *Vb, *BG, *GA, *GB; const float* bmerge; const float* ropec; const float* ropes; float* out_pp; float* out_ps;
    template <int NM> __device__ __forceinline__ void core(const pg8::f32x4 (&a)[NM][2], int row0, int cs, int fq) const {
        using namespace pg8;
        if (cs >= ZC_Q && cs < ZC_V) {
            const float ksc = (cs >= ZC_K) ? 0.08838834764831845f : 1.0f;
            const int j0 = 16 * ((cs & 127) >> 5) + 4 * fq, hd = (cs >> 7) & 7; bf16* qk = (cs >= ZC_K) ? Kb : Qb;
#pragma unroll
            for (int m = 0; m < NM; ++m) {
                const int row = row0 + m * 16; const int pos = row < MP ? (row & (SEQ - 1)) : SEQ;
                const f32x4 c4 = *(const f32x4*)(ropec + pos * 64 + j0), s4 = *(const f32x4*)(ropes + pos * 64 + j0);
                bf16* rowp = qk + (size_t)hm_row(row, hd) * DK + j0;
                const f32x4 v0 = a[m][0], v1 = a[m][1];
                const f32x4 o1 = (v0 * c4 - v1 * s4) * ksc, o2 = (v0 * s4 + v1 * c4) * ksc;
                u32x2 w1, w2; w1.x = cvt_pk_bf16(o1[0], o1[1]); w1.y = cvt_pk_bf16(o1[2], o1[3]); w2.x = cvt_pk_bf16(o2[0], o2[1]); w2.y = cvt_pk_bf16(o2[2], o2[3]);
                *(u32x2*)rowp = w1; *(u32x2*)(rowp + 64) = w2;
            }
            return;
        }
        const int act = (cs >= ZC_GA) ? 2 : (((cs >= ZC_AG && cs < ZC_Q) || (cs >= ZC_BG)) ? 1 : 0);
        const int col = cs + 8 * fq;
        f32x4 bv[2];
#pragma unroll
        for (int n = 0; n < 2; ++n) bv[n] = (act == 2) ? *(const f32x4*)(bmerge + (col - ZC_GA) + 4 * n) : (f32x4){0.f, 0.f, 0.f, 0.f};
#pragma unroll
        for (int m = 0; m < NM; ++m) {
            const int row = row0 + m * 16;
            f32x4 v0 = a[m][0] + bv[0], v1 = a[m][1] + bv[1];
            if (act == 1) {
#pragma unroll
                for (int e = 0; e < 4; ++e) { v0[e] = silu_(v0[e]); v1[e] = silu_(v1[e]); }
            } else if (act == 2) {
#pragma unroll
                for (int e = 0; e < 4; ++e) { v0[e] = sigmoidf_(v0[e]); v1[e] = sigmoidf_(v1[e]); }
            }
            u32x4 w; w.x = cvt_pk_bf16(v0[0], v0[1]); w.y = cvt_pk_bf16(v0[2], v0[3]); w.z = cvt_pk_bf16(v1[0], v1[1]); w.w = cvt_pk_bf16(v1[2], v1[3]);
            bf16* dst = (cs < ZC_AG) ? AX + (size_t)row * DPOOL + col : (cs < ZC_Q) ? AG + (size_t)row * DPOOL + (col - ZC_AG) : (cs < ZC_BG) ? Vb + (size_t)hm_row(row, (cs - ZC_V) >> 8) * DV + (col & 255)
                      : (cs < ZC_GA) ? BG + (size_t)hm_row(row, (cs - ZC_BG) >> 8) * DV + (col & 255) : (cs < ZC_GB) ? GA + (size_t)row * DM + (col - ZC_GA) : GB + (size_t)row * DM + (col - ZC_GB);
            *(u32x4*)dst = w;
            if (cs < ZC_AG) {
                if (row < MP) { const int t = row & (SEQ - 1); if (t >= SEQ - 15) { float* o = out_pp + ((size_t)((row >> 11) * 15 + (t - (SEQ - 15)))) * DPOOL + col; *(f32x4*)o = v0; *(f32x4*)(o + 4) = v1; } }
                else if (row < MP + MS) { float* o = out_ps + ((size_t)((row - MP) * 15 + 14)) * DPOOL + col; *(f32x4*)o = v0; *(f32x4*)(o + 4) = v1; }
            }
        }
    }
    template <int NM> __device__ __forceinline__ void mid(pg8::f32x4 (&)[NM][2], int, int, int) const {}
};
struct EpiPool {
    static constexpr bool PERM = true; static constexpr int MID_T = 0;
    bf16* Y; const bf16* AG; const float* pscale;
    template <int NM> __device__ __forceinline__ void core(const pg8::f32x4 (&a)[NM][2], int row0, int cs, int fq) const {
        using namespace pg8;
        const int col = cs + 8 * fq;
        const f32x4 ps0 = *(const f32x4*)(pscale + col), ps1 = *(const f32x4*)(pscale + col + 4);
#pragma unroll
        for (int m = 0; m < NM; ++m) {
            const int row = row0 + m * 16;
            const u32x4 g = *(const u32x4*)(AG + (size_t)row * DPOOL + col);
            f32x4 v0 = a[m][0] * ps0, v1 = a[m][1] * ps1;
            v0[0] *= bf_lo(g.x); v0[1] *= bf_hi(g.x); v0[2] *= bf_lo(g.y); v0[3] *= bf_hi(g.y);
            v1[0] *= bf_lo(g.z); v1[1] *= bf_hi(g.z); v1[2] *= bf_lo(g.w); v1[3] *= bf_hi(g.w);
            u32x4 w; w.x = cvt_pk_bf16(v0[0], v0[1]); w.y = cvt_pk_bf16(v0[2], v0[3]); w.z = cvt_pk_bf16(v1[0], v1[1]); w.w = cvt_pk_bf16(v1[2], v1[3]);
            *(u32x4*)(Y + (size_t)row * LDY + col) = w;
        }
    }
    template <int NM> __device__ __forceinline__ void mid(pg8::f32x4 (&)[NM][2], int, int, int) const {}
};
struct EpiMerge {
    static constexpr bool PERM = true; static constexpr int MID_T = 16;
    bf16* O; const bf16* GA; const bf16* GB;
    template <int NM> __device__ __forceinline__ void mid(pg8::f32x4 (&a)[NM][2], int row0, int cs, int fq) const {
        using namespace pg8;
        const size_t zoff = (size_t)row0 * DM + cs + 8 * fq; const bf16* za = GA + zoff; const bf16* zb = GB + zoff;
        asm volatile("" : "+v"(za), "+v"(zb));
#pragma unroll
        for (int m = 0; m < NM; ++m) {
            const u32x4 ga = *(const u32x4*)(za + (size_t)(m * 16) * DM), gb = *(const u32x4*)(zb + (size_t)(m * 16) * DM);
            f32x4& v0 = a[m][0]; f32x4& v1 = a[m][1];
            v0[0] *= bf_lo(ga.x) * __builtin_amdgcn_rcpf(bf_lo(gb.x)); v0[1] *= bf_hi(ga.x) * __builtin_amdgcn_rcpf(bf_hi(gb.x)); v0[2] *= bf_lo(ga.y) * __builtin_amdgcn_rcpf(bf_lo(gb.y)); v0[3] *= bf_hi(ga.y) * __builtin_amdgcn_rcpf(bf_hi(gb.y));
            v1[0] *= bf_lo(ga.z) * __builtin_amdgcn_rcpf(bf_lo(gb.z)); v1[1] *= bf_hi(ga.z) * __builtin_amdgcn_rcpf(bf_hi(gb.z)); v1[2] *= bf_lo(ga.w) * __builtin_amdgcn_rcpf(bf_lo(gb.w)); v1[3] *= bf_hi(ga.w) * __builtin_amdgcn_rcpf(bf_hi(gb.w));
            if (m & 1) asm volatile("" ::: "memory");
        }
    }
    template <int NM> __device__ __forceinline__ void core(const pg8::f32x4 (&a)[NM][2], int row0, int cs, int fq) const {
        using namespace pg8;
        const int col = cs + 8 * fq;
#pragma unroll
        for (int m = 0; m < NM; ++m) {
            const int row = row0 + m * 16;
            const u32x4 g = *(const u32x4*)(GB + (size_t)row * DM + col);
            f32x4 v0 = a[m][0], v1 = a[m][1];
            v0[0] *= bf_lo(g.x); v0[1] *= bf_hi(g.x); v0[2] *= bf_lo(g.y); v0[3] *= bf_hi(g.y);
            v1[0] *= bf_lo(g.z); v1[1] *= bf_hi(g.z); v1[2] *= bf_lo(g.w); v1[3] *= bf_hi(g.w);
            u32x4 w; w.x = cvt_pk_bf16(v0[0], v0[1]); w.y = cvt_pk_bf16(v0[2], v0[3]); w.z = cvt_pk_bf16(v1[0], v1[1]); w.w = cvt_pk_bf16(v1[2], v1[3]);
            *(u32x4*)(O + (size_t)row * DM + col) = w;
        }
    }
};
struct EpiOut {
    static constexpr bool PERM = true; static constexpr int MID_T = 0;
    bf16* O2; float* ss;
    template <int NM> __device__ __forceinline__ void core(const pg8::f32x4 (&a)[NM][2], int row0, int cs, int fq) const {
        using namespace pg8;
#pragma unroll
        for (int m = 0; m < NM; ++m) {
            const int row = row0 + m * 16;
            float s = 0.f;
#pragma unroll
            for (int n = 0; n < 2; ++n) { const f32x4 v = a[m][n]; s += (v[0] * v[0] + v[1] * v[1]) + (v[2] * v[2] + v[3] * v[3]); }
            s += __shfl_xor(s, 16); s += __shfl_xor(s, 32);
            if (fq == 0) ss[(size_t)row * 64 + (cs >> 5)] = s;
            const f32x4 v0 = a[m][0], v1 = a[m][1];
            u32x4 w; w.x = cvt_pk_bf16(v0[0], v0[1]); w.y = cvt_pk_bf16(v0[2], v0[3]); w.z = cvt_pk_bf16(v1[0], v1[1]); w.w = cvt_pk_bf16(v1[2], v1[3]);
            *(u32x4*)(O2 + (size_t)row * DM + cs + 8 * fq) = w;
        }
    }
    template <int NM> __device__ __forceinline__ void mid(pg8::f32x4 (&)[NM][2], int, int, int) const {}
};

__device__ __forceinline__ int rot_row(int n) { const int L = n & 127, hf = L >> 6, j = L & 63; return (n & ~127) + 32 * (j >> 4) + 8 * ((j >> 2) & 3) + 4 * hf + (j & 3); }
__device__ __forceinline__ void p0_transpose_item(const float* W, int N, bf16* WT, int ldw, int row_off, int koff, int rot_lo, int rot_hi, LAS float* scr, int item, int lane) {
    const int nblk = N / 32, kb = item / nblk, nb = item % nblk, k0 = 64 * kb, n0 = 32 * nb;
#pragma unroll 8
    for (int i = 0; i < 32; ++i) { const int kk = 2 * i + (lane >> 5); scr[kk * 33 + (lane & 31)] = __builtin_nontemporal_load(W + (size_t)(k0 + kk) * N + n0 + (lane & 31)); }
    LDS_WAIT(); asm volatile("" ::: "memory");
    const int c = lane & 7;
#pragma unroll
    for (int j = 0; j < 4; ++j) { const int n = (lane >> 3) + 8 * j; const LAS float* s = scr + (8 * c) * 33 + n;
        v4u o; o.x = pk2(s[0 * 33], s[1 * 33]); o.y = pk2(s[2 * 33], s[3 * 33]); o.z = pk2(s[4 * 33], s[5 * 33]); o.w = pk2(s[6 * 33], s[7 * 33]);
        int nn = n0 + n; if (nn >= rot_lo && nn < rot_hi) nn = rot_row(nn);
        *(GAS v4u*)(WT + (size_t)(row_off + nn) * ldw + koff + k0 + 8 * c) = o; }
    LDS_WAIT(); asm volatile("" ::: "memory");
}
__device__ __forceinline__ void p0_mod_item(Frame& F, int strip) {
    const int n0 = strip * 32, lane = F.lane, fr = lane & 15, fq = lane >> 4, wave = F.wave;
    f32x4 acc[9][2];
#pragma unroll
    for (int a = 0; a < 9; ++a) { acc[a][0] = (f32x4){0.f, 0.f, 0.f, 0.f}; acc[a][1] = (f32x4){0.f, 0.f, 0.f, 0.f}; }
    for (int ks = 0; ks < 8; ++ks) {
        const int k0 = wave * 256 + ks * 32 + 8 * fq;
        bf16x8 bfr[2];
#pragma unroll
        for (int nt = 0; nt < 2; ++nt) {
            float w[8];
#pragma unroll
            for (int j = 0; j < 8; ++j) w[j] = __builtin_nontemporal_load(F.ada_w + (size_t)(k0 + j) * 6144 + n0 + 16 * nt + fr);
            v4u p; p.x = pk2(w[0], w[1]); p.y = pk2(w[2], w[3]); p.z = pk2(w[4], w[5]); p.w = pk2(w[6], w[7]);
            bfr[nt] = __builtin_bit_cast(bf16x8, p);
        }
#pragma unroll
        for (int mt = 0; mt < 9; ++mt) {
            const int row = 16 * mt + fr;
            f32x4 a0 = (f32x4){0.f, 0.f, 0.f, 0.f}, a1 = a0;
            if (row < 132) { const float* cp = (row < 4 ? F.c_p + (size_t)row * DM : F.c_s + (size_t)(row - 4) * DM) + k0; a0 = *(const f32x4*)cp; a1 = *(const f32x4*)(cp + 4); }
            v4u p; p.x = pk2(silu_(a0[0]), silu_(a0[1])); p.y = pk2(silu_(a0[2]), silu_(a0[3])); p.z = pk2(silu_(a1[0]), silu_(a1[1])); p.w = pk2(silu_(a1[2]), silu_(a1[3]));
            const bf16x8 afr = __builtin_bit_cast(bf16x8, p);
            acc[mt][0] = __builtin_amdgcn_mfma_f32_16x16x32_bf16(afr, bfr[0], acc[mt][0], 0, 0, 0);
            acc[mt][1] = __builtin_amdgcn_mfma_f32_16x16x32_bf16(afr, bfr[1], acc[mt][1], 0, 0, 0);
        }
    }
    LAS float* red = (LAS float*)F.lds;
    for (int w = 0; w < 8; ++w) {
        if (wave == w) {
#pragma unroll
            for (int mt = 0; mt < 9; ++mt)
#pragma unroll
                for (int nt = 0; nt < 2; ++nt)
#pragma unroll
                    for (int r = 0; r < 4; ++r) { const int idx = (16 * mt + 4 * fq + r) * 32 + 16 * nt + fr; if (w == 0) red[idx] = acc[mt][nt][r]; else red[idx] += acc[mt][nt][r]; }
        }
        __syncthreads();
    }
    for (int i = F.tid; i < 132 * 32; i += NWAVES * 64) { const int r = i >> 5, cc = i & 31; F.mod[(size_t)r * 6144 + n0 + cc] = red[i] + F.ada_b[n0 + cc]; }
    __syncthreads();
}
__device__ __forceinline__ void rope_entry(int prow, int i, float* cosT, float* sinT) {
    double th = 1.0, bs = 0.8659643233600653;
    for (int e = i; e; e >>= 1) { if (e & 1) th *= bs; bs *= bs; }
    const double t2 = th * th; double c = 1.0, s = th, tc = 1.0, ts = th;
#pragma unroll 1
    for (int n = 1; n <= 12; ++n) { tc *= -t2 / (double)((2 * n - 1) * (2 * n)); c += tc; ts *= -t2 / (double)((2 * n) * (2 * n + 1)); s += ts; }
    const int pos = prow < SEQ ? prow : PAST;
    double rc = 1.0, rs = 0.0, bc = c, bn = s;
    for (int e = pos; e; e >>= 1) { if (e & 1) { const double t = rc * bc - rs * bn; rs = rc * bn + rs * bc; rc = t; } const double t = bc * bc - bn * bn; bn = 2.0 * bc * bn; bc = t; }
    cosT[prow * 64 + i] = (float)rc; sinT[prow * 64 + i] = (float)rs;
}
__device__ __forceinline__ void p0_prologue(Frame& F, const bool late) {
    if (!late && F.vcu < 192) for (int s = F.vcu; s < 192; s += F.G) p0_mod_item(F, s);
    LAS float* scr = (LAS float*)(F.lds + RING_OFF + F.wave * 16384);
    const int gw = F.vcu * NWAVES + F.wave, NGW = F.G * NWAVES;
    constexpr int I_IN = 32 * 256, I_MG = 32 * 128, I_A = 16 * 64, I_B = 32 * 64, I_O = 32 * 64, I_P = 4 * 8;
    constexpr int NITEMS = I_IN + I_MG + I_A + I_B + I_O + 4 * I_P;
    const int it_lo = late ? I_IN + I_MG : 0, it_hi = late ? NITEMS : I_IN + I_MG;
    for (int it = it_lo + gw; it < it_hi; it += NGW) {
        int r = it;
        if (r < I_IN) { p0_transpose_item(F.w_in, DIN, F.Wcat, DM, 0, 0, ZC_Q, ZC_V, scr, r, F.lane); continue; } r -= I_IN;
        if (r < I_MG) { p0_transpose_item(F.w_merge, 4096, F.Wcat, DM, DIN, 0, 0, 0, scr, r, F.lane); continue; } r -= I_MG;
        if (r < I_A) { p0_transpose_item(F.w_a, DM, F.Wab, LDY, 0, 0, 0, 0, scr, r, F.lane); continue; } r -= I_A;
        if (r < I_B) { p0_transpose_item(F.w_b, DM, F.Wab, LDY, 0, 1024, 0, 0, scr, r, F.lane); continue; } r -= I_B;
        if (r < I_O) { p0_transpose_item(F.w_out, DM, F.Wout, DM, 0, 0, 0, 0, scr, r, F.lane); continue; } r -= I_O;
        { const int g = r / I_P; p0_transpose_item(F.pool_w + (size_t)g * 65536, 256, F.PoolW, 256, g * 256, 0, 0, 0, scr, r % I_P, F.lane); }
    }
    if (late) return;
    const int gt = F.vcu * (NWAVES * 64) + F.tid, NGT = F.G * NWAVES * 64;
    for (int e = gt; e < 2049 * 64; e += NGT) rope_entry(e >> 6, e & 63, F.ropec, F.ropes);
}

__device__ __forceinline__ void h_row(Frame& F, const float* xrow, const float* modrow, bf16* orow) {
    const GAS f32x4* xr = (const GAS f32x4*)xrow + F.lane;
    f32x4 v[8]; float s = 0.f;
#pragma unroll
    for (int j = 0; j < 8; ++j) { v[j] = xr[64 * j]; s += (v[j].x * v[j].x + v[j].y * v[j].y) + (v[j].z * v[j].z + v[j].w * v[j].w); }
    const float rstd = 1.0f / sqrtf(wave_sum(s) * (1.0f / DM) + EPS);
    GAS v2u* o8 = (GAS v2u*)orow + F.lane;
#pragma unroll
    for (int j = 0; j < 8; ++j) {
        const int col = 4 * F.lane + 256 * j;
        const f32x4 g = *(const f32x4*)(F.g_pre + col), sh = *(const f32x4*)(modrow + col), sc = *(const f32x4*)(modrow + DM + col);
        const f32x4 o = v[j] * rstd * g * (sc + 1.0f) + sh;
        v2u w; w.x = pk2(o.x, o.y); w.y = pk2(o.z, o.w); o8[64 * j] = w;
    }
}

__device__ __forceinline__ unsigned off_a(unsigned row, unsigned ch) { return 2048u * (row >> 3) + 512u * (ch >> 2) + 64u * (row & 7) + 16u * ((ch & 3) ^ ((row >> 2) & 3)); }
struct RowA { unsigned e, d; };
struct TrA { unsigned t0, t1; };
__device__ __forceinline__ RowA row_addr(unsigned lane) { RowA r; r.e = off_a(lane & 31, lane >> 5); r.d = off_a(lane & 31, 2 + (lane >> 5)) - r.e; return r; }
__device__ __forceinline__ TrA tr_addr(unsigned lane) { const unsigned h = lane >> 5, blk = (lane >> 4) & 1, q = (lane & 15) >> 2, p = lane & 3; TrA t;
    t.t0 = off_a(8 * h + q, 2 * blk + (p >> 1)) + 8 * (p & 1); t.t1 = off_a(8 * h + 4 + q, 2 * blk + (p >> 1)) + 8 * (p & 1); return t; }
__device__ __forceinline__ bf16x8 frag_row(const LAS unsigned char* img, const RowA& ra, int s) { return *(const LAS bf16x8*)(img + (ra.e + (unsigned)(s & 1) * ra.d + 512u * (unsigned)(s >> 1))); }
__device__ __forceinline__ bf16x8 frag_tr(const LAS unsigned char* img, const TrA& ta, int c, int ks) {
    const s16x4 lo = __builtin_bit_cast(s16x4, __builtin_amdgcn_ds_read_tr16_b64_v4i16((LAS s16x4*)(img + ta.t0 + 512 * c + 4096 * ks)));
    const s16x4 hi = __builtin_bit_cast(s16x4, __builtin_amdgcn_ds_read_tr16_b64_v4i16((LAS s16x4*)(img + ta.t1 + 512 * c + 4096 * ks)));
    return __builtin_shufflevector(lo, hi, 0, 1, 2, 3, 4, 5, 6, 7);
}
#define MFMA32(a, b, c) __builtin_amdgcn_mfma_f32_32x32x16_bf16((a), (b), (c), 0, 0, 0)
__device__ __forceinline__ int crow(int reg, int h) { return (reg & 3) + 8 * (reg >> 2) + 4 * h; }

__device__ __forceinline__ void ret_ab_unit(Frame& F, int unit) {
    const int bh = unit >> 3, dh = (unit >> 2) & 1, dq = unit & 3, b = bh >> 3, h = bh & 7, lane = fresh_lane(), wave = F.wave, hh = lane >> 5, tid_ = wave * 64 + lane;
    const float lg = lg2gamma(h);
    const float cdec = __builtin_amdgcn_exp2f(128.0f * lg);
    const int di = wave & 1, dj = (wave >> 1) & 1;
    const TrA ta = tr_addr(lane);
    f32x16 acc;
#pragma unroll
    for (int e = 0; e < 16; ++e) acc[e] = 0.f;
    const bf16* Kh = F.Kb + (size_t)bh * SEQ * DK + dh * 64; const bf16* Vh = F.Vb + (size_t)bh * SEQ * DV + dq * 64;
    v4u r0[4], r1[4];
#define AB_LOAD(c, R) do { _Pragma("unroll") for (int i = 0; i < 2; ++i) { const int n = tid_ + 512 * i, row = n >> 3, ch = n & 7; const size_t tr_ = (size_t)((c) * 128 + row); \
        R[i] = *(const GAS v4u*)(Kh + tr_ * DK + ch * 8); R[2 + i] = *(const GAS v4u*)(Vh + tr_ * DV + ch * 8); } } while (0)
#define AB_STORE(buf, R) do { _Pragma("unroll") for (int i = 0; i < 2; ++i) { const int n = tid_ + 512 * i, row = n >> 3, ch = n & 7; \
        const float d = __builtin_amdgcn_exp2f((float)(127 - row) * lg); v4u kk = R[i]; \
        kk.x = pk2(bflo(kk.x) * d, bfhi(kk.x) * d); kk.y = pk2(bflo(kk.y) * d, bfhi(kk.y) * d); kk.z = pk2(bflo(kk.z) * d, bfhi(kk.z) * d); kk.w = pk2(bflo(kk.w) * d, bfhi(kk.w) * d); \
        const unsigned o = (unsigned)(buf) * 65536u + (unsigned)(row >> 5) * 8192u + off_a(row & 31, ch); \
        *(LAS v4u*)(F.lds + o) = kk; *(LAS v4u*)(F.lds + 32768u + o) = R[2 + i]; } } while (0)
#define AB_STEP(c, RC, RN) do { \
        if ((c) + 2 < 16) AB_LOAD((c) + 2, RC); \
        if (wave < 4) { \
            if ((c) > 0) { v4u w0, w1; w0.x = pk2(acc[0], acc[1]); w0.y = pk2(acc[2], acc[3]); w0.z = pk2(acc[4], acc[5]); w0.w = pk2(acc[6], acc[7]); \
                w1.x = pk2(acc[8], acc[9]); w1.y = pk2(acc[10], acc[11]); w1.z = pk2(acc[12], acc[13]); w1.w = pk2(acc[14], acc[15]); \
                bf16* sn = F.SN + ((((size_t)(bh * 16 + (c)) * 32 + (2 * dh + di) * 8 + (2 * dq + dj)) * 64 + lane) * 16); \
                *(GAS v4u*)sn = w0; *(GAS v4u*)(sn + 8) = w1; } \
            _Pragma("unroll") for (int e = 0; e < 16; ++e) acc[e] *= cdec; \
            const LAS unsigned char* kb = F.lds + ((c) & 1) * 65536; const LAS unsigned char* vb = kb + 32768; \
            _Pragma("unroll") for (int kk = 0; kk < 8; ++kk) acc = MFMA32(frag_tr(kb + (kk >> 1) * 8192, ta, di, kk & 1), frag_tr(vb + (kk >> 1) * 8192, ta, dj, kk & 1), acc); \
        } \
        if ((c) + 1 < 16) AB_STORE(((c) + 1) & 1, RN); \
        __syncthreads(); } while (0)
    AB_LOAD(0, r0); AB_LOAD(1, r1); AB_STORE(0, r0); __syncthreads();
#pragma unroll 1
    for (int c = 0; c < 16; c += 2) { AB_STEP(c, r0, r1); AB_STEP(c + 1, r1, r0); }
#undef AB_LOAD
#undef AB_STORE
#undef AB_STEP
    if (wave < 4) {
        float* so = F.out + O_RP + (size_t)bh * (DK * DV);
        const int dv = 64 * dq + 32 * dj + (lane & 31);
#pragma unroll
        for (int e = 0; e < 16; ++e) so[(size_t)(64 * dh + 32 * di + crow(e, hh)) * DV + dv] = acc[e];
    }
}

__device__ __forceinline__ void pooled_prompt(Frame& F, int it0, int it1) {
    for (int it = it0 + F.tid; it < it1; it += NWAVES * 64) {
        const int row = it >> 7, q = it & 127, t = row & (SEQ - 1), w = 2 << (q >> 5), cnt = (t + 1 < w) ? t + 1 : w;
        const bf16* p = F.AX + (size_t)row * DPOOL + q * 8;
        v4u x[16];
#pragma unroll
        for (int j = 0; j < 16; ++j) x[j] = (j < cnt) ? *(const GAS v4u*)(p - (size_t)j * DPOOL) : (v4u){0u, 0u, 0u, 0u};
        float s[8] = {0.f, 0.f, 0.f, 0.f, 0.f, 0.f, 0.f, 0.f};
#pragma unroll
        for (int j = 0; j < 16; ++j) { s[0] += bflo(x[j].x); s[1] += bfhi(x[j].x); s[2] += bflo(x[j].y); s[3] += bfhi(x[j].y); s[4] += bflo(x[j].z); s[5] += bfhi(x[j].z); s[6] += bflo(x[j].w); s[7] += bfhi(x[j].w); }
        const float inv = 1.0f / (float)cnt;
        const float a[8] = {bflo(x[0].x), bfhi(x[0].x), bflo(x[0].y), bfhi(x[0].y), bflo(x[0].z), bfhi(x[0].z), bflo(x[0].w), bfhi(x[0].w)};
        v4u o; o.x = pk2(s[0] * inv - a[0], s[1] * inv - a[1]); o.y = pk2(s[2] * inv - a[2], s[3] * inv - a[3]); o.z = pk2(s[4] * inv - a[4], s[5] * inv - a[5]); o.w = pk2(s[6] * inv - a[6], s[7] * inv - a[7]);
        *(GAS v4u*)(F.POOLED + (size_t)row * DPOOL + q * 8) = o;
    }
}
__device__ __forceinline__ void pooled_sample(Frame& F, int it0, int it1) {
    for (int it = it0 + F.tid; it < it1; it += NWAVES * 64) {
        const int bs = it >> 7, q = it & 127, w = 2 << (q >> 5);
        const v4u x = *(const GAS v4u*)(F.AX + (size_t)(MP + bs) * DPOOL + q * 8);
        float a[8] = {bflo(x.x), bfhi(x.x), bflo(x.y), bfhi(x.y), bflo(x.z), bfhi(x.z), bflo(x.w), bfhi(x.w)}, s[8];
#pragma unroll
        for (int e = 0; e < 8; ++e) s[e] = a[e];
        const float* sp = F.st_pool + (size_t)bs * 15 * DPOOL + q * 8;
        float* op = F.out + O_PS + (size_t)bs * 15 * DPOOL + q * 8;
#pragma unroll
        for (int i = 14; i >= 0; --i) {
            const f32x4 b0 = *(const f32x4*)(sp + (size_t)i * DPOOL), b1 = *(const f32x4*)(sp + (size_t)i * DPOOL + 4);
            if (i >= 1) { *(f32x4*)(op + (size_t)(i - 1) * DPOOL) = b0; *(f32x4*)(op + (size_t)(i - 1) * DPOOL + 4) = b1; }
            if (15 - i < w) { s[0] += b0.x; s[1] += b0.y; s[2] += b0.z; s[3] += b0.w; s[4] += b1.x; s[5] += b1.y; s[6] += b1.z; s[7] += b1.w; }
        }
        const float inv = 1.0f / (float)w;
        v4u o; o.x = pk2(s[0] * inv - a[0], s[1] * inv - a[1]); o.y = pk2(s[2] * inv - a[2], s[3] * inv - a[3]); o.z = pk2(s[4] * inv - a[4], s[5] * inv - a[5]); o.w = pk2(s[6] * inv - a[6], s[7] * inv - a[7]);
        *(GAS v4u*)(F.POOLED + (size_t)(MP + bs) * DPOOL + q * 8) = o;
    }
}
__device__ __forceinline__ void ret_sample_items(Frame& F, int first, int count) {
    const int lane = fresh_lane(), wave = F.wave;
    f32x4 svA[16], svB[16];
#define RS_LOAD(item, SV) do { const float* s0_ = F.st_ret + ((size_t)(item) * DK + 16 * wave) * DV + 4 * lane; \
        _Pragma("unroll") for (int r = 0; r < 16; ++r) SV[r] = __builtin_nontemporal_load((const f32x4*)(s0_ + (size_t)r * DV)); } while (0)
#define RS_BODY(item, SV, buf) do { \
        const int bs_ = (item) >> 3, h_ = (item) & 7, row_ = MP + bs_; \
        const float gam_ = 1.0f - __builtin_amdgcn_exp2f((float)(-5 - h_)); \
        const size_t hr_ = (size_t)(MP * NH) + (size_t)(item); \
        f32x4 v4_; { const v2u x_ = *(const GAS v2u*)(F.Vb + hr_ * DV + 4 * lane); v4_ = (f32x4){bflo(x_.x), bfhi(x_.x), bflo(x_.y), bfhi(x_.y)}; } \
        const v4u q0_ = *(const GAS v4u*)(F.Qb + hr_ * DK + 16 * wave), q1_ = *(const GAS v4u*)(F.Qb + hr_ * DK + 16 * wave + 8); \
        const v4u k0_ = *(const GAS v4u*)(F.Kb + hr_ * DK + 16 * wave), k1_ = *(const GAS v4u*)(F.Kb + hr_ * DK + 16 * wave + 8); \
        const float qv_[16] = {bflo(q0_.x), bfhi(q0_.x), bflo(q0_.y), bfhi(q0_.y), bflo(q0_.z), bfhi(q0_.z), bflo(q0_.w), bfhi(q0_.w), bflo(q1_.x), bfhi(q1_.x), bflo(q1_.y), bfhi(q1_.y), bflo(q1_.z), bfhi(q1_.z), bflo(q1_.w), bfhi(q1_.w)}; \
        const float kv_[16] = {bflo(k0_.x), bfhi(k0_.x), bflo(k0_.y), bfhi(k0_.y), bflo(k0_.z), bfhi(k0_.z), bflo(k0_.w), bfhi(k0_.w), bflo(k1_.x), bfhi(k1_.x), bflo(k1_.y), bfhi(k1_.y), bflo(k1_.z), bfhi(k1_.z), bflo(k1_.w), bfhi(k1_.w)}; \
        float* s1_ = F.out + O_RS + ((size_t)(item) * DK + 16 * wave) * DV + 4 * lane; \
        f32x4 o4_ = (f32x4){0.f, 0.f, 0.f, 0.f}; \
        _Pragma("unroll") for (int r = 0; r < 16; ++r) { const f32x4 sn_ = SV[r] * gam_ + v4_ * kv_[r]; __builtin_nontemporal_store(sn_, (f32x4*)(s1_ + (size_t)r * DV)); o4_ += sn_ * qv_[r]; } \
        LAS float* part_ = (LAS float*)(F.lds) + (buf) * 2048; \
        *(LAS f32x4*)(part_ + wave * 256 + 4 * lane) = o4_; \
        __syncthreads(); \
        if (wave == 0) { \
            f32x4 o_ = *(LAS f32x4*)(part_ + 4 * lane); \
            _Pragma("unroll") for (int w = 1; w < 8; ++w) o_ += *(LAS f32x4*)(part_ + w * 256 + 4 * lane); \
            const float mu_ = wave_sum((o_.x + o_.y) + (o_.z + o_.w)) * (1.0f / DV); \
            o_ = o_ - mu_; \
            const float var_ = wave_sum((o_.x * o_.x + o_.y * o_.y) + (o_.z * o_.z + o_.w * o_.w)) * (1.0f / DV); \
            const float rstd_ = 1.0f / sqrtf(var_ + EPS); \
            const f32x4 g_ = *(const f32x4*)(F.gn_g + h_ * DV + 4 * lane); \
            const v2u x_ = *(const GAS v2u*)(F.BG + hr_ * DV + 4 * lane); \
            o_ = o_ * rstd_ * g_; o_.x *= bflo(x_.x); o_.y *= bfhi(x_.x); o_.z *= bflo(x_.y); o_.w *= bfhi(x_.y); \
            v2u wv_; wv_.x = pk2(o_.x, o_.y); wv_.y = pk2(o_.z, o_.w); \
            *(GAS v2u*)(F.YAB + (size_t)row_ * LDY + 1024 + h_ * DV + 4 * lane) = wv_; \
        } } while (0)
    RS_LOAD(first, svA);
#pragma unroll 1
    for (int k = 0; k < count; k += 2) {
        if (k + 1 < count) RS_LOAD(first + k + 1, svB);
        RS_BODY(first + k, svA, 0);
        if (k + 1 < count) { if (k + 2 < count) RS_LOAD(first + k + 2, svA); RS_BODY(first + k + 1, svB, 1); }
    }
#undef RS_LOAD
#undef RS_BODY
    __syncthreads();
}

__device__ __forceinline__ void ret_c_unit(Frame& F, int unit) {
    const int bh = unit >> 4, c = unit & 15, b = bh >> 3, h = bh & 7, lane = fresh_lane(), wave = F.wave, hh = lane >> 5, l31 = lane & 31, tid_ = wave * 64 + lane;
    const float lg = lg2gamma(h);
    const int ti = wave & 3, wh = wave >> 2;
    const RowA ra = row_addr(lane); const TrA ta = tr_addr(lane);
    const int rowbase = b * SEQ + c * 128;
    const size_t hrow = (size_t)bh * SEQ + c * 128;
    const bf16* Qg = F.Qb + hrow * DK; const bf16* Kg = F.Kb + hrow * DK; const bf16* Vg = F.Vb + hrow * DV; const bf16* Bg = F.BG + hrow * DV;
    LAS unsigned char* Qi = F.lds; LAS unsigned char* Ki = F.lds + 32768; LAS unsigned char* Vi = F.lds + 65536;
    {
        v4u rq[4], rk[4], rv[8];
#pragma unroll
        for (int i = 0; i < 4; ++i) { const int n = tid_ + 512 * i;
            rq[i] = *(const GAS v4u*)(Qg + (size_t)n * 8); rk[i] = *(const GAS v4u*)(Kg + (size_t)n * 8); }
#pragma unroll
        for (int i = 0; i < 8; ++i) { const int n = tid_ + 512 * i; rv[i] = *(const GAS v4u*)(Vg + (size_t)n * 8); }
#pragma unroll
        for (int i = 0; i < 4; ++i) { const int n = tid_ + 512 * i, row = n >> 4, ch = n & 15; const unsigned o = (unsigned)(row >> 5) * 8192u + off_a(row & 31, ch);
            *(LAS v4u*)(Qi + o) = rq[i]; *(LAS v4u*)(Ki + o) = rk[i]; }
#pragma unroll
        for (int i = 0; i < 8; ++i) { const int n = tid_ + 512 * i, row = n >> 5, ch = n & 31;
            *(LAS v4u*)(Vi + (unsigned)((row >> 5) * 2 + (ch >> 4)) * 8192u + off_a(row & 31, ch & 15)) = rv[i]; }
    }
    const bf16* snb = F.SN + (((size_t)(bh * 16 + c) * 32) * 64 + lane) * 16;
    v4u sf[2][2][4];
    if (c > 0) {
#pragma unroll
        for (int i = 0; i < 2; ++i)
#pragma unroll
            for (int s2 = 0; s2 < 2; ++s2)
#pragma unroll
                for (int j = 0; j < 4; ++j) sf[i][s2][j] = *(const GAS v4u*)(snb + (size_t)(i * 8 + 4 * wh + j) * 1024 + 8 * s2);
    }
    __syncthreads();
    f32x16 X[2];
#pragma unroll
    for (int t = 0; t < 2; ++t) {
        const int sj = 2 * wh + t;
#pragma unroll
        for (int e = 0; e < 16; ++e) X[t][e] = 0.f;
        if (sj <= ti) {
#pragma unroll
            for (int ks = 0; ks < 8; ++ks) X[t] = MFMA32(frag_row(Ki + sj * 8192, ra, ks), frag_row(Qi + ti * 8192, ra, ks), X[t]);
        }
    }
    __syncthreads();
#pragma unroll
    for (int t = 0; t < 2; ++t) {
        const int sj = 2 * wh + t;
        if (sj <= ti) {
            const int tt = 32 * ti + l31;
#pragma unroll
            for (int g = 0; g < 4; ++g) {
                float p[4];
#pragma unroll
                for (int e = 0; e < 4; ++e) { const int s = 32 * sj + 8 * g + 4 * hh + e; const float f = __builtin_amdgcn_exp2f(-(float)(s + 1) * lg); p[e] = (s <= tt) ? X[t][4 * g + e] * f : 0.f; }
                v2u w; w.x = pk2(p[0], p[1]); w.y = pk2(p[2], p[3]);
                *(LAS v2u*)(Ki + ti * 8192 + off_a(l31, 4 * sj + g) + 8 * hh) = w;
            }
        }
    }
    f32x16 O[4];
#pragma unroll
    for (int j = 0; j < 4; ++j)
#pragma unroll
        for (int e = 0; e < 16; ++e) O[j][e] = 0.f;
    const unsigned qb = 2048u * (l31 >> 3) + 64u * (l31 & 7) + 8u * hh, qm = (l31 >> 2) & 3;
    const LAS unsigned char* Qt = Qi + ti * 8192 + qb;
#define QFRAG(i, s2) __builtin_shufflevector(*(const LAS s16x4*)(Qt + 512 * (i) + 16 * ((2 * (s2)) ^ qm)), *(const LAS s16x4*)(Qt + 512 * (i) + 16 * ((2 * (s2) + 1) ^ qm)), 0, 1, 2, 3, 4, 5, 6, 7)
    if (c > 0) {
#pragma unroll
        for (int i = 0; i < 2; ++i)
#pragma unroll
            for (int s2 = 0; s2 < 2; ++s2) { const bf16x8 a = QFRAG(i, s2);
#pragma unroll
                for (int j = 0; j < 4; ++j) O[j] = MFMA32(a, __builtin_bit_cast(bf16x8, sf[i][s2][j]), O[j]); }
#pragma unroll
        for (int i = 0; i < 2; ++i)
#pragma unroll
            for (int s2 = 0; s2 < 2; ++s2)
#pragma unroll
                for (int j = 0; j < 4; ++j) sf[i][s2][j] = *(const GAS v4u*)(snb + (size_t)((i + 2) * 8 + 4 * wh + j) * 1024 + 8 * s2);
    }
    __syncthreads();
    for (int kk = 0; kk < 2 * (ti + 1); ++kk) {
        const bf16x8 a = frag_row(Ki + ti * 8192, ra, kk);
        const LAS unsigned char* vimg = Vi + ((kk >> 1) * 2 + wh) * 8192;
#pragma unroll
        for (int j = 0; j < 4; ++j) O[j] = MFMA32(a, frag_tr(vimg, ta, j, kk & 1), O[j]);
    }
    if (c > 0) {
#pragma unroll
        for (int i = 0; i < 2; ++i)
#pragma unroll
            for (int s2 = 0; s2 < 2; ++s2) { const bf16x8 a = QFRAG(i + 2, s2);
#pragma unroll
                for (int j = 0; j < 4; ++j) O[j] = MFMA32(a, __builtin_bit_cast(bf16x8, sf[i][s2][j]), O[j]); }
    }
#undef QFRAG
    LAS float* st = (LAS float*)(F.lds + STAT_OFF);
    float mu[16], rs[16];
#pragma unroll
    for (int e = 0; e < 16; ++e) {
        const float f = __builtin_amdgcn_exp2f((float)(crow(e, hh) + 32 * ti + 1) * lg);
        float s = 0.f;
#pragma unroll
        for (int j = 0; j < 4; ++j) { O[j][e] *= f; s += O[j][e]; }
        s += __shfl_xor(s, 1); s += __shfl_xor(s, 2); s += __shfl_xor(s, 4); s += __shfl_xor(s, 8); s += __shfl_xor(s, 16);
        if (l31 == 0) st[(32 * ti + crow(e, hh)) * 2 + wh] = s;
    }
    __syncthreads();
#pragma unroll
    for (int e = 0; e < 16; ++e) { const int r = 32 * ti + crow(e, hh); mu[e] = (st[r * 2] + st[r * 2 + 1]) * (1.0f / DV); }
#pragma unroll
    for (int e = 0; e < 16; ++e) {
        float s = 0.f;
#pragma unroll
        for (int j = 0; j < 4; ++j) { O[j][e] -= mu[e]; s += O[j][e] * O[j][e]; }
        s += __shfl_xor(s, 1); s += __shfl_xor(s, 2); s += __shfl_xor(s, 4); s += __shfl_xor(s, 8); s += __shfl_xor(s, 16);
        if (l31 == 0) st[256 + (32 * ti + crow(e, hh)) * 2 + wh] = s;
    }
    __syncthreads();
#pragma unroll
    for (int e = 0; e < 16; ++e) { const int r = 32 * ti + crow(e, hh); rs[e] = 1.0f / sqrtf((st[256 + r * 2] + st[256 + r * 2 + 1]) * (1.0f / DV) + EPS); }
    LAS float* T = (LAS float*)F.lds;
#pragma unroll
    for (int j = 0; j < 4; ++j) {
        const float g = F.gn_g[h * DV + 128 * wh + 32 * j + l31];
#pragma unroll
        for (int e = 0; e < 16; ++e) T[(32 * ti + crow(e, hh)) * 256 + 128 * wh + 32 * j + l31] = O[j][e] * rs[e] * g;
    }
    __syncthreads();
    {
        v4u bg[8];
#pragma unroll
        for (int i = 0; i < 8; ++i) { const int n = tid_ + 512 * i; bg[i] = *(const GAS v4u*)(Bg + (size_t)n * 8); }
#pragma unroll
        for (int i = 0; i < 8; ++i) { const int n = tid_ + 512 * i, row = n >> 5, ch = n & 31;
            const f32x4 t0 = *(const LAS f32x4*)(T + row * 256 + ch * 8), t1 = *(const LAS f32x4*)(T + row * 256 + ch * 8 + 4);
            v4u o; o.x = pk2(t0.x * bflo(bg[i].x), t0.y * bfhi(bg[i].x)); o.y = pk2(t0.z * bflo(bg[i].y), t0.w * bfhi(bg[i].y));
            o.z = pk2(t1.x * bflo(bg[i].z), t1.y * bfhi(bg[i].z)); o.w = pk2(t1.z * bflo(bg[i].w), t1.w * bfhi(bg[i].w));
            *(GAS v4u*)(F.YAB + (size_t)(rowbase + row) * LDY + 1024 + h * DV + ch * 8) = o; }
    }
    __syncthreads();
}


constexpr int CW_Q = 8192;
__device__ __forceinline__ int wg_ticket(Frame& F, int q, int n) {
    __syncthreads();
    if (F.tid == 0) F.MISC[16] = __hip_atomic_fetch_add((unsigned*)(F.ctl + CW_Q + 64 * q), (unsigned)n, __ATOMIC_RELAXED, __HIP_MEMORY_SCOPE_AGENT);
    __syncthreads();
    return (int)F.MISC[16];
}

__device__ __forceinline__ void final_row(Frame& F, const float* xrow, const bf16* orow, float* ywr, const float* ssrow, const float* gaterow) {
    const float s = ssrow[F.lane];
    const float rstd = 1.0f / sqrtf(wave_sum(s) * (1.0f / DM) + EPS);
#pragma unroll
    for (int j = 0; j < 4; ++j) {
        const int col = 8 * F.lane + 512 * j;
        const v4u o = __builtin_nontemporal_load((const v4u*)(orow + col));
        const f32x4 x0 = __builtin_nontemporal_load((const f32x4*)(xrow + col)), x1 = __builtin_nontemporal_load((const f32x4*)(xrow + col + 4));
        const f32x4 g0 = *(const f32x4*)(F.g_post + col), g1 = *(const f32x4*)(F.g_post + col + 4), t0 = *(const f32x4*)(gaterow + col), t1 = *(const f32x4*)(gaterow + col + 4);
        const f32x4 o0 = (f32x4){bflo(o.x), bfhi(o.x), bflo(o.y), bfhi(o.y)}, o1 = (f32x4){bflo(o.z), bfhi(o.z), bflo(o.w), bfhi(o.w)};
        __builtin_nontemporal_store(x0 + t0 * (o0 * rstd * g0), (f32x4*)(ywr + col));
        __builtin_nontemporal_store(x1 + t1 * (o1 * rstd * g1), (f32x4*)(ywr + col + 4));
    }
}

struct Args { const float* in[19]; float* out; unsigned char* ws; int ph_lo, ph_hi; };
constexpr int N_PHASES = 9;
__global__ void __launch_bounds__(NWAVES * 64, 2) hybrid_fwd(Args args) {
    extern __shared__ __attribute__((aligned(16))) unsigned char lds[];
    Frame F;
    F.lds = (LAS unsigned char*)lds;
    F.MISC = (volatile LAS unsigned*)(F.lds + MISC_OFF);
    F.wave = __builtin_amdgcn_readfirstlane((int)threadIdx.x >> 6); F.lane = fresh_lane(); F.tid = F.wave * 64 + F.lane;
    F.G = gridDim.x; { const int bx = blockIdx.x; F.vcu = (F.G % 8 == 0) ? (bx % 8) * (F.G / 8) + bx / 8 : bx; }
    unsigned char* ws = args.ws;
    F.ctl = (gu32*)(ws + WS_CTL);
    F.x_p = args.in[0]; F.x_s = args.in[1]; F.st_pool = args.in[2]; F.st_ret = args.in[3]; F.c_p = args.in[4]; F.c_s = args.in[5]; F.ada_w = args.in[6]; F.ada_b = args.in[7];
    F.g_pre = args.in[8]; F.g_post = args.in[9]; F.w_in = args.in[10]; F.pool_w = args.in[11]; F.pool_scale = args.in[12]; F.gn_g = args.in[13]; F.w_a = args.in[14]; F.w_b = args.in[15];
    F.w_merge = args.in[16]; F.b_merge = args.in[17]; F.w_out = args.in[18]; F.out = args.out;
    F.ropec = (float*)(ws + WS_ROPE); F.ropes = F.ropec + 2049 * 64; F.mod = (float*)(ws + WS_MOD); F.ss = (float*)(ws + WS_SS);
    F.Wcat = (bf16*)(ws + WS_WCAT); F.Wab = (bf16*)(ws + WS_WAB); F.Wout = (bf16*)(ws + WS_WOUT); F.PoolW = (bf16*)(ws + WS_POOLW);
    F.H = (bf16*)(ws + WS_H); F.AX = (bf16*)(ws + WS_AX); F.AG = (bf16*)(ws + WS_AG); F.Qb = (bf16*)(ws + WS_Q); F.Kb = (bf16*)(ws + WS_K); F.Vb = (bf16*)(ws + WS_V); F.BG = (bf16*)(ws + WS_BG); F.GA = (bf16*)(ws + WS_GA); F.GB = (bf16*)(ws + WS_GB); F.YAB = (bf16*)(ws + WS_YAB); F.POOLED = (bf16*)(ws + WS_POOLED); F.SN = (bf16*)(ws + WS_SN); F.MB = (bf16*)(ws + WS_MB);
    for (int u = F.tid; u < (LDS_BYTES - LDSCTL_OFF) / 4; u += NWAVES * 64) ((LAS unsigned*)(F.lds + LDSCTL_OFF))[u] = 0u;
    __syncthreads();
    const int lo = args.ph_lo, hi = args.ph_hi;
    XcdBarrier bar; bar.bar = (unsigned*)(F.ctl + CW_BAR); bar.x = 0; bar.st = nullptr; bar.wave = F.wave;
    if (hi - lo > 1) bar = xcd_barrier_post((unsigned*)(F.ctl + CW_BAR), F.MISC + 8, F.wave);
#define IN(k) (lo <= (k) && (k) < hi)
#define PHASE_BEGIN() do { F.lane = fresh_lane(); F.tid = F.wave * 64 + F.lane; } while (0)
#define SEAM(k) do { if (IN(k) && IN((k) + 1)) xcd_barrier(bar); } while (0)
    const int gw = F.vcu * NWAVES + F.wave, NGW = F.G * NWAVES;

    if (((PH_MASK >> 0) & 1) && IN(0)) for (int rep_ = 0; rep_ < (REP_PHASE == 0 ? REP_N : 1); ++rep_) { PHASE_BEGIN(); p0_prologue(F, false); } SEAM(0);

    if (((PH_MASK >> 1) & 1) && IN(1)) for (int rep_ = 0; rep_ < (REP_PHASE == 1 ? REP_N : 1); ++rep_) { PHASE_BEGIN();
        for (int m = gw; m < MP + MS; m += NGW) {
            const float* xr = m < MP ? F.x_p + (size_t)m * DM : F.x_s + (size_t)(m - MP) * DM;
            const float* mr = F.mod + (size_t)(m < MP ? (m >> 11) : 4 + (m - MP)) * 6144;
            h_row(F, xr, mr, F.H + (size_t)m * DM);
        }
    } SEAM(1);

    if (((PH_MASK >> 2) & 1) && IN(2)) for (int rep_ = 0; rep_ < (REP_PHASE == 2 ? REP_N : 1); ++rep_) { PHASE_BEGIN();
        EpiZ E{F.AX, F.AG, F.Qb, F.Kb, F.Vb, F.BG, F.GA, F.GB, F.b_merge, F.ropec, F.ropes, F.out + O_PP, F.out + O_PS};
        pg8::Gemm gs{F.H + (size_t)MP * DM, F.Wcat, DM, DM, DM, 0}; pg8::sgemm_phase<EpiZ>(F.lds + RING_OFF, gs, MP, LDZ / 64, F.vcu, F.G, E, F.tid);
    } SEAM(2);

    if (((PH_MASK >> 3) & 1) && IN(3)) for (int rep_ = 0; rep_ < (REP_PHASE == 3 ? REP_N : 1); ++rep_) { PHASE_BEGIN();
        pg8::Gemm g{F.H, F.Wcat, DM, DM, DM, 0};
        EpiZ E{F.AX, F.AG, F.Qb, F.Kb, F.Vb, F.BG, F.GA, F.GB, F.b_merge, F.ropec, F.ropes, F.out + O_PP, F.out + O_PS};
        const int n1 = 1 + (F.vcu % 5);
        { pg8::RangeOrder S; S.init(MP, LDZ, F.G, (int)blockIdx.x); S.i0 = 0; S.i1 = n1;
          pg8::gemm_phase<EpiZ, pg8::RangeOrder, true, true>(F.lds + RING_OFF, g, S, E, F.tid); }
        PHASE_BEGIN();
        { const int per = (MS * NH + F.G - 1) / F.G; const int f0 = F.vcu * per; if (f0 < MS * NH) ret_sample_items(F, f0, (f0 + per <= MS * NH) ? per : MS * NH - f0); }
        PHASE_BEGIN();
        p0_prologue(F, true); __syncthreads();
        PHASE_BEGIN();
        { pg8::RangeOrder S; S.init(MP, LDZ, F.G, (int)blockIdx.x); S.i0 = n1; S.i1 = 1 << 20;
          pg8::gemm_phase<EpiZ, pg8::RangeOrder, true, true>(F.lds + RING_OFF, g, S, E, F.tid); }
    } SEAM(3);

    if (((PH_MASK >> 4) & 1) && IN(4)) for (int rep_ = 0; rep_ < (REP_PHASE == 4 ? REP_N : 1); ++rep_) { PHASE_BEGIN();
        for (int u = F.vcu; u < 256; u += F.G) ret_ab_unit(F, u);
        PHASE_BEGIN();
        { const int gw512 = F.vcu; for (int k = gw512; k < 2048 + 32; k += F.G) { if (k < 2048) pooled_prompt(F, k * 512, k * 512 + 512); else pooled_sample(F, (k - 2048) * 512, (k - 2048) * 512 + 512); } }
    } SEAM(4);

    if (((PH_MASK >> 5) & 1) && IN(5)) for (int rep_ = 0; rep_ < (REP_PHASE == 5 ? REP_N : 1); ++rep_) { PHASE_BEGIN();
        { pg8::Gemm g{F.POOLED, F.PoolW, 256, DPOOL, 256, 512}; pg8::StaticOrder S; S.init(MT, DPOOL, F.G, (int)blockIdx.x);
          EpiPool E{F.YAB, F.AG, F.pool_scale};
          pg8::gemm_phase<EpiPool, pg8::StaticOrder, true, true>(F.lds + RING_OFF, g, S, E, F.tid); }
        PHASE_BEGIN();
        for (;;) { const int t = wg_ticket(F, 4 * rep_ + 3, 1); if (t >= 512) break; ret_c_unit(F, t); }
    } SEAM(5);

    if (((PH_MASK >> 6) & 1) && IN(6)) for (int rep_ = 0; rep_ < (REP_PHASE == 6 ? REP_N : 1); ++rep_) { PHASE_BEGIN();
        pg8::Gemm g{F.YAB, F.Wab, LDY, LDY, LDY, 0}; pg8::StaticOrder S; S.init(MP, DM, F.G, (int)blockIdx.x);
        EpiMerge E{F.MB, F.GA, F.GB};
        pg8::gemm_phase<EpiMerge, pg8::StaticOrder, true, true>(F.lds + RING_OFF, g, S, E, F.tid);
        PHASE_BEGIN();
        { pg8::Gemm gs{F.YAB + (size_t)MP * LDY, F.Wab, LDY, LDY, LDY, 0}; pg8::sgemm_phase<EpiMerge>(F.lds + RING_OFF, gs, MP, DM / 64, F.vcu, F.G, E, F.tid); }
    } SEAM(6);

    if (((PH_MASK >> 7) & 1) && IN(7)) for (int rep_ = 0; rep_ < (REP_PHASE == 7 ? REP_N : 1); ++rep_) { PHASE_BEGIN();
        pg8::Gemm g{F.MB, F.Wout, DM, DM, DM, 0}; pg8::StaticOrder S; S.init(MP, DM, F.G, (int)blockIdx.x);
        EpiOut E{F.H, F.ss};
        pg8::gemm_phase<EpiOut, pg8::StaticOrder, true, true>(F.lds + RING_OFF, g, S, E, F.tid);
        PHASE_BEGIN();
        { pg8::Gemm gs{F.MB + (size_t)MP * DM, F.Wout, DM, DM, DM, 0}; pg8::sgemm_phase<EpiOut>(F.lds + RING_OFF, gs, MP, DM / 64, F.vcu, F.G, E, F.tid); }
    } SEAM(7);

    if (((PH_MASK >> 8) & 1) && IN(8)) for (int rep_ = 0; rep_ < (REP_PHASE == 8 ? REP_N : 1); ++rep_) { PHASE_BEGIN();
        for (int m = gw; m < MP + MS; m += NGW) {
            const float* xr = m < MP ? F.x_p + (size_t)m * DM : F.x_s + (size_t)(m - MP) * DM;
            float* yr = F.out + (m < MP ? O_YP + (size_t)m * DM : O_YS + (size_t)(m - MP) * DM);
            const float* gr = F.mod + (size_t)(m < MP ? (m >> 11) : 4 + (m - MP)) * 6144 + 2 * DM;
            final_row(F, xr, F.H + (size_t)m * DM, yr, F.ss + (size_t)m * 64, gr);
        }
    }
#undef IN
#undef SEAM
}

extern "C" void kernel_launch(void* const* d_in, const int* in_sizes, int n_in, void* d_out, int out_size, void* d_ws, size_t ws_size, hipStream_t stream) {
    static int grid = 0;
    if (grid == 0) {
        if (n_in != 19 || ws_size < WS_END) { fprintf(stderr, "kernel_launch: unexpected inputs (n_in %d, ws %zu)\n", n_in, ws_size); grid = -1; return; }
        int dev = 0, cus = 0, per_cu = 0;
        if (hipGetDevice(&dev) != hipSuccess || hipDeviceGetAttribute(&cus, hipDeviceAttributeMultiprocessorCount, dev) != hipSuccess) { grid = -1; return; }
        if (hipFuncSetAttribute((const void*)hybrid_fwd, hipFuncAttributeMaxDynamicSharedMemorySize, LDS_BYTES) != hipSuccess) { fprintf(stderr, "kernel_launch: hipFuncSetAttribute failed\n"); grid = -1; return; }
        if (hipOccupancyMaxActiveBlocksPerMultiprocessor(&per_cu, (const void*)hybrid_fwd, NWAVES * 64, LDS_BYTES) != hipSuccess || per_cu < 1) { fprintf(stderr, "kernel_launch: occupancy query says %d\n", per_cu); per_cu = 1; }
        (void)hipGetLastError();
        grid = cus;
    }
    if (grid < 0) return;
    (void)hipMemsetAsync((char*)d_ws + WS_CTL, 0, CTL_ZERO_BYTES, stream);
    Args a{};
    for (int i = 0; i < 19; ++i) a.in[i] = (const float*)d_in[i];
    a.out = (float*)d_out; a.ws = (unsigned char*)d_ws;
    if (MK_N_LAUNCHES == 1) { a.ph_lo = 0; a.ph_hi = N_PHASES; hipLaunchKernelGGL(hybrid_fwd, dim3(grid), dim3(NWAVES * 64), LDS_BYTES, stream, a); }
    else for (int p = 0; p < N_PHASES; ++p) { a.ph_lo = p; a.ph_hi = p + 1; hipLaunchKernelGGL(hybrid_fwd, dim3(grid), dim3(NWAVES * 64), LDS_BYTES, stream, a); }
}
```
